# Optimizing an MI355X kernel written in HIP

```python
import jax, jax.numpy as jnp
from jax import lax
import numpy as np

D_MODEL = 1024
BATCH = 8
SEQ = 2048
DEPTH = 1
DEC_BATCH = 128
DEC_SEQ = 8
PAST_LEN = 16384
PAGE_SIZE = 128

D_MIX = D_MODEL
D_RG = D_MIX // 2
RG_BLOCKS = 8
RG_BW = D_RG // RG_BLOCKS
RG_C = 8.0
CONV_W = 4
GDN_HEADS = 4
GDN_DV = (D_MIX - D_RG) // GDN_HEADS
GDN_DK = GDN_DV
D_QK = GDN_HEADS * GDN_DK
D_V = GDN_HEADS * GDN_DV
D_GDN_CONV = 2 * D_QK + D_V
GDN_CHUNK = 64
D_FF = -(-8 * D_MODEL // (3 * 256)) * 256
EPS = 1e-6
D_IN = 2 * D_RG + D_GDN_CONV + D_V + 2 * GDN_HEADS
SPLITS = tuple(np.cumsum([D_RG, D_RG, D_GDN_CONV, D_V, GDN_HEADS]).tolist())

kernel_name = "hybrid_rglru_gdn_step"


def rmsnorm(x, w):
    xf = x.astype(jnp.float32)
    y = xf * lax.rsqrt(jnp.mean(xf * xf, axis=-1, keepdims=True) + EPS)
    return (y * w.astype(jnp.float32)).astype(x.dtype)


def l2norm(x):
    return x * lax.rsqrt(jnp.sum(x * x, axis=-1, keepdims=True) + EPS)


def causal_conv(x, buf, w):
    T = x.shape[1]
    xp = jnp.concatenate([buf.astype(x.dtype), x], axis=1)
    y = xp[:, 0:T] * w[0]
    for j in range(1, CONV_W):
        y = y + xp[:, j:j + T] * w[j]
    return y, xp[:, -(CONV_W - 1):]


def rglru(x, h0, w_a, b_a, w_i, b_i, lam):
    B, T, _ = x.shape
    xb = x.reshape(B, T, RG_BLOCKS, RG_BW)
    gate_r = jax.nn.sigmoid(jnp.einsum("bthi,hij->bthj", xb, w_a).reshape(B, T, D_RG) + b_a)
    gate_i = jax.nn.sigmoid(jnp.einsum("bthi,hij->bthj", xb, w_i).reshape(B, T, D_RG) + b_i)
    log_a = -RG_C * gate_r * jax.nn.softplus(-lam)
    a = jnp.exp(log_a)
    u = jnp.sqrt(-jnp.expm1(2.0 * log_a)) * (gate_i * x)
    u = u.at[:, 0].add(a[:, 0] * h0)

    def combine(left, right):
        a1, b1 = left
        a2, b2 = right
        return a1 * a2, a2 * b1 + b2

    _, h = lax.associative_scan(combine, (a, u), axis=1)
    return h, h[:, -1]


def gated_delta_chunked(q, k, v, g, beta, S0):
    B, T, H, DK = k.shape
    DV = v.shape[-1]
    C = min(GDN_CHUNK, T)
    pad = (-T) % C
    N = (T + pad) // C

    def to_chunks(z):
        z = jnp.pad(z, [(0, 0), (0, pad)] + [(0, 0)] * (z.ndim - 2))
        z = jnp.moveaxis(z, 2, 1)
        return z.reshape((B, H, N, C) + z.shape[3:])

    q, k, v, g, beta = (to_chunks(z) for z in (q, k, v, g, beta))
    gc = jnp.cumsum(g, axis=-1)
    tril = jnp.tril(jnp.ones((C, C), dtype=bool))
    strict = jnp.tril(jnp.ones((C, C), dtype=bool), -1)
    decay = jnp.exp(jnp.where(tril, gc[..., :, None] - gc[..., None, :], -jnp.inf))
    kb = k * beta[..., None]
    kkt = jnp.einsum("bhnid,bhnjd->bhnij", kb, k) * decay
    A = jnp.eye(C, dtype=k.dtype) + jnp.where(strict, kkt, 0.0)
    rhs = jnp.concatenate([v * beta[..., None], kb * jnp.exp(gc)[..., None]], axis=-1)
    sol = lax.linalg.triangular_solve(A, rhs, left_side=True, lower=True, unit_diagonal=True)
    u, w = sol[..., :DV], sol[..., DV:]
    qk = jnp.einsum("bhnid,bhnjd->bhnij", q, k) * decay
    q_dec = q * jnp.exp(gc)[..., None]
    k_tail = k * jnp.exp(gc[..., -1:] - gc)[..., None]
    g_last = jnp.exp(gc[..., -1])

    xs = tuple(jnp.moveaxis(z, 2, 0) for z in (qk, u, w, q_dec, k_tail, g_last))

    def step(S, inp):
        qk_n, u_n, w_n, qd_n, kt_n, gl_n = inp
        v_new = u_n - jnp.einsum("bhcd,bhde->bhce", w_n, S)
        o = jnp.einsum("bhcd,bhde->bhce", qd_n, S) + jnp.einsum("bhij,bhje->bhie", qk_n, v_new)
        S = S * gl_n[..., None, None] + jnp.einsum("bhcd,bhce->bhde", kt_n, v_new)
        return S, o

    S, o = lax.scan(step, S0, xs)
    o = jnp.transpose(o, (1, 0, 3, 2, 4)).reshape(B, N * C, H, DV)[:, :T]
    return o, S


def trunk(x, rg_conv_s, rg_h_s, gdn_conv_s, gdn_S_s,
          norm1, w_in, rg_conv_w, rg_conv_b, rg_wa, rg_ba, rg_wi, rg_bi, rg_lambda,
          gdn_conv_w, gdn_A_log, gdn_dt_bias, gdn_norm_w, w_out,
          norm2, w_gate, w_up, w_down, final_norm):
    B, T, _ = x.shape
    new_rc, new_rh, new_gc, new_gs = [], [], [], []
    for l in range(DEPTH):
        hn = rmsnorm(x, norm1[l])
        proj = hn @ w_in[l]
        xr, yr, qkv_raw, z, rest = jnp.split(proj, SPLITS[:4], axis=-1)
        b_raw, a_raw = rest[..., :GDN_HEADS], rest[..., GDN_HEADS:]

        xc, rc_new = causal_conv(xr, rg_conv_s[l], rg_conv_w[l])
        xc = (xc + rg_conv_b[l]).astype(jnp.float32)
        h, rh_new = rglru(xc, rg_h_s[l].astype(jnp.float32), rg_wa[l], rg_ba[l], rg_wi[l], rg_bi[l], rg_lambda[l])
        out_rg = (jax.nn.gelu(yr.astype(jnp.float32)) * h).astype(x.dtype)

        qkv, gc_new = causal_conv(qkv_raw, gdn_conv_s[l], gdn_conv_w[l])
        qkv = jax.nn.silu(qkv.astype(jnp.float32))
        q, k, v = jnp.split(qkv, [D_QK, 2 * D_QK], axis=-1)
        q = l2norm(q.reshape(B, T, GDN_HEADS, GDN_DK)) * (GDN_DK ** -0.5)
        k = l2norm(k.reshape(B, T, GDN_HEADS, GDN_DK))
        v = v.reshape(B, T, GDN_HEADS, GDN_DV)
        beta = jax.nn.sigmoid(b_raw.astype(jnp.float32))
        g = -jnp.exp(gdn_A_log[l].astype(jnp.float32)) * jax.nn.softplus(a_raw.astype(jnp.float32) + gdn_dt_bias[l])
        o, S_new = gated_delta_chunked(q, k, v, g, beta, gdn_S_s[l].astype(jnp.float32))
        zh = z.astype(jnp.float32).reshape(B, T, GDN_HEADS, GDN_DV)
        out_gdn = (rmsnorm(o, gdn_norm_w[l]) * jax.nn.silu(zh)).reshape(B, T, D_V).astype(x.dtype)

        x = x + jnp.concatenate([out_rg, out_gdn], axis=-1) @ w_out[l]

        hf = rmsnorm(x, norm2[l])
        x = x + (jax.nn.silu(hf @ w_gate[l]) * (hf @ w_up[l])) @ w_down[l]

        new_rc.append(rc_new)
        new_rh.append(rh_new)
        new_gc.append(gc_new)
        new_gs.append(S_new)
    y = rmsnorm(x, final_norm)
    return y, jnp.stack(new_rc), jnp.stack(new_rh), jnp.stack(new_gc), jnp.stack(new_gs)


def setup_inputs(seed: int = 0) -> dict:
    key = jax.random.key(seed)
    ks = iter(jax.random.split(key, 40))
    nrm = lambda shape, s: jax.random.normal(next(ks), shape, jnp.float32) * s
    L = DEPTH
    a0 = jax.random.uniform(next(ks), (L, D_RG), jnp.float32, 0.9, 0.999) ** (1.0 / RG_C)
    rg_lambda = jnp.log(a0) - jnp.log1p(-a0)
    A = jax.random.uniform(next(ks), (L, GDN_HEADS), jnp.float32, 1.0, 16.0)
    return {
        "x_prompt": nrm((BATCH, SEQ, D_MODEL), 1.0),
        "x_sample": nrm((DEC_BATCH, DEC_SEQ, D_MODEL), 1.0),
        "state_rglru_conv": nrm((L, DEC_BATCH, CONV_W - 1, D_RG), 1.0),
        "state_rglru_h": nrm((L, DEC_BATCH, D_RG), 0.5),
        "state_gdn_conv": nrm((L, DEC_BATCH, CONV_W - 1, D_GDN_CONV), 1.0),
        "state_gdn_S": nrm((L, DEC_BATCH, GDN_HEADS, GDN_DK, GDN_DV), GDN_DK ** -0.5),
        "norm1": 1.0 + nrm((L, D_MODEL), 0.02),
        "w_in": nrm((L, D_MODEL, D_IN), D_MODEL ** -0.5),
        "rg_conv_w": nrm((L, CONV_W, D_RG), CONV_W ** -0.5),
        "rg_conv_b": nrm((L, D_RG), 0.01),
        "rg_wa": nrm((L, RG_BLOCKS, RG_BW, RG_BW), RG_BW ** -0.5),
        "rg_ba": nrm((L, D_RG), 0.01),
        "rg_wi": nrm((L, RG_BLOCKS, RG_BW, RG_BW), RG_BW ** -0.5),
        "rg_bi": nrm((L, D_RG), 0.01),
        "rg_lambda": rg_lambda,
        "gdn_conv_w": nrm((L, CONV_W, D_GDN_CONV), CONV_W ** -0.5),
        "gdn_A_log": jnp.log(A),
        "gdn_dt_bias": nrm((L, GDN_HEADS), 0.1),
        "gdn_norm_w": 1.0 + nrm((L, GDN_DV), 0.02),
        "w_out": nrm((L, D_MIX, D_MODEL), D_MIX ** -0.5),
        "norm2": 1.0 + nrm((L, D_MODEL), 0.02),
        "w_gate": nrm((L, D_MODEL, D_FF), D_MODEL ** -0.5),
        "w_up": nrm((L, D_MODEL, D_FF), D_MODEL ** -0.5),
        "w_down": nrm((L, D_FF, D_MODEL), D_FF ** -0.5),
        "final_norm": 1.0 + nrm((D_MODEL,), 0.02),
    }


def reference(x_prompt, x_sample, state_rglru_conv, state_rglru_h, state_gdn_conv, state_gdn_S,
              norm1, w_in, rg_conv_w, rg_conv_b, rg_wa, rg_ba, rg_wi, rg_bi, rg_lambda,
              gdn_conv_w, gdn_A_log, gdn_dt_bias, gdn_norm_w, w_out,
              norm2, w_gate, w_up, w_down, final_norm):
    weights = (norm1, w_in, rg_conv_w, rg_conv_b, rg_wa, rg_ba, rg_wi, rg_bi, rg_lambda,
               gdn_conv_w, gdn_A_log, gdn_dt_bias, gdn_norm_w, w_out,
               norm2, w_gate, w_up, w_down, final_norm)
    Bp = x_prompt.shape[0]
    dt = x_prompt.dtype
    p0_rc = jnp.zeros((DEPTH, Bp, CONV_W - 1, D_RG), dt)
    p0_rh = jnp.zeros((DEPTH, Bp, D_RG), jnp.float32)
    p0_gc = jnp.zeros((DEPTH, Bp, CONV_W - 1, D_GDN_CONV), dt)
    p0_gs = jnp.zeros((DEPTH, Bp, GDN_HEADS, GDN_DK, GDN_DV), jnp.float32)
    y_prompt, p_rc, p_rh, p_gc, p_gs = trunk(x_prompt, p0_rc, p0_rh, p0_gc, p0_gs, *weights)
    y_sample, s_rc, s_rh, s_gc, s_gs = trunk(x_sample, state_rglru_conv, state_rglru_h,
                                             state_gdn_conv, state_gdn_S, *weights)
    return (y_prompt, y_sample, p_rc, p_rh, p_gc, p_gs, s_rc, s_rh, s_gc, s_gs)
```

```cpp
#include <hip/hip_runtime.h>
#include <hip/hip_cooperative_groups.h>
#include <cstdio>
#include <cstdint>
namespace cg = cooperative_groups;
namespace pg8 {
#define PG8_LAS __attribute__((address_space(3)))
typedef unsigned short bf16_t;
typedef short bf16x8 __attribute__((ext_vector_type(8)));
typedef float f32x4 __attribute__((ext_vector_type(4)));
typedef unsigned u32x4 __attribute__((ext_vector_type(4)));
constexpr int BM = 256, BK = 64, HALF = 128, HTB = HALF * BK * 2  , STAGE_BYTES = 8 * HTB, NXCD = 8, WGM = 8;

__host__ __device__ __forceinline__ int lds_byte(int r, int c) { const int st = (r >> 4) * 2 + (c >> 5), rr = r & 15, cc = c & 31, ob = rr * 64 + cc * 2; return st * 1024 + (ob ^ (((ob >> 9) & 1) << 5)); }
__host__ __device__ __forceinline__ void stage_rc(int b, int& R, int& C) { const int st = b / 1024, sb = b % 1024, swz = sb ^ (((sb >> 9) & 1) << 5); R = (st >> 1) * 16 + swz / 64; C = (st & 1) * 32 + (swz % 64) / 2; }
__host__ __device__ __forceinline__ int perm32(int rho) { const int n = rho >> 4, i = rho & 15; return 8 * (i >> 2) + 4 * n + (i & 3); }

struct Unit { int pm, pn; };
struct Gemm { const bf16_t* A; const bf16_t* Bt; int M, N, K; };

struct StaticOrder {
    int nM, nN, nwg, G, c;
    __host__ __device__ void init(int M, int N, int G_, int c_) { nM = M / BM; nN = N / BM; nwg = nM * nN; G = G_; c = c_; }
    __host__ __device__ bool next(int i, Unit& u) const {
        const long L = (long)i * G + c; if (L >= nwg) return false;
        int wgid = (int)L; { const int q = nwg / NXCD, r = nwg % NXCD, xcd = wgid % NXCD, off = wgid / NXCD; wgid = (xcd < r ? xcd * (q + 1) : r * (q + 1) + (xcd - r) * q) + off; }
        const int nig = WGM * nN, gid = wgid / nig, fm = gid * WGM, gsz = (nM - fm) < WGM ? (nM - fm) : WGM;
        u.pm = fm + ((wgid % nig) % gsz); u.pn = (wgid % nig) / gsz; return true;
    }
    __device__ __forceinline__ void a_ready(const Unit&) const {}
    __device__ __forceinline__ void done(const Unit&) const {}
};
__device__ __forceinline__ unsigned cvt_pk_bf16(float lo, float hi) { unsigned r; asm volatile("v_cvt_pk_bf16_f32 %0, %1, %2" : "=v"(r) : "v"(lo), "v"(hi)); return r; }
template <class Epi, class Sched, bool ALIGN_EPI = false, bool SP2 = false>
__device__ __forceinline__ void gemm_phase(PG8_LAS unsigned char* lds, const Gemm g, const Sched& S, const Epi& E) {
    int tid = threadIdx.x; asm volatile("" : "+v"(tid)); const int wid = __builtin_amdgcn_readfirstlane(tid >> 6), lane = tid & 63, wr = wid >> 2, wc = wid & 3, fr = lane & 15, fq = lane >> 4;
    const int K = g.K, nt = K / BK;
    unsigned voffA[2], voffB[2];
#pragma unroll
    for (int i = 0; i < 2; ++i) { int R, C; stage_rc(tid * 16 + i * 8192, R, C); const int Rb = Epi::PERM ? ((R & ~31) + perm32(R & 31)) : R;
        voffA[i] = (unsigned)(R * K + C) * 2u; voffB[i] = (unsigned)(Rb * K + C) * 2u; }
    const size_t kstep = (size_t)(BK * 2);
    const size_t hstep = (size_t)HALF * K * 2;
    const size_t tstep = 2 * hstep;
    const unsigned ldsw = (unsigned)wid * 1024u;
    const int aoff = lds_byte(wr * 64 + fr, fq * 8), boff = lds_byte(wc * 32 + fr, fq * 8);
#define PG8_SA(b, h) (((b) * 2 + (h)) * HTB)
#define PG8_SB(b, h) ((4 + (b) * 2 + (h)) * HTB)
#define PG8_STAGE(bufoff, gbase, voff) do { _Pragma("unroll") for (int _i = 0; _i < 2; ++_i) \
        __builtin_amdgcn_global_load_lds((const unsigned*)((const char*)(gbase) + (voff)[_i]), (PG8_LAS unsigned*)(lds + (bufoff) + ldsw + _i * 8192), 16, 0, 0); } while (0)
#define PG8_LDA(dst, b, h) do { _Pragma("unroll") for (int m = 0; m < 4; ++m) _Pragma("unroll") for (int k = 0; k < 2; ++k) dst[m][k] = *(const PG8_LAS bf16x8*)(lds + PG8_SA(b, h) + aoff + m * 2048 + k * 1024); } while (0)
#define PG8_LDB(dst, b, h) do { _Pragma("unroll") for (int n = 0; n < 2; ++n) _Pragma("unroll") for (int k = 0; k < 2; ++k) dst[n][k] = *(const PG8_LAS bf16x8*)(lds + PG8_SB(b, h) + boff + n * 2048 + k * 1024); } while (0)
#define PG8_MMA(ai, bj, At, Bt) do { __builtin_amdgcn_s_setprio(1); _Pragma("unroll") for (int m = 0; m < 4; ++m) _Pragma("unroll") for (int n = 0; n < 2; ++n) _Pragma("unroll") for (int k = 0; k < 2; ++k) \
        acc[ai][bj][m][n] = __builtin_amdgcn_mfma_f32_16x16x32_bf16(Bt[n][k], At[m][k], acc[ai][bj][m][n], 0, 0, 0); __builtin_amdgcn_s_setprio(0); } while (0)
#define PG8_WAIT_V(n) asm volatile("s_waitcnt vmcnt(" #n ")" ::: "memory")
#define PG8_WAIT_L(n) asm volatile("s_waitcnt lgkmcnt(" #n ")" ::: "memory")
#define PG8_BAR __builtin_amdgcn_s_barrier()
#define PG8_SCHED __builtin_amdgcn_sched_barrier(0)
    Unit cur, nxt; int ui = 0;
    if (!S.next(0, cur)) return;
    f32x4 acc[2][2][4][2];
#pragma unroll
    for (int a = 0; a < 2; ++a)
#pragma unroll
        for (int b = 0; b < 2; ++b)
#pragma unroll
            for (int m = 0; m < 4; ++m)
#pragma unroll
                for (int n = 0; n < 2; ++n) acc[a][b][m][n] = (f32x4){0.f, 0.f, 0.f, 0.f};
    bf16x8 At[4][2], B0[2][2], B1[2][2];
    const char* cA = (const char*)g.A + (size_t)cur.pm * tstep; const char* cB = (const char*)g.Bt + (size_t)cur.pn * tstep;
    S.a_ready(cur);
    if constexpr (SP2) {
        PG8_STAGE(PG8_SB(0, 0), cB, voffB); PG8_STAGE(PG8_SB(0, 1), cB + hstep, voffB); PG8_STAGE(PG8_SA(0, 0), cA, voffA); PG8_STAGE(PG8_SA(0, 1), cA + hstep, voffA);
        if (wr == 1) PG8_BAR;
        PG8_WAIT_V(2); PG8_BAR;
        PG8_STAGE(PG8_SB(1, 0), cB + kstep, voffB); PG8_STAGE(PG8_SA(1, 0), cA + kstep, voffA); PG8_STAGE(PG8_SB(1, 1), cB + hstep + kstep, voffB);
        PG8_WAIT_V(6); PG8_BAR;
    } else {
        PG8_STAGE(PG8_SB(0, 0), cB, voffB); PG8_STAGE(PG8_SA(0, 0), cA, voffA); PG8_STAGE(PG8_SB(0, 1), cB + hstep, voffB); PG8_STAGE(PG8_SA(0, 1), cA + hstep, voffA);
        if (wr == 1) PG8_BAR;
        PG8_WAIT_V(4); PG8_BAR;
        PG8_STAGE(PG8_SB(1, 0), cB + kstep, voffB); PG8_STAGE(PG8_SA(1, 0), cA + kstep, voffA); PG8_STAGE(PG8_SB(1, 1), cB + hstep + kstep, voffB);
        PG8_WAIT_V(6); PG8_BAR;
    }
    for (;;) {
        const bool has_next = S.next(ui + 1, nxt);
        const char* nA = has_next ? (const char*)g.A + (size_t)nxt.pm * tstep : cA; const char* nB = has_next ? (const char*)g.Bt + (size_t)nxt.pn * tstep : cB;
        for (int t = 0; t < nt; t += 2) {
            const bool last = (t == nt - 2);
            const char* a1 = cA + (size_t)(t + 1) * kstep;
            const char* a2 = last ? nA : cA + (size_t)(t + 2) * kstep; const char* b2 = last ? nB : cB + (size_t)(t + 2) * kstep;
            const char* a3 = a2 + kstep; const char* b3 = b2 + kstep;
            if (last && has_next) S.a_ready(nxt);
            if constexpr (SP2) {
            PG8_LDB(B0, 0, 0); PG8_LDB(B1, 0, 1); PG8_SCHED; PG8_LDA(At, 0, 0); PG8_STAGE(PG8_SA(1, 1), a1 + hstep, voffA);
            PG8_WAIT_V(8); PG8_WAIT_L(0); PG8_BAR; PG8_MMA(0, 0, At, B0); PG8_MMA(0, 1, At, B1); PG8_BAR; PG8_SCHED;
            PG8_LDA(At, 0, 1); PG8_STAGE(PG8_SB(0, 0), b2, voffB); PG8_STAGE(PG8_SB(0, 1), b2 + hstep, voffB); PG8_STAGE(PG8_SA(0, 0), a2, voffA);
            PG8_WAIT_V(8); PG8_WAIT_L(0); PG8_BAR; PG8_MMA(1, 0, At, B0); PG8_MMA(1, 1, At, B1); PG8_BAR; PG8_SCHED;
            PG8_LDB(B0, 1, 0); PG8_LDB(B1, 1, 1); PG8_SCHED; PG8_LDA(At, 1, 0); PG8_STAGE(PG8_SA(0, 1), a2 + hstep, voffA);
            PG8_WAIT_V(8); PG8_WAIT_L(0); PG8_BAR; PG8_MMA(0, 0, At, B0); PG8_MMA(0, 1, At, B1); PG8_BAR; PG8_SCHED;
            PG8_LDA(At, 1, 1); PG8_STAGE(PG8_SB(1, 0), b3, voffB); PG8_STAGE(PG8_SB(1, 1), b3 + hstep, voffB); PG8_STAGE(PG8_SA(1, 0), a3, voffA);
            PG8_WAIT_V(8); PG8_WAIT_L(0); PG8_BAR; PG8_MMA(1, 0, At, B0); PG8_MMA(1, 1, At, B1); PG8_BAR; PG8_SCHED;
            } else {
            PG8_LDB(B0, 0, 0); PG8_SCHED; PG8_LDA(At, 0, 0); PG8_STAGE(PG8_SA(1, 1), a1 + hstep, voffA);
            PG8_WAIT_L(8); PG8_BAR; PG8_WAIT_L(0); PG8_MMA(0, 0, At, B0); PG8_BAR; PG8_SCHED;
            PG8_LDB(B1, 0, 1); PG8_STAGE(PG8_SB(0, 0), b2, voffB);
            PG8_BAR; PG8_WAIT_L(0); PG8_MMA(0, 1, At, B1); PG8_BAR;
            PG8_LDA(At, 0, 1); PG8_STAGE(PG8_SA(0, 0), a2, voffA);
            PG8_BAR; PG8_WAIT_L(0); PG8_MMA(1, 0, At, B0); PG8_BAR; PG8_SCHED;
            PG8_STAGE(PG8_SB(0, 1), b2 + hstep, voffB);
            PG8_WAIT_V(6); PG8_BAR; PG8_MMA(1, 1, At, B1); PG8_BAR;
            PG8_LDB(B0, 1, 0); PG8_SCHED; PG8_LDA(At, 1, 0); PG8_STAGE(PG8_SA(0, 1), a2 + hstep, voffA);
            PG8_WAIT_L(8); PG8_BAR; PG8_WAIT_L(0); PG8_MMA(0, 0, At, B0); PG8_BAR; PG8_SCHED;
            PG8_LDB(B1, 1, 1); PG8_STAGE(PG8_SB(1, 0), b3, voffB);
            PG8_BAR; PG8_WAIT_L(0); PG8_MMA(0, 1, At, B1); PG8_BAR;
            PG8_LDA(At, 1, 1); PG8_STAGE(PG8_SA(1, 0), a3, voffA);
            PG8_BAR; PG8_WAIT_L(0); PG8_MMA(1, 0, At, B0); PG8_BAR; PG8_SCHED;
            PG8_STAGE(PG8_SB(1, 1), b3 + hstep, voffB);
            PG8_WAIT_V(6); PG8_BAR; PG8_MMA(1, 1, At, B1); PG8_BAR;
            }
        }
        if constexpr (ALIGN_EPI) { if (wr == 0) PG8_BAR; }
        if constexpr (!Epi::AFTER_DRAIN) { E(acc, cur, wr, wc, fr, fq); S.done(cur); }
        if (!has_next) break;
#pragma unroll
        for (int a = 0; a < 2; ++a)
#pragma unroll
            for (int b = 0; b < 2; ++b)
#pragma unroll
                for (int m = 0; m < 4; ++m)
#pragma unroll
                    for (int n = 0; n < 2; ++n) acc[a][b][m][n] = (f32x4){0.f, 0.f, 0.f, 0.f};
        cur = nxt; cA = nA; cB = nB; ++ui;
        if constexpr (ALIGN_EPI) { if (wr == 1) PG8_BAR; }
    }
    PG8_WAIT_V(0);
    if constexpr (!ALIGN_EPI) { if (wr == 0) PG8_BAR; }
    PG8_BAR;
    if constexpr (Epi::AFTER_DRAIN) { E.fused(acc, cur, wr, wc, fr, fq, lds, wid, lane); S.done(cur); }
#undef PG8_SA
#undef PG8_SB
#undef PG8_STAGE
#undef PG8_LDA
#undef PG8_LDB
#undef PG8_MMA
#undef PG8_WAIT_V
#undef PG8_WAIT_L
#undef PG8_BAR
#undef PG8_SCHED
}
}

#define LAS __attribute__((address_space(3)))
typedef unsigned short bf16_t;
typedef short bf16x8 __attribute__((ext_vector_type(8)));
typedef float f32x4 __attribute__((ext_vector_type(4)));
typedef float f32x16 __attribute__((ext_vector_type(16)));
typedef unsigned u32x4 __attribute__((ext_vector_type(4)));
typedef unsigned u32x2 __attribute__((ext_vector_type(2)));

constexpr int DM = 1024, NTOK_P = 16384, NTOK = 17408, DIN = 3080, NPROJ = 3072, DFF = 2816, NGU = 5632;
constexpr int NWAVES = 8, NTHR = 512;
constexpr int LDS_BYTES = 147456;
constexpr size_t MiB = 1u << 20;
constexpr size_t WS_CTL = 0, CTL_BYTES = 1 * MiB, WS_SS1 = 65536;
constexpr size_t WS_WIN = 1 * MiB, WS_WOUT = 7 * MiB, WS_WGU = 9 * MiB, WS_WDN = 20 * MiB;
constexpr size_t WS_RGW = 25 * MiB + 512 * 1024;
constexpr size_t WS_BETA = 26 * MiB, WS_G = 26 * MiB + 512 * 1024, WS_GL = 26 * MiB + 896 * 1024;
constexpr size_t WS_SEGA = 27 * MiB, WS_SEGH = 27 * MiB + 512 * 1024;
constexpr size_t WS_HN = 28 * MiB, WS_WF = 28 * MiB, WS_QDF = 44 * MiB, WS_X1B = 28 * MiB;
constexpr size_t WS_PROJ = 62 * MiB, WS_ACT = 62 * MiB;
constexpr size_t WS_MIX = 164 * MiB, WS_GA = 198 * MiB, WS_KTF = 214 * MiB, WS_QKF = 230 * MiB, WS_UB = 238 * MiB, WS_END = 254 * MiB;
constexpr size_t OUT_Y = 0, OUT_PRC = 17825792, OUT_PRH = 17838080, OUT_PGC = 17842176, OUT_PGS = 17879040,
                 OUT_SRC = 18403328, OUT_SRH = 18599936, OUT_SGC = 18665472, OUT_SGS = 19255296;

struct Params { const float* in[25]; float* out; unsigned char* ws; };
enum { I_XP = 0, I_XS, I_SRC, I_SRH, I_SGC, I_SGS, I_NORM1, I_WIN, I_RCW, I_RCB, I_RWA, I_RBA, I_RWI, I_RBI, I_LAM, I_GCW, I_ALOG, I_DTB, I_GNW, I_WOUT, I_NORM2, I_WG, I_WU, I_WD, I_FN };

#define DI __device__ __forceinline__
#define KAS __attribute__((address_space(4)))
DI Params load_params() {
#if defined(__HIP_DEVICE_COMPILE__)
    const KAS unsigned char* ka = (const KAS unsigned char*)__builtin_amdgcn_kernarg_segment_ptr(); asm volatile("" : "+s"(ka)); return *(const KAS Params*)ka;
#else
    return Params{};
#endif
}
template <class T> DI T vlaunder(T p) { asm volatile("" : "+v"(p)); return p; }
DI int tid_() { int t = threadIdx.x; asm volatile("" : "+v"(t)); return t; }
DI unsigned f2bf(float f) { unsigned u = __float_as_uint(f); return (u + 0x7fffu + ((u >> 16) & 1u)) >> 16; }
DI unsigned pk2(float lo, float hi) { return f2bf(lo) | (f2bf(hi) << 16); }
DI float bf2f(bf16_t b) { return __uint_as_float(((unsigned)b) << 16); }
DI float wave_sum(float v) {
#pragma unroll
    for (int o = 1; o < 64; o <<= 1) v += __shfl_xor(v, o);
    return v;
}
DI float sigm(float x) { return 1.f / (1.f + __expf(-x)); }
DI float silu(float x) { return x / (1.f + __expf(-x)); }
DI float softplus(float x) { return x > 20.f ? x : log1pf(__expf(x)); }
DI float gelu_tanh(float x) { const float u = 0.7978845608028654f * (x + 0.044715f * x * x * x); const float t = 1.f - 2.f / (1.f + __expf(2.f * u)); return 0.5f * x * (1.f + t); }
DI int crow(int reg, int hh) { return (reg & 3) + 8 * (reg >> 2) + 4 * hh; }
DI bf16x8 pack8(f32x4 a, f32x4 b) { u32x4 p; p.x = pk2(a.x, a.y); p.y = pk2(a.z, a.w); p.z = pk2(b.x, b.y); p.w = pk2(b.z, b.w); return __builtin_bit_cast(bf16x8, p); }
DI bf16x8 pack8v(const float* v) { u32x4 p; p.x = pk2(v[0], v[1]); p.y = pk2(v[2], v[3]); p.z = pk2(v[4], v[5]); p.w = pk2(v[6], v[7]); return __builtin_bit_cast(bf16x8, p); }
#define MFMA32(a, b, c) __builtin_amdgcn_mfma_f32_32x32x16_bf16((a), (b), (c), 0, 0, 0)
DI bf16x8 pack_step(const f32x16& x, int s) {
    u32x4 p;
    p.x = pk2(x[8 * s + 0], x[8 * s + 1]); p.y = pk2(x[8 * s + 2], x[8 * s + 3]); p.z = pk2(x[8 * s + 4], x[8 * s + 5]); p.w = pk2(x[8 * s + 6], x[8 * s + 7]);
    return __builtin_bit_cast(bf16x8, p);
}
DI f32x16 zero16() { f32x16 z;
#pragma unroll
    for (int i = 0; i < 16; ++i) z[i] = 0.f;
    return z; }

struct EpiProj {
    static constexpr bool PERM = true, AFTER_DRAIN = false;
    bf16_t* O; int ldc;
    DI void operator()(const f32x4 (&acc)[2][2][4][2], const pg8::Unit& u, int wr, int wc, int fr, int fq) const {
        const int row0 = u.pm * 256 + wr * 64 + fr, col0 = u.pn * 256 + wc * 32 + 8 * fq;
#pragma unroll
        for (int ai = 0; ai < 2; ++ai)
#pragma unroll
            for (int m = 0; m < 4; ++m) { bf16_t* rowp = O + (size_t)(row0 + ai * 128 + m * 16) * ldc + col0;
#pragma unroll
                for (int bj = 0; bj < 2; ++bj) { const f32x4 v0 = acc[ai][bj][m][0], v1 = acc[ai][bj][m][1];
                    u32x4 w; w.x = pg8::cvt_pk_bf16(v0[0], v0[1]); w.y = pg8::cvt_pk_bf16(v0[2], v0[3]); w.z = pg8::cvt_pk_bf16(v1[0], v1[1]); w.w = pg8::cvt_pk_bf16(v1[2], v1[3]);
                    *(u32x4*)(rowp + bj * 128) = w; } }
    }
};
struct EpiX1 {
    static constexpr bool PERM = false, AFTER_DRAIN = false;
    const float* xp; const float* xs; float* Y; bf16_t* X1B; float* SS1;
    DI void operator()(const f32x4 (&acc)[2][2][4][2], const pg8::Unit& u, int wr, int wc, int fr, int fq) const {
        const int row0 = u.pm * 256 + wr * 64 + fr, col0 = u.pn * 256 + wc * 32 + 4 * fq;
#pragma unroll
        for (int ai = 0; ai < 2; ++ai)
#pragma unroll
            for (int m = 0; m < 4; ++m) { const int row = row0 + ai * 128 + m * 16;
                const float* xin = (row < NTOK_P ? xp + (size_t)row * DM : xs + (size_t)(row - NTOK_P) * DM) + col0;
                float* yp = Y + (size_t)row * DM + col0; bf16_t* bp = X1B + (size_t)row * DM + col0; float ss = 0.f;
#pragma unroll
                for (int bj = 0; bj < 2; ++bj)
#pragma unroll
                    for (int n = 0; n < 2; ++n) { const f32x4 v = acc[ai][bj][m][n] + *(const f32x4*)(xin + bj * 128 + n * 16);
                        *(f32x4*)(yp + bj * 128 + n * 16) = v; u32x2 w; w.x = pg8::cvt_pk_bf16(v[0], v[1]); w.y = pg8::cvt_pk_bf16(v[2], v[3]);
                        *(u32x2*)(bp + bj * 128 + n * 16) = w; ss += (v[0] * v[0] + v[1] * v[1]) + (v[2] * v[2] + v[3] * v[3]); }
                ss += __shfl_xor(ss, 16); ss += __shfl_xor(ss, 32);
                if (fq == 0) atomicAdd(SS1 + row, ss); }
    }
};
struct EpiAct {
    static constexpr bool PERM = true, AFTER_DRAIN = false;
    bf16_t* ACT; const float* SS1;
    DI void operator()(const f32x4 (&acc)[2][2][4][2], const pg8::Unit& u, int wr, int wc, int fr, int fq) const {
        const int row0 = u.pm * 256 + wr * 64 + fr, col0 = u.pn * 256 + wc * 32 + 8 * fq;
#pragma unroll
        for (int ai = 0; ai < 2; ++ai)
#pragma unroll
            for (int m = 0; m < 4; ++m) { const int row = row0 + ai * 128 + m * 16; const float rstd = rsqrtf(SS1[row] * (1.f / DM) + 1e-6f);
                bf16_t* rowp = ACT + (size_t)row * DFF + (col0 >> 1);
#pragma unroll
                for (int bj = 0; bj < 2; ++bj) { const f32x4 v0 = acc[ai][bj][m][0] * rstd, v1 = acc[ai][bj][m][1] * rstd;
                    u32x2 w; w.x = pg8::cvt_pk_bf16(silu(v0[0]) * v0[1], silu(v0[2]) * v0[3]); w.y = pg8::cvt_pk_bf16(silu(v1[0]) * v1[1], silu(v1[2]) * v1[3]);
                    *(u32x2*)(rowp + bj * 64) = w; } }
    }
};
struct EpiX2 {
    static constexpr bool PERM = false, AFTER_DRAIN = false;
    float* Y;
    DI void operator()(const f32x4 (&acc)[2][2][4][2], const pg8::Unit& u, int wr, int wc, int fr, int fq) const {
        const int row0 = u.pm * 256 + wr * 64 + fr, col0 = u.pn * 256 + wc * 32 + 4 * fq;
#pragma unroll
        for (int ai = 0; ai < 2; ++ai)
#pragma unroll
            for (int m = 0; m < 4; ++m) { float* yp = Y + (size_t)(row0 + ai * 128 + m * 16) * DM + col0;
#pragma unroll
                for (int bj = 0; bj < 2; ++bj)
#pragma unroll
                    for (int n = 0; n < 2; ++n) { f32x4* p = (f32x4*)(yp + bj * 128 + n * 16); *p = *p + acc[ai][bj][m][n]; } }
    }
};

DI void p0_transpose_item(const float* W, int ldw, int nblk, int K, bf16_t* WT, int rmul, int radd, const float* ksc, LAS float* scr, int item, int lane) {
    const int kb = item / nblk, nb = item % nblk, k0 = 64 * kb, n0 = 32 * nb;
#pragma unroll 8
    for (int i = 0; i < 32; ++i) { const int kk = 2 * i + (lane >> 5); float v = W[(size_t)(k0 + kk) * ldw + n0 + (lane & 31)]; if (ksc) v *= ksc[k0 + kk]; scr[kk * 33 + (lane & 31)] = v; }
    asm volatile("s_waitcnt lgkmcnt(0)" ::: "memory");
    const int c = lane & 7;
#pragma unroll
    for (int j = 0; j < 4; ++j) { const int n = (lane >> 3) + 8 * j; const LAS float* s = scr + (8 * c) * 33 + n;
        u32x4 o; o.x = pk2(s[0 * 33], s[1 * 33]); o.y = pk2(s[2 * 33], s[3 * 33]); o.z = pk2(s[4 * 33], s[5 * 33]); o.w = pk2(s[6 * 33], s[7 * 33]);
        *(u32x4*)(WT + (size_t)((n0 + n) * rmul + radd) * K + k0 + 8 * c) = o; }
    asm volatile("s_waitcnt lgkmcnt(0)" ::: "memory");
}
DI void phase0(const Params& P, LAS unsigned char* lds) {
    const int tid = tid_(), lane = tid & 63, wave = tid >> 6, G = gridDim.x;
    unsigned char* ws = P.ws;
    LAS float* scr = (LAS float*)(lds + wave * 16384);
    const int gw = blockIdx.x * NWAVES + wave, NGW = G * NWAVES;
    constexpr int I_IN = 16 * 96, I_OUT = 16 * 32, I_G = 16 * 88, I_D = 44 * 32, NIT = I_IN + I_OUT + 2 * I_G + I_D;
    for (int it = gw; it < NIT; it += NGW) {
        int r = it;
        if (r < I_IN) { p0_transpose_item(P.in[I_WIN], DIN, 96, DM, (bf16_t*)(ws + WS_WIN), 1, 0, nullptr, scr, r, lane); continue; } r -= I_IN;
        if (r < I_OUT) { p0_transpose_item(P.in[I_WOUT], DM, 32, DM, (bf16_t*)(ws + WS_WOUT), 1, 0, nullptr, scr, r, lane); continue; } r -= I_OUT;
        if (r < I_G) { p0_transpose_item(P.in[I_WG], DFF, 88, DM, (bf16_t*)(ws + WS_WGU), 2, 0, P.in[I_NORM2], scr, r, lane); continue; } r -= I_G;
        if (r < I_G) { p0_transpose_item(P.in[I_WU], DFF, 88, DM, (bf16_t*)(ws + WS_WGU), 2, 1, P.in[I_NORM2], scr, r, lane); continue; } r -= I_G;
        p0_transpose_item(P.in[I_WD], DM, 32, DFF, (bf16_t*)(ws + WS_WDN), 1, 0, nullptr, scr, r, lane);
    }
    for (int s = blockIdx.x * NTHR + tid; s < 8192; s += G * NTHR) {
        const int l = s & 63, f = s >> 6, ks = f & 3, nt = (f >> 2) & 1, hb = (f >> 3) & 7, mat = f >> 6;
        const float* w = (mat ? P.in[I_RWI] : P.in[I_RWA]) + hb * 4096 + (16 * ks + 8 * (l >> 5)) * 64 + 32 * nt + (l & 31);
        u32x4 o; o.x = pk2(w[0], w[64]); o.y = pk2(w[128], w[192]); o.z = pk2(w[256], w[320]); o.w = pk2(w[384], w[448]);
        *(u32x4*)(ws + WS_RGW + (size_t)s * 16) = o;
    }
    __syncthreads();
    LAS float* EXT = (LAS float*)lds;
    for (int i = tid; i < 8192; i += NTHR) { const int k = i >> 3, c = i & 7, l = (k & 255) >> 2, q = k & 3, j = k >> 8;
        EXT[(((j * 4 + q) * 64 + l) << 3) + c] = P.in[I_WIN][(size_t)k * DIN + NPROJ + c]; }
    __syncthreads();
    const float* n1 = P.in[I_NORM1];
    f32x4 nw[4];
#pragma unroll
    for (int j = 0; j < 4; ++j) nw[j] = *(const f32x4*)(n1 + 4 * lane + 256 * j);
    for (int m = gw; m < NTOK; m += NGW) {
        const float* xrow = (m < NTOK_P) ? P.in[I_XP] + (size_t)m * DM : P.in[I_XS] + (size_t)(m - NTOK_P) * DM;
        f32x4 v[4]; float s = 0.f;
#pragma unroll
        for (int j = 0; j < 4; ++j) { v[j] = *(const f32x4*)(xrow + 4 * lane + 256 * j); s += (v[j].x * v[j].x + v[j].y * v[j].y) + (v[j].z * v[j].z + v[j].w * v[j].w); }
        const float rstd = rsqrtf(wave_sum(s) * (1.f / DM) + 1e-6f);
        float e[8];
#pragma unroll
        for (int c = 0; c < 8; ++c) e[c] = 0.f;
        bf16_t* orow = (bf16_t*)(ws + WS_HN) + (size_t)m * DM;
#pragma unroll
        for (int j = 0; j < 4; ++j) { v[j] = v[j] * rstd * nw[j];
            u32x2 w; w.x = pk2(v[j].x, v[j].y); w.y = pk2(v[j].z, v[j].w); *(u32x2*)(orow + 4 * lane + 256 * j) = w;
#pragma unroll
            for (int q = 0; q < 4; ++q) { const LAS f32x4* ep = (const LAS f32x4*)(EXT + (((j * 4 + q) * 64 + lane) << 3)); const f32x4 e0 = ep[0], e1 = ep[1]; const float hv = v[j][q];
                e[0] += hv * e0.x; e[1] += hv * e0.y; e[2] += hv * e0.z; e[3] += hv * e0.w; e[4] += hv * e1.x; e[5] += hv * e1.y; e[6] += hv * e1.z; e[7] += hv * e1.w; } }
#pragma unroll
        for (int c = 0; c < 8; ++c) e[c] = wave_sum(e[c]);
        if (lane < 4) { float sv = lane == 0 ? e[0] : lane == 1 ? e[1] : lane == 2 ? e[2] : e[3]; ((float*)(ws + WS_BETA))[m * 4 + lane] = sigm(sv); }
        else if (lane < 8) { const int hh = lane - 4; float sv = hh == 0 ? e[4] : hh == 1 ? e[5] : hh == 2 ? e[6] : e[7];
            ((float*)(ws + WS_G))[m * 4 + hh] = -__expf(P.in[I_ALOG][hh]) * softplus(sv + P.in[I_DTB][hh]); }
    }
}

DI void gdn_chunk_item(const Params& P, LAS unsigned char* lds, int item) {
    const int tid = tid_(), lane = tid & 63, wave = tid >> 6;
    const int h = item & 3, bn = item >> 2, b = bn >> 5, n = bn & 31;
    const int m0 = b * 2048 + n * 64, cid = (b * 4 + h) * 32 + n;
    unsigned char* ws = P.ws;
    LAS float* QT = (LAS float*)lds; LAS float* KT = QT + 64 * 132; LAS float* VT = KT + 64 * 132;
    LAS float* LM = VT + 64 * 132; LAS float* QKM = LM + 64 * 68; LAS float* SM = QKM + 64 * 68;
    const bf16_t* PROJ = (const bf16_t*)(ws + WS_PROJ);
    {
        const int d = tid & 127, tg = tid >> 7;
        const float* cw = P.in[I_GCW];
#pragma unroll 1
        for (int mat = 0; mat < 3; ++mat) {
            const int ch = mat * 512 + h * 128 + d;
            const float w0 = cw[ch], w1 = cw[1536 + ch], w2 = cw[3072 + ch], w3 = cw[4608 + ch];
            const bf16_t* src = PROJ + (size_t)(m0 + 16 * tg) * NPROJ + 1024 + ch;
            float x3 = 0.f, x2 = 0.f, x1 = 0.f;
            if (n > 0 || tg > 0) { x3 = bf2f(src[-3 * NPROJ]); x2 = bf2f(src[-2 * NPROJ]); x1 = bf2f(src[-NPROJ]); }
            LAS float* T = QT + mat * (64 * 132);
#pragma unroll 4
            for (int i = 0; i < 16; ++i) {
                const float x0 = bf2f(src[i * NPROJ]);
                const float y = w0 * x3 + w1 * x2 + w2 * x1 + w3 * x0;
                T[(16 * tg + i) * 132 + d] = silu(y);
                if (n == 31 && tg == 3 && i >= 13) P.out[OUT_PGC + (size_t)(b * 3 + (i - 13)) * 1536 + ch] = x0;
                x3 = x2; x2 = x1; x1 = x0;
            }
        }
    }
    if (tid < 64) {
        SM[128 + tid] = ((const float*)(ws + WS_BETA))[(m0 + tid) * 4 + h];
        float g = ((const float*)(ws + WS_G))[(m0 + tid) * 4 + h];
#pragma unroll
        for (int o = 1; o < 64; o <<= 1) { const float t = __shfl_up(g, o); if (lane >= o) g += t; }
        SM[tid] = g; SM[64 + tid] = __expf(g);
    }
    __syncthreads();
#pragma unroll 1
    for (int k = 0; k < 8; ++k) {
        const int i = 8 * wave + k;
        const float q0 = QT[i * 132 + lane], q1 = QT[i * 132 + 64 + lane], k0 = KT[i * 132 + lane], k1 = KT[i * 132 + 64 + lane];
        const float rq = rsqrtf(wave_sum(q0 * q0 + q1 * q1) + 1e-6f) * 0.08838834764831845f, rk = rsqrtf(wave_sum(k0 * k0 + k1 * k1) + 1e-6f);
        QT[i * 132 + lane] = q0 * rq; QT[i * 132 + 64 + lane] = q1 * rq; KT[i * 132 + lane] = k0 * rk; KT[i * 132 + 64 + lane] = k1 * rk;
    }
    __syncthreads();
    {
        const int which = wave >> 2, it = (wave >> 1) & 1, jt = wave & 1, r = lane & 31, hh = lane >> 5;
        LAS float* dst = which ? QKM : LM;
        f32x16 acc = zero16();
        if (!(it == 0 && jt == 1)) {
            const LAS float* Ar = (which ? QT : KT) + (32 * it + r) * 132 + 8 * hh;
            const LAS float* Br = KT + (32 * jt + r) * 132 + 8 * hh;
#pragma unroll
            for (int ks = 0; ks < 8; ++ks) {
                const bf16x8 a = pack8(*(const LAS f32x4*)(Ar + 16 * ks), *(const LAS f32x4*)(Ar + 16 * ks + 4));
                const bf16x8 bb = pack8(*(const LAS f32x4*)(Br + 16 * ks), *(const LAS f32x4*)(Br + 16 * ks + 4));
                acc = MFMA32(a, bb, acc);
            }
        }
        const int j = 32 * jt + r; const float gcj = SM[j];
#pragma unroll
        for (int reg = 0; reg < 16; ++reg) {
            const int i = 32 * it + crow(reg, hh); const float gci = SM[i];
            float v = 0.f;
            if (which == 0) { if (j < i) v = acc[reg] * SM[128 + i] * __expf(gci - gcj); }
            else { if (j <= i) v = acc[reg] * __expf(gci - gcj); }
            dst[i * 68 + j] = v;
        }
    }
    __syncthreads();
    {
        const float gcl = SM[63];
        bf16_t* QDF = (bf16_t*)(ws + WS_QDF) + (size_t)cid * 8192; bf16_t* KTF = (bf16_t*)(ws + WS_KTF) + (size_t)cid * 8192; bf16_t* QKF = (bf16_t*)(ws + WS_QKF) + (size_t)cid * 4096;
#pragma unroll 1
        for (int s = tid; s < 2560; s += NTHR) {
            const int l = s & 63, r = l & 31, hh = l >> 5, f = s >> 6;
            float v[8];
            if (f < 16) { const int mt = f >> 3, kk = f & 7, c = 32 * mt + r, db = 16 * kk + 4 * hh; const float sc = SM[64 + c];
#pragma unroll
                for (int e = 0; e < 8; ++e) v[e] = QT[c * 132 + db + 8 * (e >> 2) + (e & 3)] * sc;
                *(bf16x8*)(QDF + f * 512 + l * 8) = pack8v(v);
            } else if (f < 32) { const int f2 = f - 16, dmt = f2 >> 2, ks = f2 & 3, d = 32 * dmt + r, cb = 16 * ks + 4 * hh;
#pragma unroll
                for (int e = 0; e < 8; ++e) { const int c = cb + 8 * (e >> 2) + (e & 3); v[e] = KT[c * 132 + d] * __expf(gcl - SM[c]); }
                *(bf16x8*)(KTF + f2 * 512 + l * 8) = pack8v(v);
            } else { const int f3 = f - 32, mt = f3 >> 2, ks = f3 & 3, i = 32 * mt + r, cb = 16 * ks + 4 * hh;
#pragma unroll
                for (int e = 0; e < 8; ++e) v[e] = QKM[i * 68 + cb + 8 * (e >> 2) + (e & 3)];
                *(bf16x8*)(QKF + f3 * 512 + l * 8) = pack8v(v);
            }
        }
        if (tid == 0) ((float*)(ws + WS_GL))[cid] = __expf(gcl);
    }
    __syncthreads();
    if (tid < 256) {
        const bool isw = tid >= 128; const int ci = tid & 127;
        LAS float* Tc = vlaunder((isw ? KT : VT) + ci);
        const LAS float* LMv = vlaunder(LM); const LAS float* SMv = vlaunder(SM);
        float x[64];
#pragma unroll
        for (int i = 0; i < 64; ++i) {
            float rhs = Tc[i * 132] * SMv[128 + i]; if (isw) rhs *= SMv[64 + i];
            float a0 = rhs, a1 = 0.f, a2 = 0.f, a3 = 0.f;
#pragma unroll
            for (int j4 = 0; j4 < (i + 3) / 4; ++j4) { const f32x4 l4 = *(const LAS f32x4*)(LMv + i * 68 + 4 * j4);
                if (4 * j4 + 0 < i) a0 -= l4.x * x[4 * j4 + 0]; if (4 * j4 + 1 < i) a1 -= l4.y * x[4 * j4 + 1];
                if (4 * j4 + 2 < i) a2 -= l4.z * x[4 * j4 + 2]; if (4 * j4 + 3 < i) a3 -= l4.w * x[4 * j4 + 3]; }
            x[i] = (a0 + a1) + (a2 + a3); Tc[i * 132] = x[i];
        }
    }
    __syncthreads();
    {
        bf16_t* WF = (bf16_t*)(ws + WS_WF) + (size_t)cid * 8192; bf16_t* UB = (bf16_t*)(ws + WS_UB) + (size_t)cid * 8192;
#pragma unroll 1
        for (int s = tid; s < 2048; s += NTHR) {
            float v[8];
            if (s < 1024) { const int l = s & 63, r = l & 31, hh = l >> 5, f = s >> 6, mt = f >> 3, kk = f & 7, c = 32 * mt + r, db = 16 * kk + 4 * hh;
#pragma unroll
                for (int e = 0; e < 8; ++e) v[e] = -KT[c * 132 + db + 8 * (e >> 2) + (e & 3)];
                *(bf16x8*)(WF + f * 512 + l * 8) = pack8v(v);
            } else { const int s2 = s - 1024, c = s2 >> 4, e0 = (s2 & 15) * 8;
#pragma unroll
                for (int e = 0; e < 8; ++e) v[e] = VT[c * 132 + e0 + e];
                *(bf16x8*)(UB + c * 128 + e0) = pack8v(v);
            }
        }
    }
    __syncthreads();
}

DI void rg_tile_item(const Params& P, LAS unsigned char* lds, int T) {
    const int tid = tid_(), lane = tid & 63, wave = tid >> 6, r = lane & 31, hh = lane >> 5;
    unsigned char* ws = P.ws;
    LAS bf16_t* XC = (LAS bf16_t*)lds + wave * (64 * 72);
    const bf16_t* PROJ = (const bf16_t*)(ws + WS_PROJ);
    const int m0 = 64 * T; const bool prm = T < 256; const int sq0 = prm ? 0 : (m0 - NTOK_P) / 8;
    {
        const int c = 64 * wave + lane;
        const float* cw = P.in[I_RCW]; const float w0 = cw[c], w1 = cw[512 + c], w2 = cw[1024 + c], w3 = cw[1536 + c], cb = P.in[I_RCB][c];
        const bf16_t* src = PROJ + (size_t)m0 * NPROJ + c;
        float x3 = 0.f, x2 = 0.f, x1 = 0.f;
        if (prm && (T & 31) != 0) { x3 = bf2f(src[-3 * NPROJ]); x2 = bf2f(src[-2 * NPROJ]); x1 = bf2f(src[-NPROJ]); }
        const float* rcs = P.in[I_SRC];
#pragma unroll 4
        for (int i = 0; i < 64; ++i) {
            const int seq = sq0 + (i >> 3);
            if (!prm && (i & 7) == 0) { x3 = rcs[(size_t)(seq * 3 + 0) * 512 + c]; x2 = rcs[(size_t)(seq * 3 + 1) * 512 + c]; x1 = rcs[(size_t)(seq * 3 + 2) * 512 + c]; }
            const float x0 = bf2f(src[i * NPROJ]);
            XC[i * 72 + lane] = (bf16_t)f2bf(w0 * x3 + w1 * x2 + w2 * x1 + w3 * x0 + cb);
            if (prm) { if ((T & 31) == 31 && i >= 61) P.out[OUT_PRC + (size_t)((T >> 5) * 3 + (i - 61)) * 512 + c] = x0; }
            else { if ((i & 7) >= 5) P.out[OUT_SRC + (size_t)(seq * 3 + (i & 7) - 5) * 512 + c] = x0; }
            x3 = x2; x2 = x1; x1 = x0;
        }
    }
    asm volatile("s_waitcnt lgkmcnt(0)" ::: "memory");
    const bf16x8* RGW = (const bf16x8*)(ws + WS_RGW);
#pragma unroll 1
    for (int nt = 0; nt < 2; ++nt) {
        f32x16 aa[2], ai[2]; aa[0] = zero16(); aa[1] = zero16(); ai[0] = zero16(); ai[1] = zero16();
#pragma unroll
        for (int ks = 0; ks < 4; ++ks) {
            const bf16x8 bfa = RGW[(((0 * 8 + wave) * 2 + nt) * 4 + ks) * 64 + lane], bfi = RGW[(((1 * 8 + wave) * 2 + nt) * 4 + ks) * 64 + lane];
#pragma unroll
            for (int mt = 0; mt < 2; ++mt) { const bf16x8 a = *(const LAS bf16x8*)(XC + (32 * mt + r) * 72 + 16 * ks + 8 * hh);
                aa[mt] = MFMA32(a, bfa, aa[mt]); ai[mt] = MFMA32(a, bfi, ai[mt]); }
        }
        const int j = 64 * wave + 32 * nt + r;
        const float ba = P.in[I_RBA][j], bi = P.in[I_RBI][j], spl = -8.f * softplus(-P.in[I_LAM][j]);
        float Cc = 0.f, Pp = 1.f;
        const bf16_t* projb = PROJ + (size_t)(m0 + 4 * hh) * NPROJ + 512 + j;
        bf16_t* mixb = (bf16_t*)(ws + WS_MIX) + (size_t)(m0 + 4 * hh) * DM + j;
        bf16_t* gab = (bf16_t*)(ws + WS_GA) + (size_t)(m0 + 4 * hh) * 512 + j;
#pragma unroll
        for (int Gi = 0; Gi < 8; ++Gi) {
            const int mt = Gi >> 2, g = Gi & 3;
            const bf16_t* pb = vlaunder(projb); bf16_t* mb = vlaunder(mixb); bf16_t* gb = vlaunder(gab);
            float Hl[4], Ac[4];
#pragma unroll
            for (int k = 0; k < 4; ++k) { const int reg = 4 * g + k, t = 32 * mt + 8 * g + 4 * hh + k;
                const float rg_ = sigm(aa[mt][reg] + ba), ig = sigm(ai[mt][reg] + bi), la = spl * rg_, a = __expf(la), mult = sqrtf(-expm1f(2.f * la));
                const float u = mult * ig * bf2f(XC[t * 72 + 32 * nt + r]);
                if (k == 0) { Hl[0] = u; Ac[0] = a; } else { Hl[k] = a * Hl[k - 1] + u; Ac[k] = a * Ac[k - 1]; } }
            const float Ag = Ac[3], Hg = Hl[3], pA = __shfl_xor(Ag, 32), pH = __shfl_xor(Hg, 32);
            const int seq = sq0 + Gi;
            if (!prm) { Cc = P.in[I_SRH][(size_t)seq * 512 + j]; Pp = 1.f; }
            float cin, pin, Cn, Pn;
            if (hh == 0) { cin = Cc; pin = Pp; Cn = pA * (Ag * Cc + Hg) + pH; Pn = Pp * Ag * pA; }
            else { cin = pA * Cc + pH; pin = Pp * pA; Cn = Ag * cin + Hg; Pn = Pp * pA * Ag; }
#pragma unroll
            for (int k = 0; k < 4; ++k) { const int tt = 32 * mt + 8 * g + k;
                const float hv = Hl[k] + Ac[k] * cin, gy = gelu_tanh(bf2f(pb[(size_t)tt * NPROJ]));
                mb[(size_t)tt * DM] = (bf16_t)f2bf(gy * hv);
                if (prm) gb[(size_t)tt * 512] = (bf16_t)f2bf(gy * Ac[k] * pin);
                else if (hh == 1 && k == 3) P.out[OUT_SRH + (size_t)seq * 512 + j] = hv; }
            Cc = Cn; Pp = Pn;
            asm volatile("" ::: "memory"); __builtin_amdgcn_sched_barrier(0);
        }
        if (prm && hh == 0) { ((float*)(ws + WS_SEGA))[T * 512 + j] = Pp; ((float*)(ws + WS_SEGH))[T * 512 + j] = Cc; }
    }
    asm volatile("s_waitcnt lgkmcnt(0)" ::: "memory");
}

DI void gdn_seq_block(const Params& P, LAS unsigned char* lds, int bh) {
    const int tid = tid_(), lane = tid & 63, wave = tid >> 6, r = lane & 31, hh = lane >> 5;
    const int b = bh >> 2, h = bh & 3;
    unsigned char* ws = P.ws;
    LAS float* OB = (LAS float*)lds;
    const bf16_t* PROJ = (const bf16_t*)(ws + WS_PROJ);
    f32x16 S[4]; S[0] = zero16(); S[1] = zero16(); S[2] = zero16(); S[3] = zero16();
    const int e0 = 32 * (wave & 3);
#pragma unroll 1
    for (int n = 0; n <= 32; ++n) {
        if (wave < 4 && n < 32) {
            const int cid = bh * 32 + n;
            const bf16x8* WF = (const bf16x8*)(ws + WS_WF) + (size_t)cid * 1024 + lane; const bf16x8* QDF = (const bf16x8*)(ws + WS_QDF) + (size_t)cid * 1024 + lane;
            const bf16x8* KTF = (const bf16x8*)(ws + WS_KTF) + (size_t)cid * 1024 + lane; const bf16x8* QKF = (const bf16x8*)(ws + WS_QKF) + (size_t)cid * 512 + lane;
            const bf16_t* UB = (const bf16_t*)(ws + WS_UB) + (size_t)cid * 8192;
            const float gl = ((const float*)(ws + WS_GL))[cid];
            bf16x8 Sb[8];
#pragma unroll
            for (int dt = 0; dt < 4; ++dt) { Sb[2 * dt] = pack_step(S[dt], 0); Sb[2 * dt + 1] = pack_step(S[dt], 1); }
            f32x16 vacc[2], oacc[2];
#pragma unroll
            for (int mt = 0; mt < 2; ++mt) {
#pragma unroll
                for (int reg = 0; reg < 16; ++reg) vacc[mt][reg] = bf2f(UB[(32 * mt + crow(reg, hh)) * 128 + e0 + r]);
                oacc[mt] = zero16();
            }
#pragma unroll
            for (int mt = 0; mt < 2; ++mt)
#pragma unroll
                for (int kk = 0; kk < 8; ++kk) { vacc[mt] = MFMA32(WF[(mt * 8 + kk) * 64], Sb[kk], vacc[mt]); oacc[mt] = MFMA32(QDF[(mt * 8 + kk) * 64], Sb[kk], oacc[mt]); }
            bf16x8 vb[4];
#pragma unroll
            for (int ct = 0; ct < 2; ++ct) { vb[2 * ct] = pack_step(vacc[ct], 0); vb[2 * ct + 1] = pack_step(vacc[ct], 1); }
#pragma unroll
            for (int mt = 0; mt < 2; ++mt)
#pragma unroll
                for (int ks = 0; ks < 4; ++ks) oacc[mt] = MFMA32(QKF[(mt * 4 + ks) * 64], vb[ks], oacc[mt]);
#pragma unroll
            for (int dt = 0; dt < 4; ++dt) { S[dt] = S[dt] * gl;
#pragma unroll
                for (int ks = 0; ks < 4; ++ks) S[dt] = MFMA32(KTF[(dt * 4 + ks) * 64], vb[ks], S[dt]); }
            LAS float* ob = OB + (n & 1) * (64 * 132);
#pragma unroll
            for (int mt = 0; mt < 2; ++mt)
#pragma unroll
                for (int reg = 0; reg < 16; ++reg) ob[(32 * mt + crow(reg, hh)) * 132 + e0 + r] = oacc[mt][reg];
        }
        if (wave >= 4 && n >= 1) {
            const LAS float* ob = OB + ((n - 1) & 1) * (64 * 132);
            const int mb = b * 2048 + (n - 1) * 64;
            const float gw0 = P.in[I_GNW][lane], gw1 = P.in[I_GNW][lane + 64];
#pragma unroll 4
            for (int k = 0; k < 16; ++k) { const int c = 16 * (wave - 4) + k; const size_t m = mb + c;
                const float o0 = ob[c * 132 + lane], o1 = ob[c * 132 + 64 + lane];
                const float rstd = rsqrtf(wave_sum(o0 * o0 + o1 * o1) * (1.f / 128.f) + 1e-6f);
                const float z0 = bf2f(PROJ[m * NPROJ + 2560 + 128 * h + lane]), z1 = bf2f(PROJ[m * NPROJ + 2560 + 128 * h + 64 + lane]);
                bf16_t* mp = (bf16_t*)(ws + WS_MIX) + m * DM + 512 + 128 * h;
                mp[lane] = (bf16_t)f2bf(o0 * rstd * gw0 * silu(z0)); mp[lane + 64] = (bf16_t)f2bf(o1 * rstd * gw1 * silu(z1)); }
        }
        __syncthreads();
    }
    if (wave < 4) {
#pragma unroll
        for (int dt = 0; dt < 4; ++dt)
#pragma unroll
            for (int reg = 0; reg < 16; ++reg) P.out[OUT_PGS + ((size_t)bh * 128 + 32 * dt + crow(reg, hh)) * 128 + e0 + r] = S[dt][reg];
    }
}

DI void gdn_sample_item(const Params& P, LAS unsigned char* lds, int s, int h) {
    const int tid = tid_(), lane = tid & 63, wave = tid >> 6;
    unsigned char* ws = P.ws;
    LAS float* Q = (LAS float*)lds; LAS float* K = Q + 1024; LAS float* V = K + 1024; LAS float* Uu = V + 1024; LAS float* Ww = Uu + 1024; LAS float* Oo = Ww + 1024;
    LAS float* RED = Oo + 1024;
    LAS float* SMs = RED + 8192;
    const bf16_t* PROJ = (const bf16_t*)(ws + WS_PROJ);
    const int m0 = NTOK_P + 8 * s;
    if (tid < 384) {
        const int mat = tid >> 7, d = tid & 127, ch = mat * 512 + h * 128 + d;
        const float* cw = P.in[I_GCW]; const float w0 = cw[ch], w1 = cw[1536 + ch], w2 = cw[3072 + ch], w3 = cw[4608 + ch];
        const float* st = P.in[I_SGC] + (size_t)s * 3 * 1536 + ch;
        float x3 = st[0], x2 = st[1536], x1 = st[3072];
        LAS float* T = Q + mat * 1024;
#pragma unroll
        for (int t = 0; t < 8; ++t) { const float x0 = bf2f(PROJ[(size_t)(m0 + t) * NPROJ + 1024 + ch]);
            T[t * 128 + d] = silu(w0 * x3 + w1 * x2 + w2 * x1 + w3 * x0);
            if (t >= 5) P.out[OUT_SGC + (size_t)(s * 3 + t - 5) * 1536 + ch] = x0;
            x3 = x2; x2 = x1; x1 = x0; }
    }
    if (tid == 511) { float acc = 0.f;
        for (int t = 0; t < 8; ++t) { acc += ((const float*)(ws + WS_G))[(m0 + t) * 4 + h]; SMs[t] = acc; SMs[8 + t] = __expf(acc); SMs[16 + t] = ((const float*)(ws + WS_BETA))[(m0 + t) * 4 + h]; }
        for (int t = 0; t < 8; ++t) SMs[24 + t] = __expf(acc - SMs[t]); }
    __syncthreads();
    {   const int i = wave;
        const float q0 = Q[i * 128 + lane], q1 = Q[i * 128 + 64 + lane], k0 = K[i * 128 + lane], k1 = K[i * 128 + 64 + lane];
        const float rq = rsqrtf(wave_sum(q0 * q0 + q1 * q1) + 1e-6f) * 0.08838834764831845f, rk = rsqrtf(wave_sum(k0 * k0 + k1 * k1) + 1e-6f);
        Q[i * 128 + lane] = q0 * rq; Q[i * 128 + 64 + lane] = q1 * rq; K[i * 128 + lane] = k0 * rk; K[i * 128 + 64 + lane] = k1 * rk; }
    __syncthreads();
    if (tid < 128) { const int which = tid >> 6, i = (tid >> 3) & 7, j = tid & 7;
        const LAS float* a = (which ? Q : K) + i * 128; const LAS float* bq = K + j * 128; float dot = 0.f;
        for (int d = 0; d < 128; ++d) dot += a[d] * bq[d];
        const float dec = __expf(SMs[i] - SMs[j]);
        if (which == 0) SMs[32 + i * 8 + j] = (j < i) ? dot * SMs[16 + i] * dec : 0.f;
        else SMs[96 + i * 8 + j] = (j <= i) ? dot * dec : 0.f; }
    __syncthreads();
    if (tid < 256) { const bool isw = tid >= 128; const int ci = tid & 127; float x[8];
#pragma unroll
        for (int i = 0; i < 8; ++i) { float acc = (isw ? K : V)[i * 128 + ci] * SMs[16 + i]; if (isw) acc *= SMs[8 + i];
#pragma unroll
            for (int j = 0; j < 8; ++j) if (j < i) acc -= SMs[32 + i * 8 + j] * x[j];
            x[i] = acc; (isw ? Ww : Uu)[i * 128 + ci] = acc; } }
    __syncthreads();
    {   const int e = tid & 127, dq = tid >> 7;
        const float* S0 = P.in[I_SGS] + ((size_t)(s * 4 + h) * 128 + 32 * dq) * 128 + e;
        float Sr[32];
#pragma unroll
        for (int k = 0; k < 32; ++k) Sr[k] = S0[(size_t)k * 128];
        float pv[8], po[8];
#pragma unroll
        for (int c = 0; c < 8; ++c) { pv[c] = 0.f; po[c] = 0.f; }
#pragma unroll
        for (int k = 0; k < 32; ++k) { const int d = 32 * dq + k;
#pragma unroll
            for (int c = 0; c < 8; ++c) { pv[c] += Ww[c * 128 + d] * Sr[k]; po[c] += Q[c * 128 + d] * Sr[k]; } }
#pragma unroll
        for (int c = 0; c < 8; ++c) { RED[(dq * 16 + c) * 128 + e] = pv[c]; RED[(dq * 16 + 8 + c) * 128 + e] = po[c] * SMs[8 + c]; }
        __syncthreads();
        float vn[8];
#pragma unroll
        for (int c = 0; c < 8; ++c) vn[c] = Uu[c * 128 + e] - ((RED[(0 * 16 + c) * 128 + e] + RED[(1 * 16 + c) * 128 + e]) + (RED[(2 * 16 + c) * 128 + e] + RED[(3 * 16 + c) * 128 + e]));
        const float gl = SMs[15];
        float* So = P.out + OUT_SGS + ((size_t)(s * 4 + h) * 128 + 32 * dq) * 128 + e;
#pragma unroll
        for (int k = 0; k < 32; ++k) { const int d = 32 * dq + k; float acc = Sr[k] * gl;
#pragma unroll
            for (int c = 0; c < 8; ++c) acc += K[c * 128 + d] * SMs[24 + c] * vn[c];
            So[(size_t)k * 128] = acc; }
        if (dq == 0) {
#pragma unroll
            for (int c = 0; c < 8; ++c) { float o = (RED[(0 * 16 + 8 + c) * 128 + e] + RED[(1 * 16 + 8 + c) * 128 + e]) + (RED[(2 * 16 + 8 + c) * 128 + e] + RED[(3 * 16 + 8 + c) * 128 + e]);
#pragma unroll
                for (int j = 0; j < 8; ++j) if (j <= c) o += SMs[96 + c * 8 + j] * vn[j];
                Oo[c * 128 + e] = o; } }
    }
    __syncthreads();
    {   const int c = wave; const size_t m = m0 + c;
        const float o0 = Oo[c * 128 + lane], o1 = Oo[c * 128 + 64 + lane];
        const float rstd = rsqrtf(wave_sum(o0 * o0 + o1 * o1) * (1.f / 128.f) + 1e-6f);
        const float z0 = bf2f(PROJ[m * NPROJ + 2560 + 128 * h + lane]), z1 = bf2f(PROJ[m * NPROJ + 2560 + 128 * h + 64 + lane]);
        bf16_t* mp = (bf16_t*)(ws + WS_MIX) + m * DM + 512 + 128 * h;
        mp[lane] = (bf16_t)f2bf(o0 * rstd * P.in[I_GNW][lane] * silu(z0)); mp[lane + 64] = (bf16_t)f2bf(o1 * rstd * P.in[I_GNW][lane + 64] * silu(z1)); }
    __syncthreads();
}

DI void rg_fix_item(const Params& P, int b, int n) {
    const int c = tid_(); unsigned char* ws = P.ws;
    const float* SA = (const float*)(ws + WS_SEGA); const float* SH = (const float*)(ws + WS_SEGH);
    float Cc = 0.f;
    for (int j = 0; j < n; ++j) { const int Tj = b * 32 + j; Cc = SA[Tj * 512 + c] * Cc + SH[Tj * 512 + c]; }
    bf16_t* MIX = (bf16_t*)(ws + WS_MIX); const bf16_t* GA = (const bf16_t*)(ws + WS_GA);
    const size_t mb = (size_t)b * 2048 + 64 * n;
#pragma unroll 8
    for (int i = 0; i < 64; ++i) { const size_t m = mb + i; MIX[m * DM + c] = (bf16_t)f2bf(bf2f(MIX[m * DM + c]) + bf2f(GA[m * 512 + c]) * Cc); }
    if (n == 31) { const int Tj = b * 32 + 31; P.out[OUT_PRH + (size_t)b * 512 + c] = SA[Tj * 512 + c] * Cc + SH[Tj * 512 + c]; }
}

__global__ void __launch_bounds__(NTHR, 2) hybrid_fwd(Params Pk) {
    extern __shared__ __attribute__((aligned(16))) unsigned char lds_raw[];
    LAS unsigned char* lds = (LAS unsigned char*)lds_raw;
    cg::grid_group grid = cg::this_grid();
    const int G = gridDim.x;

    { const Params P = load_params(); phase0(P, lds); }
    grid.sync();
    {   const Params P = load_params(); unsigned char* ws = P.ws;
        pg8::Gemm g{(const bf16_t*)(ws + WS_HN), (const bf16_t*)(ws + WS_WIN), NTOK, NPROJ, DM}; pg8::StaticOrder S; S.init(NTOK, NPROJ, G, (int)blockIdx.x);
        EpiProj E{(bf16_t*)(ws + WS_PROJ), NPROJ};
        pg8::gemm_phase<EpiProj, pg8::StaticOrder, true, true>(lds, g, S, E); }
    grid.sync();
    for (int it = blockIdx.x; it < 1024; it += G) { const Params P = load_params(); gdn_chunk_item(P, lds, it); }
    for (int it = blockIdx.x; it < 272; it += G) { const Params P = load_params(); rg_tile_item(P, lds, it); __syncthreads(); }
    grid.sync();
    if (blockIdx.x < 32) { const Params P = load_params(); gdn_seq_block(P, lds, blockIdx.x); }
    else {
        for (int it = blockIdx.x - 32; it < 512; it += G - 32) { const Params P = load_params(); gdn_sample_item(P, lds, it >> 2, it & 3); }
        for (int q = blockIdx.x - 32; q < 248; q += G - 32) { const Params P = load_params(); rg_fix_item(P, q / 31, 1 + q % 31); }
    }
    grid.sync();
    {   const Params P = load_params(); unsigned char* ws = P.ws;
        pg8::Gemm g{(const bf16_t*)(ws + WS_MIX), (const bf16_t*)(ws + WS_WOUT), NTOK, DM, DM}; pg8::StaticOrder S; S.init(NTOK, DM, G, (int)blockIdx.x);
        EpiX1 E{P.in[I_XP], P.in[I_XS], P.out + OUT_Y, (bf16_t*)(ws + WS_X1B), (float*)(ws + WS_SS1)};
        pg8::gemm_phase<EpiX1, pg8::StaticOrder, true, true>(lds, g, S, E); }
    grid.sync();
    {   const Params P = load_params(); unsigned char* ws = P.ws;
        pg8::Gemm g{(const bf16_t*)(ws + WS_X1B), (const bf16_t*)(ws + WS_WGU), NTOK, NGU, DM}; pg8::StaticOrder S; S.init(NTOK, NGU, G, (int)blockIdx.x);
        EpiAct E{(bf16_t*)(ws + WS_ACT), (const float*)(ws + WS_SS1)};
        pg8::gemm_phase<EpiAct, pg8::StaticOrder, true, true>(lds, g, S, E); }
    grid.sync();
    {   const Params P = load_params(); unsigned char* ws = P.ws;
        pg8::Gemm g{(const bf16_t*)(ws + WS_ACT), (const bf16_t*)(ws + WS_WDN), NTOK, DM, DFF}; pg8::StaticOrder S; S.init(NTOK, DM, G, (int)blockIdx.x);
        EpiX2 E{P.out + OUT_Y};
        pg8::gemm_phase<EpiX2, pg8::StaticOrder, true, true>(lds, g, S, E); }
    grid.sync();
    {
        const Params P = load_params();
        const int tid = tid_(), lane = tid & 63, wave = tid >> 6; const float* fw = P.in[I_FN];
        f32x4 nw[4];
#pragma unroll
        for (int j = 0; j < 4; ++j) nw[j] = *(const f32x4*)(fw + 4 * lane + 256 * j);
        for (int m = blockIdx.x * NWAVES + wave; m < NTOK; m += G * NWAVES) {
            float* row = P.out + OUT_Y + (size_t)m * DM; f32x4 v[4]; float s = 0.f;
#pragma unroll
            for (int j = 0; j < 4; ++j) { v[j] = *(const f32x4*)(row + 4 * lane + 256 * j); s += (v[j].x * v[j].x + v[j].y * v[j].y) + (v[j].z * v[j].z + v[j].w * v[j].w); }
            const float rstd = rsqrtf(wave_sum(s) * (1.f / DM) + 1e-6f);
#pragma unroll
            for (int j = 0; j < 4; ++j) *(f32x4*)(row + 4 * lane + 256 * j) = v[j] * rstd * nw[j];
        }
    }
}

extern "C" void kernel_launch(void* const* d_in, const int* in_sizes, int n_in, void* d_out, int out_size, void* d_ws, size_t ws_size, hipStream_t stream) {
    static int grid = 0;
    if (grid == 0) {
        int dev = 0, cus = 0, per_cu = 0;
        if (n_in != 25 || ws_size < WS_END) { fprintf(stderr, "kernel_launch: unexpected n_in %d / ws_size %zu\n", n_in, ws_size); grid = -1; return; }
        hipGetDevice(&dev); hipDeviceGetAttribute(&cus, hipDeviceAttributeMultiprocessorCount, dev);
        hipFuncSetAttribute((const void*)hybrid_fwd, hipFuncAttributeMaxDynamicSharedMemorySize, LDS_BYTES);
        hipOccupancyMaxActiveBlocksPerMultiprocessor(&per_cu, (const void*)hybrid_fwd, NTHR, LDS_BYTES);
        (void)hipGetLastError();
        if (per_cu < 1) { fprintf(stderr, "kernel_launch: occupancy query says %d blocks per CU\n", per_cu); per_cu = 1; }
        grid = cus;
        if (grid > 256) grid = 256;
    }
    if (grid < 0) return;
    hipMemsetAsync((char*)d_ws + WS_CTL, 0, CTL_BYTES, stream);
    Params p{};
    for (int i = 0; i < 25; ++i) p.in[i] = (const float*)d_in[i];
    p.out = (float*)d_out; p.ws = (unsigned char*)d_ws;
    void* args[] = {&p};
    hipError_t e = hipLaunchCooperativeKernel((const void*)hybrid_fwd, dim3(grid), dim3(NTHR), args, LDS_BYTES, stream);
    if (e != hipSuccess) fprintf(stderr, "cooperative launch failed: %s (grid %d)\n", hipGetErrorString(e), grid);
}
```

```cpp
#include <hip/hip_runtime.h>
#include <hip/hip_cooperative_groups.h>
#include <cstdio>
#include <cstdint>
namespace cg = cooperative_groups;
namespace pg8 {
#define PG8_LAS __attribute__((address_space(3)))
typedef unsigned short bf16_t;
typedef short bf16x8 __attribute__((ext_vector_type(8)));
typedef float f32x4 __attribute__((ext_vector_type(4)));
typedef unsigned u32x4 __attribute__((ext_vector_type(4)));
constexpr int BM = 256, BK = 64, HALF = 128, HTB = HALF * BK * 2  , STAGE_BYTES = 8 * HTB, NXCD = 8, WGM = 8;

__host__ __device__ __forceinline__ int lds_byte(int r, int c) { const int st = (r >> 4) * 2 + (c >> 5), rr = r & 15, cc = c & 31, ob = rr * 64 + cc * 2; return st * 1024 + (ob ^ (((ob >> 9) & 1) << 5)); }
__host__ __device__ __forceinline__ void stage_rc(int b, int& R, int& C) { const int st = b / 1024, sb = b % 1024, swz = sb ^ (((sb >> 9) & 1) << 5); R = (st >> 1) * 16 + swz / 64; C = (st & 1) * 32 + (swz % 64) / 2; }
__host__ __device__ __forceinline__ int perm32(int rho) { const int n = rho >> 4, i = rho & 15; return 8 * (i >> 2) + 4 * n + (i & 3); }

struct Unit { int pm, pn; };
struct Gemm { const bf16_t* A; const bf16_t* Bt; int M, N, K; };

struct StaticOrder {
    int nM, nN, nwg, G, c;
    __host__ __device__ void init(int M, int N, int G_, int c_) { nM = M / BM; nN = N / BM; nwg = nM * nN; G = G_; c = c_; }
    __host__ __device__ bool next(int i, Unit& u) const {
        const long L = (long)i * G + c; if (L >= nwg) return false;
        int wgid = (int)L; { const int q = nwg / NXCD, r = nwg % NXCD, xcd = wgid % NXCD, off = wgid / NXCD; wgid = (xcd < r ? xcd * (q + 1) : r * (q + 1) + (xcd - r) * q) + off; }
        const int nig = WGM * nN, gid = wgid / nig, fm = gid * WGM, gsz = (nM - fm) < WGM ? (nM - fm) : WGM;
        u.pm = fm + ((wgid % nig) % gsz); u.pn = (wgid % nig) / gsz; return true;
    }
    __device__ __forceinline__ void a_ready(const Unit&) const {}
    __device__ __forceinline__ void done(const Unit&) const {}
};
__device__ __forceinline__ unsigned cvt_pk_bf16(float lo, float hi) { unsigned r; asm volatile("v_cvt_pk_bf16_f32 %0, %1, %2" : "=v"(r) : "v"(lo), "v"(hi)); return r; }
template <class Epi, class Sched, bool ALIGN_EPI = false, bool SP2 = false>
__device__ __forceinline__ void gemm_phase(PG8_LAS unsigned char* lds, const Gemm g, const Sched& S, const Epi& E) {
    int tid = threadIdx.x; asm volatile("" : "+v"(tid)); const int wid = __builtin_amdgcn_readfirstlane(tid >> 6), lane = tid & 63, wr = wid >> 2, wc = wid & 3, fr = lane & 15, fq = lane >> 4;
    const int K = g.K, nt = K / BK;
    unsigned voffA[2], voffB[2];
#pragma unroll
    for (int i = 0; i < 2; ++i) { int R, C; stage_rc(tid * 16 + i * 8192, R, C); const int Rb = Epi::PERM ? ((R & ~31) + perm32(R & 31)) : R;
        voffA[i] = (unsigned)(R * K + C) * 2u; voffB[i] = (unsigned)(Rb * K + C) * 2u; }
    const size_t kstep = (size_t)(BK * 2);
    const size_t hstep = (size_t)HALF * K * 2;
    const size_t tstep = 2 * hstep;
    const unsigned ldsw = (unsigned)wid * 1024u;
    const int aoff = lds_byte(wr * 64 + fr, fq * 8), boff = lds_byte(wc * 32 + fr, fq * 8);
#define PG8_SA(b, h) (((b) * 2 + (h)) * HTB)
#define PG8_SB(b, h) ((4 + (b) * 2 + (h)) * HTB)
#define PG8_STAGE(bufoff, gbase, voff) do { _Pragma("unroll") for (int _i = 0; _i < 2; ++_i) \
        __builtin_amdgcn_global_load_lds((const unsigned*)((const char*)(gbase) + (voff)[_i]), (PG8_LAS unsigned*)(lds + (bufoff) + ldsw + _i * 8192), 16, 0, 0); } while (0)
#define PG8_LDA(dst, b, h) do { _Pragma("unroll") for (int m = 0; m < 4; ++m) _Pragma("unroll") for (int k = 0; k < 2; ++k) dst[m][k] = *(const PG8_LAS bf16x8*)(lds + PG8_SA(b, h) + aoff + m * 2048 + k * 1024); } while (0)
#define PG8_LDB(dst, b, h) do { _Pragma("unroll") for (int n = 0; n < 2; ++n) _Pragma("unroll") for (int k = 0; k < 2; ++k) dst[n][k] = *(const PG8_LAS bf16x8*)(lds + PG8_SB(b, h) + boff + n * 2048 + k * 1024); } while (0)
#define PG8_MMA(ai, bj, At, Bt) do { __builtin_amdgcn_s_setprio(1); _Pragma("unroll") for (int m = 0; m < 4; ++m) _Pragma("unroll") for (int n = 0; n < 2; ++n) _Pragma("unroll") for (int k = 0; k < 2; ++k) \
        acc[ai][bj][m][n] = __builtin_amdgcn_mfma_f32_16x16x32_bf16(Bt[n][k], At[m][k], acc[ai][bj][m][n], 0, 0, 0); __builtin_amdgcn_s_setprio(0); } while (0)
#define PG8_WAIT_V(n) asm volatile("s_waitcnt vmcnt(" #n ")" ::: "memory")
#define PG8_WAIT_L(n) asm volatile("s_waitcnt lgkmcnt(" #n ")" ::: "memory")
#define PG8_BAR __builtin_amdgcn_s_barrier()
#define PG8_SCHED __builtin_amdgcn_sched_barrier(0)
    Unit cur, nxt; int ui = 0;
    if (!S.next(0, cur)) return;
    f32x4 acc[2][2][4][2];
#pragma unroll
    for (int a = 0; a < 2; ++a)
#pragma unroll
        for (int b = 0; b < 2; ++b)
#pragma unroll
            for (int m = 0; m < 4; ++m)
#pragma unroll
                for (int n = 0; n < 2; ++n) acc[a][b][m][n] = (f32x4){0.f, 0.f, 0.f, 0.f};
    bf16x8 At[4][2], B0[2][2], B1[2][2];
    const char* cA = (const char*)g.A + (size_t)cur.pm * tstep; const char* cB = (const char*)g.Bt + (size_t)cur.pn * tstep;
    S.a_ready(cur);
    if constexpr (SP2) {
        PG8_STAGE(PG8_SB(0, 0), cB, voffB); PG8_STAGE(PG8_SB(0, 1), cB + hstep, voffB); PG8_STAGE(PG8_SA(0, 0), cA, voffA); PG8_STAGE(PG8_SA(0, 1), cA + hstep, voffA);
        if (wr == 1) PG8_BAR;
        PG8_WAIT_V(2); PG8_BAR;
        PG8_STAGE(PG8_SB(1, 0), cB + kstep, voffB); PG8_STAGE(PG8_SA(1, 0), cA + kstep, voffA); PG8_STAGE(PG8_SB(1, 1), cB + hstep + kstep, voffB);
        PG8_WAIT_V(6); PG8_BAR;
    } else {
        PG8_STAGE(PG8_SB(0, 0), cB, voffB); PG8_STAGE(PG8_SA(0, 0), cA, voffA); PG8_STAGE(PG8_SB(0, 1), cB + hstep, voffB); PG8_STAGE(PG8_SA(0, 1), cA + hstep, voffA);
        if (wr == 1) PG8_BAR;
        PG8_WAIT_V(4); PG8_BAR;
        PG8_STAGE(PG8_SB(1, 0), cB + kstep, voffB); PG8_STAGE(PG8_SA(1, 0), cA + kstep, voffA); PG8_STAGE(PG8_SB(1, 1), cB + hstep + kstep, voffB);
        PG8_WAIT_V(6); PG8_BAR;
    }
    for (;;) {
        const bool has_next = S.next(ui + 1, nxt);
        const char* nA = has_next ? (const char*)g.A + (size_t)nxt.pm * tstep : cA; const char* nB = has_next ? (const char*)g.Bt + (size_t)nxt.pn * tstep : cB;
        for (int t = 0; t < nt; t += 2) {
            const bool last = (t == nt - 2);
            const char* a1 = cA + (size_t)(t + 1) * kstep;
            const char* a2 = last ? nA : cA + (size_t)(t + 2) * kstep; const char* b2 = last ? nB : cB + (size_t)(t + 2) * kstep;
            const char* a3 = a2 + kstep; const char* b3 = b2 + kstep;
            if (last && has_next) S.a_ready(nxt);
            if constexpr (SP2) {
            PG8_LDB(B0, 0, 0); PG8_LDB(B1, 0, 1); PG8_SCHED; PG8_LDA(At, 0, 0); PG8_STAGE(PG8_SA(1, 1), a1 + hstep, voffA);
            PG8_WAIT_V(8); PG8_WAIT_L(0); PG8_BAR; PG8_MMA(0, 0, At, B0); PG8_MMA(0, 1, At, B1); PG8_BAR; PG8_SCHED;
            PG8_LDA(At, 0, 1); PG8_STAGE(PG8_SB(0, 0), b2, voffB); PG8_STAGE(PG8_SB(0, 1), b2 + hstep, voffB); PG8_STAGE(PG8_SA(0, 0), a2, voffA);
            PG8_WAIT_V(8); PG8_WAIT_L(0); PG8_BAR; PG8_MMA(1, 0, At, B0); PG8_MMA(1, 1, At, B1); PG8_BAR; PG8_SCHED;
            PG8_LDB(B0, 1, 0); PG8_LDB(B1, 1, 1); PG8_SCHED; PG8_LDA(At, 1, 0); PG8_STAGE(PG8_SA(0, 1), a2 + hstep, voffA);
            PG8_WAIT_V(8); PG8_WAIT_L(0); PG8_BAR; PG8_MMA(0, 0, At, B0); PG8_MMA(0, 1, At, B1); PG8_BAR; PG8_SCHED;
            PG8_LDA(At, 1, 1); PG8_STAGE(PG8_SB(1, 0), b3, voffB); PG8_STAGE(PG8_SB(1, 1), b3 + hstep, voffB); PG8_STAGE(PG8_SA(1, 0), a3, voffA);
            PG8_WAIT_V(8); PG8_WAIT_L(0); PG8_BAR; PG8_MMA(1, 0, At, B0); PG8_MMA(1, 1, At, B1); PG8_BAR; PG8_SCHED;
            } else {
            PG8_LDB(B0, 0, 0); PG8_SCHED; PG8_LDA(At, 0, 0); PG8_STAGE(PG8_SA(1, 1), a1 + hstep, voffA);
            PG8_WAIT_L(8); PG8_BAR; PG8_WAIT_L(0); PG8_MMA(0, 0, At, B0); PG8_BAR; PG8_SCHED;
            PG8_LDB(B1, 0, 1); PG8_STAGE(PG8_SB(0, 0), b2, voffB);
            PG8_BAR; PG8_WAIT_L(0); PG8_MMA(0, 1, At, B1); PG8_BAR;
            PG8_LDA(At, 0, 1); PG8_STAGE(PG8_SA(0, 0), a2, voffA);
            PG8_BAR; PG8_WAIT_L(0); PG8_MMA(1, 0, At, B0); PG8_BAR; PG8_SCHED;
            PG8_STAGE(PG8_SB(0, 1), b2 + hstep, voffB);
            PG8_WAIT_V(6); PG8_BAR; PG8_MMA(1, 1, At, B1); PG8_BAR;
            PG8_LDB(B0, 1, 0); PG8_SCHED; PG8_LDA(At, 1, 0); PG8_STAGE(PG8_SA(0, 1), a2 + hstep, voffA);
            PG8_WAIT_L(8); PG8_BAR; PG8_WAIT_L(0); PG8_MMA(0, 0, At, B0); PG8_BAR; PG8_SCHED;
            PG8_LDB(B1, 1, 1); PG8_STAGE(PG8_SB(1, 0), b3, voffB);
            PG8_BAR; PG8_WAIT_L(0); PG8_MMA(0, 1, At, B1); PG8_BAR;
            PG8_LDA(At, 1, 1); PG8_STAGE(PG8_SA(1, 0), a3, voffA);
            PG8_BAR; PG8_WAIT_L(0); PG8_MMA(1, 0, At, B0); PG8_BAR; PG8_SCHED;
            PG8_STAGE(PG8_SB(1, 1), b3 + hstep, voffB);
            PG8_WAIT_V(6); PG8_BAR; PG8_MMA(1, 1, At, B1); PG8_BAR;
            }
        }
        if constexpr (ALIGN_EPI) { if (wr == 0) PG8_BAR; }
        if constexpr (!Epi::AFTER_DRAIN) { E(acc, cur, wr, wc, fr, fq); S.done(cur); }
        if (!has_next) break;
#pragma unroll
        for (int a = 0; a < 2; ++a)
#pragma unroll
            for (int b = 0; b < 2; ++b)
#pragma unroll
                for (int m = 0; m < 4; ++m)
#pragma unroll
                    for (int n = 0; n < 2; ++n) acc[a][b][m][n] = (f32x4){0.f, 0.f, 0.f, 0.f};
        cur = nxt; cA = nA; cB = nB; ++ui;
        if constexpr (ALIGN_EPI) { if (wr == 1) PG8_BAR; }
    }
    PG8_WAIT_V(0);
    if constexpr (!ALIGN_EPI) { if (wr == 0) PG8_BAR; }
    PG8_BAR;
    if constexpr (Epi::AFTER_DRAIN) { E.fused(acc, cur, wr, wc, fr, fq, lds, wid, lane); S.done(cur); }
#undef PG8_SA
#undef PG8_SB
#undef PG8_STAGE
#undef PG8_LDA
#undef PG8_LDB
#undef PG8_MMA
#undef PG8_WAIT_V
#undef PG8_WAIT_L
#undef PG8_BAR
#undef PG8_SCHED
}
}

#define LAS __attribute__((address_space(3)))
typedef unsigned short bf16_t;
typedef short bf16x8 __attribute__((ext_vector_type(8)));
typedef float f32x4 __attribute__((ext_vector_type(4)));
typedef float f32x16 __attribute__((ext_vector_type(16)));
typedef unsigned u32x4 __attribute__((ext_vector_type(4)));
typedef unsigned u32x2 __attribute__((ext_vector_type(2)));

#define XB_TMO      128
#define XB_XCNT(j)  (256  + 64 * (j))
#define XB_XSUB(j)  (1280 + 64 * (j))
#define XB_XGEN(j)  (2304 + 64 * (j))
#define XB_TOP      3328
#define XB_TOPGEN   3392
#define XCD_BAR_WORDS 3456
#define XB_SPIN_CAP (1u << 18)

__device__ __forceinline__ unsigned xb_ld(unsigned* p)              { return __hip_atomic_load(p, __ATOMIC_RELAXED, __HIP_MEMORY_SCOPE_AGENT); }
__device__ __forceinline__ unsigned xb_add(unsigned* p, unsigned v) { return __hip_atomic_fetch_add(p, v, __ATOMIC_RELAXED, __HIP_MEMORY_SCOPE_AGENT); }
__device__ __forceinline__ unsigned xb_xcc_id() { return (unsigned)__builtin_amdgcn_s_getreg((3 << 11) | 20) & 0xFu; }
#define XB_SPIN(cond, bar) do { unsigned _sp = 0; while (cond) { __builtin_amdgcn_s_sleep(1); \
    if ((++_sp & 255u) == 0u) { if (xb_ld(&(bar)[XB_TMO])) break; if (_sp > XB_SPIN_CAP) { atomicAdd(&(bar)[XB_TMO], 1u); break; } } } } while (0)

struct XcdBarrier {
    unsigned* bar; unsigned x;
    volatile LAS unsigned* st;
};

__device__ __forceinline__ XcdBarrier xcd_barrier_post(unsigned* bar, volatile LAS unsigned* st) {
    XcdBarrier b; b.bar = bar; b.x = xb_xcc_id(); b.st = st;
    if (threadIdx.x == 0) (void)xb_add(&bar[XB_XCNT(b.x)], 1u);
    return b;
}
__device__ __forceinline__ void xcd_barrier_complete(unsigned* bar, unsigned x, unsigned& nloc, unsigned& nx) {
    const unsigned G = gridDim.x * gridDim.y * gridDim.z;
    unsigned sum, cnt, mine, sp = 0u;
    for (;;) {
        sum = 0u; cnt = 0u; mine = 0u;
#pragma unroll
        for (unsigned j = 0; j < 16; ++j) { const unsigned c = xb_ld(&bar[XB_XCNT(j)]); sum += c; cnt += (c > 0u) ? 1u : 0u; mine = (j == x) ? c : mine; }
        if (sum == G) break;
        __builtin_amdgcn_s_sleep(1);
        if ((++sp & 255u) == 0u) { if (xb_ld(&bar[XB_TMO])) break; if (sp > XB_SPIN_CAP) { atomicAdd(&bar[XB_TMO], 1u); break; } }
    }
    nloc = mine > 0u ? mine : 1u; nx = cnt > 0u ? cnt : 1u;
}

__device__ __forceinline__ void xcd_barrier(const XcdBarrier& b) {
    asm volatile("s_waitcnt vmcnt(0)" ::: "memory");
    __syncthreads();
    if (threadIdx.x == 0) {
        unsigned* bar = b.bar;
        __builtin_amdgcn_s_waitcnt(0);
        unsigned nloc = b.st[0], nx = b.st[1];
        if (nloc == 0u) { xcd_barrier_complete(bar, b.x, nloc, nx); b.st[0] = nloc; b.st[1] = nx; }
        const unsigned old = xb_add(&bar[XB_XSUB(b.x)], 1u);
        const unsigned gen = old / nloc;
        if (old + 1u == (gen + 1u) * nloc) {
            __builtin_amdgcn_fence(__ATOMIC_RELEASE, "agent");
            asm volatile("s_waitcnt vmcnt(0)" ::: "memory");
            const unsigned og = xb_add(&bar[XB_TOP], 1u);
            const unsigned tg = og / nx;
            if (og + 1u == (tg + 1u) * nx) xb_add(&bar[XB_TOPGEN], 1u);
            else XB_SPIN(xb_ld(&bar[XB_TOPGEN]) == tg, bar);
            __builtin_amdgcn_fence(__ATOMIC_ACQUIRE, "agent");
            xb_add(&bar[XB_XGEN(b.x)], 1u);
            asm volatile("s_waitcnt vmcnt(0)" ::: "memory");
        } else {
            XB_SPIN(xb_ld(&bar[XB_XGEN(b.x)]) == gen, bar);
            __builtin_amdgcn_fence(__ATOMIC_ACQUIRE, "agent");
            asm volatile("s_waitcnt vmcnt(0)" ::: "memory");
        }
    }
    __syncthreads();
}


constexpr int DM = 1024, NTOK_P = 16384, NTOK = 17408, DIN = 3080, NPROJ = 3072, DFF = 2816, NGU = 5632;
constexpr int NWAVES = 8, NTHR = 512;
constexpr int LDS_BYTES = 147456;
constexpr size_t MiB = 1u << 20;
constexpr size_t WS_CTL = 0, CTL_BYTES = 1 * MiB, WS_SS1 = 65536;
constexpr size_t WS_WIN = 1 * MiB, WS_WOUT = 7 * MiB, WS_WGU = 9 * MiB, WS_WDN = 20 * MiB;
constexpr size_t WS_RGW = 25 * MiB + 512 * 1024;
constexpr size_t WS_BETA = 26 * MiB, WS_G = 26 * MiB + 512 * 1024, WS_GL = 26 * MiB + 896 * 1024;
constexpr size_t WS_SEGA = 27 * MiB, WS_SEGH = 27 * MiB + 512 * 1024;
constexpr size_t WS_HN = 28 * MiB, WS_WF = 28 * MiB, WS_QDF = 44 * MiB, WS_X1B = 28 * MiB;
constexpr size_t WS_PROJ = 62 * MiB, WS_ACT = 62 * MiB;
constexpr size_t WS_MIX = 164 * MiB, WS_GA = 198 * MiB, WS_KTF = 214 * MiB, WS_QKF = 230 * MiB, WS_UB = 238 * MiB, WS_END = 254 * MiB;
constexpr size_t OUT_Y = 0, OUT_PRC = 17825792, OUT_PRH = 17838080, OUT_PGC = 17842176, OUT_PGS = 17879040,
                 OUT_SRC = 18403328, OUT_SRH = 18599936, OUT_SGC = 18665472, OUT_SGS = 19255296;

struct Params { const float* in[25]; float* out; unsigned char* ws; };
enum { I_XP = 0, I_XS, I_SRC, I_SRH, I_SGC, I_SGS, I_NORM1, I_WIN, I_RCW, I_RCB, I_RWA, I_RBA, I_RWI, I_RBI, I_LAM, I_GCW, I_ALOG, I_DTB, I_GNW, I_WOUT, I_NORM2, I_WG, I_WU, I_WD, I_FN };

#define DI __device__ __forceinline__
#define KAS __attribute__((address_space(4)))
DI Params load_params() {
#if defined(__HIP_DEVICE_COMPILE__)
    const KAS unsigned char* ka = (const KAS unsigned char*)__builtin_amdgcn_kernarg_segment_ptr(); asm volatile("" : "+s"(ka)); return *(const KAS Params*)ka;
#else
    return Params{};
#endif
}
template <class T> DI T vlaunder(T p) { asm volatile("" : "+v"(p)); return p; }
DI int tid_() { int t = threadIdx.x; asm volatile("" : "+v"(t)); return t; }
DI unsigned f2bf(float f) { unsigned u = __float_as_uint(f); return (u + 0x7fffu + ((u >> 16) & 1u)) >> 16; }
DI unsigned pk2(float lo, float hi) { return f2bf(lo) | (f2bf(hi) << 16); }
DI float bf2f(bf16_t b) { return __uint_as_float(((unsigned)b) << 16); }
DI float wave_sum(float v) {
#pragma unroll
    for (int o = 1; o < 64; o <<= 1) v += __shfl_xor(v, o);
    return v;
}
DI float sigm(float x) { return 1.f / (1.f + __expf(-x)); }
DI float silu(float x) { return x / (1.f + __expf(-x)); }
DI float softplus(float x) { return x > 20.f ? x : log1pf(__expf(x)); }
DI float gelu_tanh(float x) { const float u = 0.7978845608028654f * (x + 0.044715f * x * x * x); const float t = 1.f - 2.f / (1.f + __expf(2.f * u)); return 0.5f * x * (1.f + t); }
DI int crow(int reg, int hh) { return (reg & 3) + 8 * (reg >> 2) + 4 * hh; }
DI bf16x8 pack8(f32x4 a, f32x4 b) { u32x4 p; p.x = pk2(a.x, a.y); p.y = pk2(a.z, a.w); p.z = pk2(b.x, b.y); p.w = pk2(b.z, b.w); return __builtin_bit_cast(bf16x8, p); }
DI bf16x8 pack8v(const float* v) { u32x4 p; p.x = pk2(v[0], v[1]); p.y = pk2(v[2], v[3]); p.z = pk2(v[4], v[5]); p.w = pk2(v[6], v[7]); return __builtin_bit_cast(bf16x8, p); }
#define MFMA32(a, b, c) __builtin_amdgcn_mfma_f32_32x32x16_bf16((a), (b), (c), 0, 0, 0)
DI bf16x8 pack_step(const f32x16& x, int s) {
    u32x4 p;
    p.x = pk2(x[8 * s + 0], x[8 * s + 1]); p.y = pk2(x[8 * s + 2], x[8 * s + 3]); p.z = pk2(x[8 * s + 4], x[8 * s + 5]); p.w = pk2(x[8 * s + 6], x[8 * s + 7]);
    return __builtin_bit_cast(bf16x8, p);
}
DI f32x16 zero16() { f32x16 z;
#pragma unroll
    for (int i = 0; i < 16; ++i) z[i] = 0.f;
    return z; }

struct EpiProj {
    static constexpr bool PERM = true, AFTER_DRAIN = false;
    bf16_t* O; int ldc;
    DI void operator()(const f32x4 (&acc)[2][2][4][2], const pg8::Unit& u, int wr, int wc, int fr, int fq) const {
        const int row0 = u.pm * 256 + wr * 64 + fr, col0 = u.pn * 256 + wc * 32 + 8 * fq;
#pragma unroll
        for (int ai = 0; ai < 2; ++ai)
#pragma unroll
            for (int m = 0; m < 4; ++m) { bf16_t* rowp = O + (size_t)(row0 + ai * 128 + m * 16) * ldc + col0;
#pragma unroll
                for (int bj = 0; bj < 2; ++bj) { const f32x4 v0 = acc[ai][bj][m][0], v1 = acc[ai][bj][m][1];
                    u32x4 w; w.x = pg8::cvt_pk_bf16(v0[0], v0[1]); w.y = pg8::cvt_pk_bf16(v0[2], v0[3]); w.z = pg8::cvt_pk_bf16(v1[0], v1[1]); w.w = pg8::cvt_pk_bf16(v1[2], v1[3]);
                    *(u32x4*)(rowp + bj * 128) = w; } }
    }
};
struct EpiX1 {
    static constexpr bool PERM = false, AFTER_DRAIN = false;
    const float* xp; const float* xs; float* Y; bf16_t* X1B; float* SS1;
    DI void operator()(const f32x4 (&acc)[2][2][4][2], const pg8::Unit& u, int wr, int wc, int fr, int fq) const {
        const int row0 = u.pm * 256 + wr * 64 + fr, col0 = u.pn * 256 + wc * 32 + 4 * fq;
#pragma unroll
        for (int ai = 0; ai < 2; ++ai)
#pragma unroll
            for (int m = 0; m < 4; ++m) { const int row = row0 + ai * 128 + m * 16;
                const float* xin = (row < NTOK_P ? xp + (size_t)row * DM : xs + (size_t)(row - NTOK_P) * DM) + col0;
                float* yp = Y + (size_t)row * DM + col0; bf16_t* bp = X1B + (size_t)row * DM + col0; float ss = 0.f;
#pragma unroll
                for (int bj = 0; bj < 2; ++bj)
#pragma unroll
                    for (int n = 0; n < 2; ++n) { const f32x4 v = acc[ai][bj][m][n] + *(const f32x4*)(xin + bj * 128 + n * 16);
                        *(f32x4*)(yp + bj * 128 + n * 16) = v; u32x2 w; w.x = pg8::cvt_pk_bf16(v[0], v[1]); w.y = pg8::cvt_pk_bf16(v[2], v[3]);
                        *(u32x2*)(bp + bj * 128 + n * 16) = w; ss += (v[0] * v[0] + v[1] * v[1]) + (v[2] * v[2] + v[3] * v[3]); }
                ss += __shfl_xor(ss, 16); ss += __shfl_xor(ss, 32);
                if (fq == 0) atomicAdd(SS1 + row, ss); }
    }
};
struct EpiAct {
    static constexpr bool PERM = true, AFTER_DRAIN = false;
    bf16_t* ACT; const float* SS1;
    DI void operator()(const f32x4 (&acc)[2][2][4][2], const pg8::Unit& u, int wr, int wc, int fr, int fq) const {
        const int row0 = u.pm * 256 + wr * 64 + fr, col0 = u.pn * 256 + wc * 32 + 8 * fq;
#pragma unroll
        for (int ai = 0; ai < 2; ++ai)
#pragma unroll
            for (int m = 0; m < 4; ++m) { const int row = row0 + ai * 128 + m * 16; const float rstd = rsqrtf(SS1[row] * (1.f / DM) + 1e-6f);
                bf16_t* rowp = ACT + (size_t)row * DFF + (col0 >> 1);
#pragma unroll
                for (int bj = 0; bj < 2; ++bj) { const f32x4 v0 = acc[ai][bj][m][0] * rstd, v1 = acc[ai][bj][m][1] * rstd;
                    u32x2 w; w.x = pg8::cvt_pk_bf16(silu(v0[0]) * v0[1], silu(v0[2]) * v0[3]); w.y = pg8::cvt_pk_bf16(silu(v1[0]) * v1[1], silu(v1[2]) * v1[3]);
                    *(u32x2*)(rowp + bj * 64) = w; } }
    }
};
struct EpiX2 {
    static constexpr bool PERM = false, AFTER_DRAIN = false;
    float* Y;
    DI void operator()(const f32x4 (&acc)[2][2][4][2], const pg8::Unit& u, int wr, int wc, int fr, int fq) const {
        const int row0 = u.pm * 256 + wr * 64 + fr, col0 = u.pn * 256 + wc * 32 + 4 * fq;
#pragma unroll
        for (int ai = 0; ai < 2; ++ai)
#pragma unroll
            for (int m = 0; m < 4; ++m) { float* yp = Y + (size_t)(row0 + ai * 128 + m * 16) * DM + col0;
#pragma unroll
                for (int bj = 0; bj < 2; ++bj)
#pragma unroll
                    for (int n = 0; n < 2; ++n) { f32x4* p = (f32x4*)(yp + bj * 128 + n * 16); *p = *p + acc[ai][bj][m][n]; } }
    }
};

DI void p0_transpose_item(const float* W, int ldw, int nblk, int K, bf16_t* WT, int rmul, int radd, const float* ksc, LAS float* scr, int item, int lane) {
    const int kb = item / nblk, nb = item % nblk, k0 = 64 * kb, n0 = 32 * nb;
#pragma unroll 8
    for (int i = 0; i < 32; ++i) { const int kk = 2 * i + (lane >> 5); float v = W[(size_t)(k0 + kk) * ldw + n0 + (lane & 31)]; if (ksc) v *= ksc[k0 + kk]; scr[kk * 33 + (lane & 31)] = v; }
    asm volatile("s_waitcnt lgkmcnt(0)" ::: "memory");
    const int c = lane & 7;
#pragma unroll
    for (int j = 0; j < 4; ++j) { const int n = (lane >> 3) + 8 * j; const LAS float* s = scr + (8 * c) * 33 + n;
        u32x4 o; o.x = pk2(s[0 * 33], s[1 * 33]); o.y = pk2(s[2 * 33], s[3 * 33]); o.z = pk2(s[4 * 33], s[5 * 33]); o.w = pk2(s[6 * 33], s[7 * 33]);
        *(u32x4*)(WT + (size_t)((n0 + n) * rmul + radd) * K + k0 + 8 * c) = o; }
    asm volatile("s_waitcnt lgkmcnt(0)" ::: "memory");
}
DI void phase0(const Params& P, LAS unsigned char* lds) {
    const int tid = tid_(), lane = tid & 63, wave = tid >> 6, G = gridDim.x;
    unsigned char* ws = P.ws;
    LAS float* scr = (LAS float*)(lds + wave * 16384);
    const int gw = blockIdx.x * NWAVES + wave, NGW = G * NWAVES;
    constexpr int I_IN = 16 * 96, I_OUT = 16 * 32, I_G = 16 * 88, I_D = 44 * 32, NIT = I_IN + I_OUT + 2 * I_G + I_D;
    for (int it = gw; it < NIT; it += NGW) {
        int r = it;
        if (r < I_IN) { p0_transpose_item(P.in[I_WIN], DIN, 96, DM, (bf16_t*)(ws + WS_WIN), 1, 0, nullptr, scr, r, lane); continue; } r -= I_IN;
        if (r < I_OUT) { p0_transpose_item(P.in[I_WOUT], DM, 32, DM, (bf16_t*)(ws + WS_WOUT), 1, 0, nullptr, scr, r, lane); continue; } r -= I_OUT;
        if (r < I_G) { p0_transpose_item(P.in[I_WG], DFF, 88, DM, (bf16_t*)(ws + WS_WGU), 2, 0, P.in[I_NORM2], scr, r, lane); continue; } r -= I_G;
        if (r < I_G) { p0_transpose_item(P.in[I_WU], DFF, 88, DM, (bf16_t*)(ws + WS_WGU), 2, 1, P.in[I_NORM2], scr, r, lane); continue; } r -= I_G;
        p0_transpose_item(P.in[I_WD], DM, 32, DFF, (bf16_t*)(ws + WS_WDN), 1, 0, nullptr, scr, r, lane);
    }
    for (int s = blockIdx.x * NTHR + tid; s < 8192; s += G * NTHR) {
        const int l = s & 63, f = s >> 6, ks = f & 3, nt = (f >> 2) & 1, hb = (f >> 3) & 7, mat = f >> 6;
        const float* w = (mat ? P.in[I_RWI] : P.in[I_RWA]) + hb * 4096 + (16 * ks + 8 * (l >> 5)) * 64 + 32 * nt + (l & 31);
        u32x4 o; o.x = pk2(w[0], w[64]); o.y = pk2(w[128], w[192]); o.z = pk2(w[256], w[320]); o.w = pk2(w[384], w[448]);
        *(u32x4*)(ws + WS_RGW + (size_t)s * 16) = o;
    }
    __syncthreads();
    LAS float* EXT = (LAS float*)lds;
    for (int i = tid; i < 8192; i += NTHR) { const int k = i >> 3, c = i & 7, l = (k & 255) >> 2, q = k & 3, j = k >> 8;
        EXT[(((j * 4 + q) * 64 + l) << 3) + c] = P.in[I_WIN][(size_t)k * DIN + NPROJ + c]; }
    __syncthreads();
    const float* n1 = P.in[I_NORM1];
    f32x4 nw[4];
#pragma unroll
    for (int j = 0; j < 4; ++j) nw[j] = *(const f32x4*)(n1 + 4 * lane + 256 * j);
    for (int m = gw; m < NTOK; m += NGW) {
        const float* xrow = (m < NTOK_P) ? P.in[I_XP] + (size_t)m * DM : P.in[I_XS] + (size_t)(m - NTOK_P) * DM;
        f32x4 v[4]; float s = 0.f;
#pragma unroll
        for (int j = 0; j < 4; ++j) { v[j] = *(const f32x4*)(xrow + 4 * lane + 256 * j); s += (v[j].x * v[j].x + v[j].y * v[j].y) + (v[j].z * v[j].z + v[j].w * v[j].w); }
        const float rstd = rsqrtf(wave_sum(s) * (1.f / DM) + 1e-6f);
        float e[8];
#pragma unroll
        for (int c = 0; c < 8; ++c) e[c] = 0.f;
        bf16_t* orow = (bf16_t*)(ws + WS_HN) + (size_t)m * DM;
#pragma unroll
        for (int j = 0; j < 4; ++j) { v[j] = v[j] * rstd * nw[j];
            u32x2 w; w.x = pk2(v[j].x, v[j].y); w.y = pk2(v[j].z, v[j].w); *(u32x2*)(orow + 4 * lane + 256 * j) = w;
#pragma unroll
            for (int q = 0; q < 4; ++q) { const LAS f32x4* ep = (const LAS f32x4*)(EXT + (((j * 4 + q) * 64 + lane) << 3)); const f32x4 e0 = ep[0], e1 = ep[1]; const float hv = v[j][q];
                e[0] += hv * e0.x; e[1] += hv * e0.y; e[2] += hv * e0.z; e[3] += hv * e0.w; e[4] += hv * e1.x; e[5] += hv * e1.y; e[6] += hv * e1.z; e[7] += hv * e1.w; } }
#pragma unroll
        for (int c = 0; c < 8; ++c) e[c] = wave_sum(e[c]);
        if (lane < 4) { float sv = lane == 0 ? e[0] : lane == 1 ? e[1] : lane == 2 ? e[2] : e[3]; ((float*)(ws + WS_BETA))[m * 4 + lane] = sigm(sv); }
        else if (lane < 8) { const int hh = lane - 4; float sv = hh == 0 ? e[4] : hh == 1 ? e[5] : hh == 2 ? e[6] : e[7];
            ((float*)(ws + WS_G))[m * 4 + hh] = -__expf(P.in[I_ALOG][hh]) * softplus(sv + P.in[I_DTB][hh]); }
    }
}

DI void gdn_chunk_item(const Params& P, LAS unsigned char* lds, int item) {
    const int tid = tid_(), lane = tid & 63, wave = tid >> 6;
    const int h = item & 3, bn = item >> 2, b = bn >> 5, n = bn & 31;
    const int m0 = b * 2048 + n * 64, cid = (b * 4 + h) * 32 + n;
    unsigned char* ws = P.ws;
    LAS float* QT = (LAS float*)lds; LAS float* KT = QT + 64 * 132; LAS float* VT = KT + 64 * 132;
    LAS float* LM = VT + 64 * 132; LAS float* QKM = LM + 64 * 68; LAS float* SM = QKM + 64 * 68;
    const bf16_t* PROJ = (const bf16_t*)(ws + WS_PROJ);
    {
        const int d = tid & 127, tg = tid >> 7;
        const float* cw = P.in[I_GCW];
#pragma unroll 1
        for (int mat = 0; mat < 3; ++mat) {
            const int ch = mat * 512 + h * 128 + d;
            const float w0 = cw[ch], w1 = cw[1536 + ch], w2 = cw[3072 + ch], w3 = cw[4608 + ch];
            const bf16_t* src = PROJ + (size_t)(m0 + 16 * tg) * NPROJ + 1024 + ch;
            float x3 = 0.f, x2 = 0.f, x1 = 0.f;
            if (n > 0 || tg > 0) { x3 = bf2f(src[-3 * NPROJ]); x2 = bf2f(src[-2 * NPROJ]); x1 = bf2f(src[-NPROJ]); }
            LAS float* T = QT + mat * (64 * 132);
#pragma unroll 4
            for (int i = 0; i < 16; ++i) {
                const float x0 = bf2f(src[i * NPROJ]);
                const float y = w0 * x3 + w1 * x2 + w2 * x1 + w3 * x0;
                T[(16 * tg + i) * 132 + d] = silu(y);
                if (n == 31 && tg == 3 && i >= 13) P.out[OUT_PGC + (size_t)(b * 3 + (i - 13)) * 1536 + ch] = x0;
                x3 = x2; x2 = x1; x1 = x0;
            }
        }
    }
    if (tid < 64) {
        SM[128 + tid] = ((const float*)(ws + WS_BETA))[(m0 + tid) * 4 + h];
        float g = ((const float*)(ws + WS_G))[(m0 + tid) * 4 + h];
#pragma unroll
        for (int o = 1; o < 64; o <<= 1) { const float t = __shfl_up(g, o); if (lane >= o) g += t; }
        SM[tid] = g; SM[64 + tid] = __expf(g);
    }
    __syncthreads();
#pragma unroll 1
    for (int k = 0; k < 8; ++k) {
        const int i = 8 * wave + k;
        const float q0 = QT[i * 132 + lane], q1 = QT[i * 132 + 64 + lane], k0 = KT[i * 132 + lane], k1 = KT[i * 132 + 64 + lane];
        const float rq = rsqrtf(wave_sum(q0 * q0 + q1 * q1) + 1e-6f) * 0.08838834764831845f, rk = rsqrtf(wave_sum(k0 * k0 + k1 * k1) + 1e-6f);
        QT[i * 132 + lane] = q0 * rq; QT[i * 132 + 64 + lane] = q1 * rq; KT[i * 132 + lane] = k0 * rk; KT[i * 132 + 64 + lane] = k1 * rk;
    }
    __syncthreads();
    {
        const int which = wave >> 2, it = (wave >> 1) & 1, jt = wave & 1, r = lane & 31, hh = lane >> 5;
        LAS float* dst = which ? QKM : LM;
        f32x16 acc = zero16();
        if (!(it == 0 && jt == 1)) {
            const LAS float* Ar = (which ? QT : KT) + (32 * it + r) * 132 + 8 * hh;
            const LAS float* Br = KT + (32 * jt + r) * 132 + 8 * hh;
#pragma unroll
            for (int ks = 0; ks < 8; ++ks) {
                const bf16x8 a = pack8(*(const LAS f32x4*)(Ar + 16 * ks), *(const LAS f32x4*)(Ar + 16 * ks + 4));
                const bf16x8 bb = pack8(*(const LAS f32x4*)(Br + 16 * ks), *(const LAS f32x4*)(Br + 16 * ks + 4));
                acc = MFMA32(a, bb, acc);
            }
        }
        const int j = 32 * jt + r; const float gcj = SM[j];
#pragma unroll
        for (int reg = 0; reg < 16; ++reg) {
            const int i = 32 * it + crow(reg, hh); const float gci = SM[i];
            float v = 0.f;
            if (which == 0) { if (j < i) v = acc[reg] * SM[128 + i] * __expf(gci - gcj); }
            else { if (j <= i) v = acc[reg] * __expf(gci - gcj); }
            dst[i * 68 + j] = v;
        }
    }
    __syncthreads();
    {
        const float gcl = SM[63];
        bf16_t* QDF = (bf16_t*)(ws + WS_QDF) + (size_t)cid * 8192; bf16_t* KTF = (bf16_t*)(ws + WS_KTF) + (size_t)cid * 8192; bf16_t* QKF = (bf16_t*)(ws + WS_QKF) + (size_t)cid * 4096;
#pragma unroll 1
        for (int s = tid; s < 2560; s += NTHR) {
            const int l = s & 63, r = l & 31, hh = l >> 5, f = s >> 6;
            float v[8];
            if (f < 16) { const int mt = f >> 3, kk = f & 7, c = 32 * mt + r, db = 16 * kk + 4 * hh; const float sc = SM[64 + c];
#pragma unroll
                for (int e = 0; e < 8; ++e) v[e] = QT[c * 132 + db + 8 * (e >> 2) + (e & 3)] * sc;
                *(bf16x8*)(QDF + f * 512 + l * 8) = pack8v(v);
            } else if (f < 32) { const int f2 = f - 16, dmt = f2 >> 2, ks = f2 & 3, d = 32 * dmt + r, cb = 16 * ks + 4 * hh;
#pragma unroll
                for (int e = 0; e < 8; ++e) { const int c = cb + 8 * (e >> 2) + (e & 3); v[e] = KT[c * 132 + d] * __expf(gcl - SM[c]); }
                *(bf16x8*)(KTF + f2 * 512 + l * 8) = pack8v(v);
            } else { const int f3 = f - 32, mt = f3 >> 2, ks = f3 & 3, i = 32 * mt + r, cb = 16 * ks + 4 * hh;
#pragma unroll
                for (int e = 0; e < 8; ++e) v[e] = QKM[i * 68 + cb + 8 * (e >> 2) + (e & 3)];
                *(bf16x8*)(QKF + f3 * 512 + l * 8) = pack8v(v);
            }
        }
        if (tid == 0) ((float*)(ws + WS_GL))[cid] = __expf(gcl);
    }
    __syncthreads();
    if (tid < 256) {
        const bool isw = tid >= 128; const int ci = tid & 127;
        LAS float* Tc = vlaunder((isw ? KT : VT) + ci);
        const LAS float* LMv = vlaunder(LM); const LAS float* SMv = vlaunder(SM);
        float x[64];
#pragma unroll
        for (int i = 0; i < 64; ++i) {
            float rhs = Tc[i * 132] * SMv[128 + i]; if (isw) rhs *= SMv[64 + i];
            float a0 = rhs, a1 = 0.f, a2 = 0.f, a3 = 0.f;
#pragma unroll
            for (int j4 = 0; j4 < (i + 3) / 4; ++j4) { const f32x4 l4 = *(const LAS f32x4*)(LMv + i * 68 + 4 * j4);
                if (4 * j4 + 0 < i) a0 -= l4.x * x[4 * j4 + 0]; if (4 * j4 + 1 < i) a1 -= l4.y * x[4 * j4 + 1];
                if (4 * j4 + 2 < i) a2 -= l4.z * x[4 * j4 + 2]; if (4 * j4 + 3 < i) a3 -= l4.w * x[4 * j4 + 3]; }
            x[i] = (a0 + a1) + (a2 + a3); Tc[i * 132] = x[i];
        }
    }
    __syncthreads();
    {
        bf16_t* WF = (bf16_t*)(ws + WS_WF) + (size_t)cid * 8192; bf16_t* UB = (bf16_t*)(ws + WS_UB) + (size_t)cid * 8192;
#pragma unroll 1
        for (int s = tid; s < 2048; s += NTHR) {
            float v[8];
            if (s < 1024) { const int l = s & 63, r = l & 31, hh = l >> 5, f = s >> 6, mt = f >> 3, kk = f & 7, c = 32 * mt + r, db = 16 * kk + 4 * hh;
#pragma unroll
                for (int e = 0; e < 8; ++e) v[e] = -KT[c * 132 + db + 8 * (e >> 2) + (e & 3)];
                *(bf16x8*)(WF + f * 512 + l * 8) = pack8v(v);
            } else { const int s2 = s - 1024, c = s2 >> 4, e0 = (s2 & 15) * 8;
#pragma unroll
                for (int e = 0; e < 8; ++e) v[e] = VT[c * 132 + e0 + e];
                *(bf16x8*)(UB + c * 128 + e0) = pack8v(v);
            }
        }
    }
    __syncthreads();
}

DI void rg_tile_item(const Params& P, LAS unsigned char* lds, int T) {
    const int tid = tid_(), lane = tid & 63, wave = tid >> 6, r = lane & 31, hh = lane >> 5;
    unsigned char* ws = P.ws;
    LAS bf16_t* XC = (LAS bf16_t*)lds + wave * (64 * 72);
    const bf16_t* PROJ = (const bf16_t*)(ws + WS_PROJ);
    const int m0 = 64 * T; const bool prm = T < 256; const int sq0 = prm ? 0 : (m0 - NTOK_P) / 8;
    {
        const int c = 64 * wave + lane;
        const float* cw = P.in[I_RCW]; const float w0 = cw[c], w1 = cw[512 + c], w2 = cw[1024 + c], w3 = cw[1536 + c], cb = P.in[I_RCB][c];
        const bf16_t* src = PROJ + (size_t)m0 * NPROJ + c;
        float x3 = 0.f, x2 = 0.f, x1 = 0.f;
        if (prm && (T & 31) != 0) { x3 = bf2f(src[-3 * NPROJ]); x2 = bf2f(src[-2 * NPROJ]); x1 = bf2f(src[-NPROJ]); }
        const float* rcs = P.in[I_SRC];
#pragma unroll 4
        for (int i = 0; i < 64; ++i) {
            const int seq = sq0 + (i >> 3);
            if (!prm && (i & 7) == 0) { x3 = rcs[(size_t)(seq * 3 + 0) * 512 + c]; x2 = rcs[(size_t)(seq * 3 + 1) * 512 + c]; x1 = rcs[(size_t)(seq * 3 + 2) * 512 + c]; }
            const float x0 = bf2f(src[i * NPROJ]);
            XC[i * 72 + lane] = (bf16_t)f2bf(w0 * x3 + w1 * x2 + w2 * x1 + w3 * x0 + cb);
            if (prm) { if ((T & 31) == 31 && i >= 61) P.out[OUT_PRC + (size_t)((T >> 5) * 3 + (i - 61)) * 512 + c] = x0; }
            else { if ((i & 7) >= 5) P.out[OUT_SRC + (size_t)(seq * 3 + (i & 7) - 5) * 512 + c] = x0; }
            x3 = x2; x2 = x1; x1 = x0;
        }
    }
    asm volatile("s_waitcnt lgkmcnt(0)" ::: "memory");
    const bf16x8* RGW = (const bf16x8*)(ws + WS_RGW);
#pragma unroll 1
    for (int nt = 0; nt < 2; ++nt) {
        f32x16 aa[2], ai[2]; aa[0] = zero16(); aa[1] = zero16(); ai[0] = zero16(); ai[1] = zero16();
#pragma unroll
        for (int ks = 0; ks < 4; ++ks) {
            const bf16x8 bfa = RGW[(((0 * 8 + wave) * 2 + nt) * 4 + ks) * 64 + lane], bfi = RGW[(((1 * 8 + wave) * 2 + nt) * 4 + ks) * 64 + lane];
#pragma unroll
            for (int mt = 0; mt < 2; ++mt) { const bf16x8 a = *(const LAS bf16x8*)(XC + (32 * mt + r) * 72 + 16 * ks + 8 * hh);
                aa[mt] = MFMA32(a, bfa, aa[mt]); ai[mt] = MFMA32(a, bfi, ai[mt]); }
        }
        const int j = 64 * wave + 32 * nt + r;
        const float ba = P.in[I_RBA][j], bi = P.in[I_RBI][j], spl = -8.f * softplus(-P.in[I_LAM][j]);
        float Cc = 0.f, Pp = 1.f;
        const bf16_t* projb = PROJ + (size_t)(m0 + 4 * hh) * NPROJ + 512 + j;
        bf16_t* mixb = (bf16_t*)(ws + WS_MIX) + (size_t)(m0 + 4 * hh) * DM + j;
        bf16_t* gab = (bf16_t*)(ws + WS_GA) + (size_t)(m0 + 4 * hh) * 512 + j;
#pragma unroll
        for (int Gi = 0; Gi < 8; ++Gi) {
            const int mt = Gi >> 2, g = Gi & 3;
            const bf16_t* pb = vlaunder(projb); bf16_t* mb = vlaunder(mixb); bf16_t* gb = vlaunder(gab);
            float Hl[4], Ac[4];
#pragma unroll
            for (int k = 0; k < 4; ++k) { const int reg = 4 * g + k, t = 32 * mt + 8 * g + 4 * hh + k;
                const float rg_ = sigm(aa[mt][reg] + ba), ig = sigm(ai[mt][reg] + bi), la = spl * rg_, a = __expf(la), mult = sqrtf(-expm1f(2.f * la));
                const float u = mult * ig * bf2f(XC[t * 72 + 32 * nt + r]);
                if (k == 0) { Hl[0] = u; Ac[0] = a; } else { Hl[k] = a * Hl[k - 1] + u; Ac[k] = a * Ac[k - 1]; } }
            const float Ag = Ac[3], Hg = Hl[3], pA = __shfl_xor(Ag, 32), pH = __shfl_xor(Hg, 32);
            const int seq = sq0 + Gi;
            if (!prm) { Cc = P.in[I_SRH][(size_t)seq * 512 + j]; Pp = 1.f; }
            float cin, pin, Cn, Pn;
            if (hh == 0) { cin = Cc; pin = Pp; Cn = pA * (Ag * Cc + Hg) + pH; Pn = Pp * Ag * pA; }
            else { cin = pA * Cc + pH; pin = Pp * pA; Cn = Ag * cin + Hg; Pn = Pp * pA * Ag; }
#pragma unroll
            for (int k = 0; k < 4; ++k) { const int tt = 32 * mt + 8 * g + k;
                const float hv = Hl[k] + Ac[k] * cin, gy = gelu_tanh(bf2f(pb[(size_t)tt * NPROJ]));
                mb[(size_t)tt * DM] = (bf16_t)f2bf(gy * hv);
                if (prm) gb[(size_t)tt * 512] = (bf16_t)f2bf(gy * Ac[k] * pin);
                else if (hh == 1 && k == 3) P.out[OUT_SRH + (size_t)seq * 512 + j] = hv; }
            Cc = Cn; Pp = Pn;
            asm volatile("" ::: "memory"); __builtin_amdgcn_sched_barrier(0);
        }
        if (prm && hh == 0) { ((float*)(ws + WS_SEGA))[T * 512 + j] = Pp; ((float*)(ws + WS_SEGH))[T * 512 + j] = Cc; }
    }
    asm volatile("s_waitcnt lgkmcnt(0)" ::: "memory");
}

DI void gdn_seq_block(const Params& P, LAS unsigned char* lds, int bh) {
    const int tid = tid_(), lane = tid & 63, wave = tid >> 6, r = lane & 31, hh = lane >> 5;
    const int b = bh >> 2, h = bh & 3;
    unsigned char* ws = P.ws;
    LAS float* OB = (LAS float*)lds;
    const bf16_t* PROJ = (const bf16_t*)(ws + WS_PROJ);
    f32x16 S[4]; S[0] = zero16(); S[1] = zero16(); S[2] = zero16(); S[3] = zero16();
    const int e0 = 32 * (wave & 3);
#pragma unroll 1
    for (int n = 0; n <= 32; ++n) {
        if (wave < 4 && n < 32) {
            const int cid = bh * 32 + n;
            const bf16x8* WF = (const bf16x8*)(ws + WS_WF) + (size_t)cid * 1024 + lane; const bf16x8* QDF = (const bf16x8*)(ws + WS_QDF) + (size_t)cid * 1024 + lane;
            const bf16x8* KTF = (const bf16x8*)(ws + WS_KTF) + (size_t)cid * 1024 + lane; const bf16x8* QKF = (const bf16x8*)(ws + WS_QKF) + (size_t)cid * 512 + lane;
            const bf16_t* UB = (const bf16_t*)(ws + WS_UB) + (size_t)cid * 8192;
            const float gl = ((const float*)(ws + WS_GL))[cid];
            bf16x8 Sb[8];
#pragma unroll
            for (int dt = 0; dt < 4; ++dt) { Sb[2 * dt] = pack_step(S[dt], 0); Sb[2 * dt + 1] = pack_step(S[dt], 1); }
            f32x16 vacc[2], oacc[2];
#pragma unroll
            for (int mt = 0; mt < 2; ++mt) {
#pragma unroll
                for (int reg = 0; reg < 16; ++reg) vacc[mt][reg] = bf2f(UB[(32 * mt + crow(reg, hh)) * 128 + e0 + r]);
                oacc[mt] = zero16();
            }
#pragma unroll
            for (int mt = 0; mt < 2; ++mt)
#pragma unroll
                for (int kk = 0; kk < 8; ++kk) { vacc[mt] = MFMA32(WF[(mt * 8 + kk) * 64], Sb[kk], vacc[mt]); oacc[mt] = MFMA32(QDF[(mt * 8 + kk) * 64], Sb[kk], oacc[mt]); }
            bf16x8 vb[4];
#pragma unroll
            for (int ct = 0; ct < 2; ++ct) { vb[2 * ct] = pack_step(vacc[ct], 0); vb[2 * ct + 1] = pack_step(vacc[ct], 1); }
#pragma unroll
            for (int mt = 0; mt < 2; ++mt)
#pragma unroll
                for (int ks = 0; ks < 4; ++ks) oacc[mt] = MFMA32(QKF[(mt * 4 + ks) * 64], vb[ks], oacc[mt]);
#pragma unroll
            for (int dt = 0; dt < 4; ++dt) { S[dt] = S[dt] * gl;
#pragma unroll
                for (int ks = 0; ks < 4; ++ks) S[dt] = MFMA32(KTF[(dt * 4 + ks) * 64], vb[ks], S[dt]); }
            LAS float* ob = OB + (n & 1) * (64 * 132);
#pragma unroll
            for (int mt = 0; mt < 2; ++mt)
#pragma unroll
                for (int reg = 0; reg < 16; ++reg) ob[(32 * mt + crow(reg, hh)) * 132 + e0 + r] = oacc[mt][reg];
        }
        if (wave >= 4 && n >= 1) {
            const LAS float* ob = OB + ((n - 1) & 1) * (64 * 132);
            const int mb = b * 2048 + (n - 1) * 64;
            const float gw0 = P.in[I_GNW][lane], gw1 = P.in[I_GNW][lane + 64];
#pragma unroll 4
            for (int k = 0; k < 16; ++k) { const int c = 16 * (wave - 4) + k; const size_t m = mb + c;
                const float o0 = ob[c * 132 + lane], o1 = ob[c * 132 + 64 + lane];
                const float rstd = rsqrtf(wave_sum(o0 * o0 + o1 * o1) * (1.f / 128.f) + 1e-6f);
                const float z0 = bf2f(PROJ[m * NPROJ + 2560 + 128 * h + lane]), z1 = bf2f(PROJ[m * NPROJ + 2560 + 128 * h + 64 + lane]);
                bf16_t* mp = (bf16_t*)(ws + WS_MIX) + m * DM + 512 + 128 * h;
                mp[lane] = (bf16_t)f2bf(o0 * rstd * gw0 * silu(z0)); mp[lane + 64] = (bf16_t)f2bf(o1 * rstd * gw1 * silu(z1)); }
        }
        __syncthreads();
    }
    if (wave < 4) {
#pragma unroll
        for (int dt = 0; dt < 4; ++dt)
#pragma unroll
            for (int reg = 0; reg < 16; ++reg) P.out[OUT_PGS + ((size_t)bh * 128 + 32 * dt + crow(reg, hh)) * 128 + e0 + r] = S[dt][reg];
    }
}

DI void gdn_sample_item(const Params& P, LAS unsigned char* lds, int s, int h) {
    const int tid = tid_(), lane = tid & 63, wave = tid >> 6;
    unsigned char* ws = P.ws;
    LAS float* Q = (LAS float*)lds; LAS float* K = Q + 1024; LAS float* V = K + 1024; LAS float* Uu = V + 1024; LAS float* Ww = Uu + 1024; LAS float* Oo = Ww + 1024;
    LAS float* RED = Oo + 1024;
    LAS float* SMs = RED + 8192;
    const bf16_t* PROJ = (const bf16_t*)(ws + WS_PROJ);
    const int m0 = NTOK_P + 8 * s;
    if (tid < 384) {
        const int mat = tid >> 7, d = tid & 127, ch = mat * 512 + h * 128 + d;
        const float* cw = P.in[I_GCW]; const float w0 = cw[ch], w1 = cw[1536 + ch], w2 = cw[3072 + ch], w3 = cw[4608 + ch];
        const float* st = P.in[I_SGC] + (size_t)s * 3 * 1536 + ch;
        float x3 = st[0], x2 = st[1536], x1 = st[3072];
        LAS float* T = Q + mat * 1024;
#pragma unroll
        for (int t = 0; t < 8; ++t) { const float x0 = bf2f(PROJ[(size_t)(m0 + t) * NPROJ + 1024 + ch]);
            T[t * 128 + d] = silu(w0 * x3 + w1 * x2 + w2 * x1 + w3 * x0);
            if (t >= 5) P.out[OUT_SGC + (size_t)(s * 3 + t - 5) * 1536 + ch] = x0;
            x3 = x2; x2 = x1; x1 = x0; }
    }
    if (tid == 511) { float acc = 0.f;
        for (int t = 0; t < 8; ++t) { acc += ((const float*)(ws + WS_G))[(m0 + t) * 4 + h]; SMs[t] = acc; SMs[8 + t] = __expf(acc); SMs[16 + t] = ((const float*)(ws + WS_BETA))[(m0 + t) * 4 + h]; }
        for (int t = 0; t < 8; ++t) SMs[24 + t] = __expf(acc - SMs[t]); }
    __syncthreads();
    {   const int i = wave;
        const float q0 = Q[i * 128 + lane], q1 = Q[i * 128 + 64 + lane], k0 = K[i * 128 + lane], k1 = K[i * 128 + 64 + lane];
        const float rq = rsqrtf(wave_sum(q0 * q0 + q1 * q1) + 1e-6f) * 0.08838834764831845f, rk = rsqrtf(wave_sum(k0 * k0 + k1 * k1) + 1e-6f);
        Q[i * 128 + lane] = q0 * rq; Q[i * 128 + 64 + lane] = q1 * rq; K[i * 128 + lane] = k0 * rk; K[i * 128 + 64 + lane] = k1 * rk; }
    __syncthreads();
    if (tid < 128) { const int which = tid >> 6, i = (tid >> 3) & 7, j = tid & 7;
        const LAS float* a = (which ? Q : K) + i * 128; const LAS float* bq = K + j * 128; float dot = 0.f;
        for (int d = 0; d < 128; ++d) dot += a[d] * bq[d];
        const float dec = __expf(SMs[i] - SMs[j]);
        if (which == 0) SMs[32 + i * 8 + j] = (j < i) ? dot * SMs[16 + i] * dec : 0.f;
        else SMs[96 + i * 8 + j] = (j <= i) ? dot * dec : 0.f; }
    __syncthreads();
    if (tid < 256) { const bool isw = tid >= 128; const int ci = tid & 127; float x[8];
#pragma unroll
        for (int i = 0; i < 8; ++i) { float acc = (isw ? K : V)[i * 128 + ci] * SMs[16 + i]; if (isw) acc *= SMs[8 + i];
#pragma unroll
            for (int j = 0; j < 8; ++j) if (j < i) acc -= SMs[32 + i * 8 + j] * x[j];
            x[i] = acc; (isw ? Ww : Uu)[i * 128 + ci] = acc; } }
    __syncthreads();
    {   const int e = tid & 127, dq = tid >> 7;
        const float* S0 = P.in[I_SGS] + ((size_t)(s * 4 + h) * 128 + 32 * dq) * 128 + e;
        float Sr[32];
#pragma unroll
        for (int k = 0; k < 32; ++k) Sr[k] = S0[(size_t)k * 128];
        float pv[8], po[8];
#pragma unroll
        for (int c = 0; c < 8; ++c) { pv[c] = 0.f; po[c] = 0.f; }
#pragma unroll
        for (int k = 0; k < 32; ++k) { const int d = 32 * dq + k;
#pragma unroll
            for (int c = 0; c < 8; ++c) { pv[c] += Ww[c * 128 + d] * Sr[k]; po[c] += Q[c * 128 + d] * Sr[k]; } }
#pragma unroll
        for (int c = 0; c < 8; ++c) { RED[(dq * 16 + c) * 128 + e] = pv[c]; RED[(dq * 16 + 8 + c) * 128 + e] = po[c] * SMs[8 + c]; }
        __syncthreads();
        float vn[8];
#pragma unroll
        for (int c = 0; c < 8; ++c) vn[c] = Uu[c * 128 + e] - ((RED[(0 * 16 + c) * 128 + e] + RED[(1 * 16 + c) * 128 + e]) + (RED[(2 * 16 + c) * 128 + e] + RED[(3 * 16 + c) * 128 + e]));
        const float gl = SMs[15];
        float* So = P.out + OUT_SGS + ((size_t)(s * 4 + h) * 128 + 32 * dq) * 128 + e;
#pragma unroll
        for (int k = 0; k < 32; ++k) { const int d = 32 * dq + k; float acc = Sr[k] * gl;
#pragma unroll
            for (int c = 0; c < 8; ++c) acc += K[c * 128 + d] * SMs[24 + c] * vn[c];
            So[(size_t)k * 128] = acc; }
        if (dq == 0) {
#pragma unroll
            for (int c = 0; c < 8; ++c) { float o = (RED[(0 * 16 + 8 + c) * 128 + e] + RED[(1 * 16 + 8 + c) * 128 + e]) + (RED[(2 * 16 + 8 + c) * 128 + e] + RED[(3 * 16 + 8 + c) * 128 + e]);
#pragma unroll
                for (int j = 0; j < 8; ++j) if (j <= c) o += SMs[96 + c * 8 + j] * vn[j];
                Oo[c * 128 + e] = o; } }
    }
    __syncthreads();
    {   const int c = wave; const size_t m = m0 + c;
        const float o0 = Oo[c * 128 + lane], o1 = Oo[c * 128 + 64 + lane];
        const float rstd = rsqrtf(wave_sum(o0 * o0 + o1 * o1) * (1.f / 128.f) + 1e-6f);
        const float z0 = bf2f(PROJ[m * NPROJ + 2560 + 128 * h + lane]), z1 = bf2f(PROJ[m * NPROJ + 2560 + 128 * h + 64 + lane]);
        bf16_t* mp = (bf16_t*)(ws + WS_MIX) + m * DM + 512 + 128 * h;
        mp[lane] = (bf16_t)f2bf(o0 * rstd * P.in[I_GNW][lane] * silu(z0)); mp[lane + 64] = (bf16_t)f2bf(o1 * rstd * P.in[I_GNW][lane + 64] * silu(z1)); }
    __syncthreads();
}

DI void rg_fix_item(const Params& P, int b, int n) {
    const int c = tid_(); unsigned char* ws = P.ws;
    const float* SA = (const float*)(ws + WS_SEGA); const float* SH = (const float*)(ws + WS_SEGH);
    float Cc = 0.f;
    for (int j = 0; j < n; ++j) { const int Tj = b * 32 + j; Cc = SA[Tj * 512 + c] * Cc + SH[Tj * 512 + c]; }
    bf16_t* MIX = (bf16_t*)(ws + WS_MIX); const bf16_t* GA = (const bf16_t*)(ws + WS_GA);
    const size_t mb = (size_t)b * 2048 + 64 * n;
#pragma unroll 8
    for (int i = 0; i < 64; ++i) { const size_t m = mb + i; MIX[m * DM + c] = (bf16_t)f2bf(bf2f(MIX[m * DM + c]) + bf2f(GA[m * 512 + c]) * Cc); }
    if (n == 31) { const int Tj = b * 32 + 31; P.out[OUT_PRH + (size_t)b * 512 + c] = SA[Tj * 512 + c] * Cc + SH[Tj * 512 + c]; }
}

__global__ void __launch_bounds__(NTHR, 2) hybrid_fwd(Params Pk) {
    extern __shared__ __attribute__((aligned(16))) unsigned char lds_raw[];
    LAS unsigned char* lds = (LAS unsigned char*)lds_raw;
    cg::grid_group grid = cg::this_grid();
    const int G = gridDim.x;
    volatile LAS unsigned* bst = (volatile LAS unsigned*)(lds + (LDS_BYTES - 64));
    if (threadIdx.x < 2) bst[threadIdx.x] = 0u;
    __syncthreads();
    XcdBarrier xb; { const Params P = load_params(); xb = xcd_barrier_post((unsigned*)(P.ws + WS_CTL), bst); }

    { const Params P = load_params(); phase0(P, lds); }
    grid.sync();
    {   const Params P = load_params(); unsigned char* ws = P.ws;
        pg8::Gemm g{(const bf16_t*)(ws + WS_HN), (const bf16_t*)(ws + WS_WIN), NTOK, NPROJ, DM}; pg8::StaticOrder S; S.init(NTOK, NPROJ, G, (int)blockIdx.x);
        EpiProj E{(bf16_t*)(ws + WS_PROJ), NPROJ};
        pg8::gemm_phase<EpiProj, pg8::StaticOrder, true, true>(lds, g, S, E); }
    xcd_barrier(xb);
    for (int it = blockIdx.x; it < 1024; it += G) { const Params P = load_params(); gdn_chunk_item(P, lds, it); }
    for (int it = blockIdx.x; it < 272; it += G) { const Params P = load_params(); rg_tile_item(P, lds, it); __syncthreads(); }
    xcd_barrier(xb);
    if (blockIdx.x < 32) { const Params P = load_params(); gdn_seq_block(P, lds, blockIdx.x); }
    else {
        for (int it = blockIdx.x - 32; it < 512; it += G - 32) { const Params P = load_params(); gdn_sample_item(P, lds, it >> 2, it & 3); }
        for (int q = blockIdx.x - 32; q < 248; q += G - 32) { const Params P = load_params(); rg_fix_item(P, q / 31, 1 + q % 31); }
    }
    xcd_barrier(xb);
    {   const Params P = load_params(); unsigned char* ws = P.ws;
        pg8::Gemm g{(const bf16_t*)(ws + WS_MIX), (const bf16_t*)(ws + WS_WOUT), NTOK, DM, DM}; pg8::StaticOrder S; S.init(NTOK, DM, G, (int)blockIdx.x);
        EpiX1 E{P.in[I_XP], P.in[I_XS], P.out + OUT_Y, (bf16_t*)(ws + WS_X1B), (float*)(ws + WS_SS1)};
        pg8::gemm_phase<EpiX1, pg8::StaticOrder, true, true>(lds, g, S, E); }
    xcd_barrier(xb);
    {   const Params P = load_params(); unsigned char* ws = P.ws;
        pg8::Gemm g{(const bf16_t*)(ws + WS_X1B), (const bf16_t*)(ws + WS_WGU), NTOK, NGU, DM}; pg8::StaticOrder S; S.init(NTOK, NGU, G, (int)blockIdx.x);
        EpiAct E{(bf16_t*)(ws + WS_ACT), (const float*)(ws + WS_SS1)};
        pg8::gemm_phase<EpiAct, pg8::StaticOrder, true, true>(lds, g, S, E); }
    xcd_barrier(xb);
    {   const Params P = load_params(); unsigned char* ws = P.ws;
        pg8::Gemm g{(const bf16_t*)(ws + WS_ACT), (const bf16_t*)(ws + WS_WDN), NTOK, DM, DFF}; pg8::StaticOrder S; S.init(NTOK, DM, G, (int)blockIdx.x);
        EpiX2 E{P.out + OUT_Y};
        pg8::gemm_phase<EpiX2, pg8::StaticOrder, true, true>(lds, g, S, E); }
    xcd_barrier(xb);
    {
        const Params P = load_params();
        const int tid = tid_(), lane = tid & 63, wave = tid >> 6; const float* fw = P.in[I_FN];
        f32x4 nw[4];
#pragma unroll
        for (int j = 0; j < 4; ++j) nw[j] = *(const f32x4*)(fw + 4 * lane + 256 * j);
        for (int m = blockIdx.x * NWAVES + wave; m < NTOK; m += G * NWAVES) {
            float* row = P.out + OUT_Y + (size_t)m * DM; f32x4 v[4]; float s = 0.f;
#pragma unroll
            for (int j = 0; j < 4; ++j) { v[j] = *(const f32x4*)(row + 4 * lane + 256 * j); s += (v[j].x * v[j].x + v[j].y * v[j].y) + (v[j].z * v[j].z + v[j].w * v[j].w); }
            const float rstd = rsqrtf(wave_sum(s) * (1.f / DM) + 1e-6f);
#pragma unroll
            for (int j = 0; j < 4; ++j) *(f32x4*)(row + 4 * lane + 256 * j) = v[j] * rstd * nw[j];
        }
    }
}

extern "C" void kernel_launch(void* const* d_in, const int* in_sizes, int n_in, void* d_out, int out_size, void* d_ws, size_t ws_size, hipStream_t stream) {
    static int grid = 0;
    if (grid == 0) {
        int dev = 0, cus = 0, per_cu = 0;
        if (n_in != 25 || ws_size < WS_END) { fprintf(stderr, "kernel_launch: unexpected n_in %d / ws_size %zu\n", n_in, ws_size); grid = -1; return; }
        hipGetDevice(&dev); hipDeviceGetAttribute(&cus, hipDeviceAttributeMultiprocessorCount, dev);
        hipFuncSetAttribute((const void*)hybrid_fwd, hipFuncAttributeMaxDynamicSharedMemorySize, LDS_BYTES);
        hipOccupancyMaxActiveBlocksPerMultiprocessor(&per_cu, (const void*)hybrid_fwd, NTHR, LDS_BYTES);
        (void)hipGetLastError();
        if (per_cu < 1) { fprintf(stderr, "kernel_launch: occupancy query says %d blocks per CU\n", per_cu); per_cu = 1; }
        grid = cus;
        if (grid > 256) grid = 256;
    }
    if (grid < 0) return;
    hipMemsetAsync((char*)d_ws + WS_CTL, 0, CTL_BYTES, stream);
    Params p{};
    for (int i = 0; i < 25; ++i) p.in[i] = (const float*)d_in[i];
    p.out = (float*)d_out; p.ws = (unsigned char*)d_ws;
    void* args[] = {&p};
    hipError_t e = hipLaunchCooperativeKernel((const void*)hybrid_fwd, dim3(grid), dim3(NTHR), args, LDS_BYTES, stream);
    if (e != hipSuccess) fprintf(stderr, "cooperative launch failed: %s (grid %d)\n", hipGetErrorString(e), grid);
}
```

```cpp
#include <hip/hip_runtime.h>
#include <hip/hip_cooperative_groups.h>
#include <cstdio>
#include <cstdint>
namespace cg = cooperative_groups;
namespace pg8 {
#define PG8_LAS __attribute__((address_space(3)))
typedef unsigned short bf16_t;
typedef short bf16x8 __attribute__((ext_vector_type(8)));
typedef float f32x4 __attribute__((ext_vector_type(4)));
typedef unsigned u32x4 __attribute__((ext_vector_type(4)));
constexpr int BM = 256, BK = 64, HALF = 128, HTB = HALF * BK * 2  , STAGE_BYTES = 8 * HTB, NXCD = 8, WGM = 8;

__host__ __device__ __forceinline__ int lds_byte(int r, int c) { const int st = (r >> 4) * 2 + (c >> 5), rr = r & 15, cc = c & 31, ob = rr * 64 + cc * 2; return st * 1024 + (ob ^ (((ob >> 9) & 1) << 5)); }
__host__ __device__ __forceinline__ void stage_rc(int b, int& R, int& C) { const int st = b / 1024, sb = b % 1024, swz = sb ^ (((sb >> 9) & 1) << 5); R = (st >> 1) * 16 + swz / 64; C = (st & 1) * 32 + (swz % 64) / 2; }
__host__ __device__ __forceinline__ int perm32(int rho) { const int n = rho >> 4, i = rho & 15; return 8 * (i >> 2) + 4 * n + (i & 3); }

struct Unit { int pm, pn; };
struct Gemm { const bf16_t* A; const bf16_t* Bt; int M, N, K; };

struct StaticOrder {
    int nM, nN, nwg, G, c;
    __host__ __device__ void init(int M, int N, int G_, int c_) { nM = M / BM; nN = N / BM; nwg = nM * nN; G = G_; c = c_; }
    __host__ __device__ bool next(int i, Unit& u) const {
        const long L = (long)i * G + c; if (L >= nwg) return false;
        int wgid = (int)L; { const int q = nwg / NXCD, r = nwg % NXCD, xcd = wgid % NXCD, off = wgid / NXCD; wgid = (xcd < r ? xcd * (q + 1) : r * (q + 1) + (xcd - r) * q) + off; }
        const int nig = WGM * nN, gid = wgid / nig, fm = gid * WGM, gsz = (nM - fm) < WGM ? (nM - fm) : WGM;
        u.pm = fm + ((wgid % nig) % gsz); u.pn = (wgid % nig) / gsz; return true;
    }
    __device__ __forceinline__ void a_ready(const Unit&) const {}
    __device__ __forceinline__ void done(const Unit&) const {}
};
__device__ __forceinline__ unsigned cvt_pk_bf16(float lo, float hi) { unsigned r; asm volatile("v_cvt_pk_bf16_f32 %0, %1, %2" : "=v"(r) : "v"(lo), "v"(hi)); return r; }
template <class Epi, class Sched, bool ALIGN_EPI = false, bool SP2 = false>
__device__ __forceinline__ void gemm_phase(PG8_LAS unsigned char* lds, const Gemm g, const Sched& S, const Epi& E) {
    int tid = threadIdx.x; asm volatile("" : "+v"(tid)); const int wid = __builtin_amdgcn_readfirstlane(tid >> 6), lane = tid & 63, wr = wid >> 2, wc = wid & 3, fr = lane & 15, fq = lane >> 4;
    const int K = g.K, nt = K / BK;
    unsigned voffA[2], voffB[2];
#pragma unroll
    for (int i = 0; i < 2; ++i) { int R, C; stage_rc(tid * 16 + i * 8192, R, C); const int Rb = Epi::PERM ? ((R & ~31) + perm32(R & 31)) : R;
        voffA[i] = (unsigned)(R * K + C) * 2u; voffB[i] = (unsigned)(Rb * K + C) * 2u; }
    const size_t kstep = (size_t)(BK * 2);
    const size_t hstep = (size_t)HALF * K * 2;
    const size_t tstep = 2 * hstep;
    const unsigned ldsw = (unsigned)wid * 1024u;
    const int aoff = lds_byte(wr * 64 + fr, fq * 8), boff = lds_byte(wc * 32 + fr, fq * 8);
#define PG8_SA(b, h) (((b) * 2 + (h)) * HTB)
#define PG8_SB(b, h) ((4 + (b) * 2 + (h)) * HTB)
#define PG8_STAGE(bufoff, gbase, voff) do { _Pragma("unroll") for (int _i = 0; _i < 2; ++_i) \
        __builtin_amdgcn_global_load_lds((const unsigned*)((const char*)(gbase) + (voff)[_i]), (PG8_LAS unsigned*)(lds + (bufoff) + ldsw + _i * 8192), 16, 0, 0); } while (0)
#define PG8_LDA(dst, b, h) do { _Pragma("unroll") for (int m = 0; m < 4; ++m) _Pragma("unroll") for (int k = 0; k < 2; ++k) dst[m][k] = *(const PG8_LAS bf16x8*)(lds + PG8_SA(b, h) + aoff + m * 2048 + k * 1024); } while (0)
#define PG8_LDB(dst, b, h) do { _Pragma("unroll") for (int n = 0; n < 2; ++n) _Pragma("unroll") for (int k = 0; k < 2; ++k) dst[n][k] = *(const PG8_LAS bf16x8*)(lds + PG8_SB(b, h) + boff + n * 2048 + k * 1024); } while (0)
#define PG8_MMA(ai, bj, At, Bt) do { __builtin_amdgcn_s_setprio(1); _Pragma("unroll") for (int m = 0; m < 4; ++m) _Pragma("unroll") for (int n = 0; n < 2; ++n) _Pragma("unroll") for (int k = 0; k < 2; ++k) \
        acc[ai][bj][m][n] = __builtin_amdgcn_mfma_f32_16x16x32_bf16(Bt[n][k], At[m][k], acc[ai][bj][m][n], 0, 0, 0); __builtin_amdgcn_s_setprio(0); } while (0)
#define PG8_WAIT_V(n) asm volatile("s_waitcnt vmcnt(" #n ")" ::: "memory")
#define PG8_WAIT_L(n) asm volatile("s_waitcnt lgkmcnt(" #n ")" ::: "memory")
#define PG8_BAR __builtin_amdgcn_s_barrier()
#define PG8_SCHED __builtin_amdgcn_sched_barrier(0)
    Unit cur, nxt; int ui = 0;
    if (!S.next(0, cur)) return;
    f32x4 acc[2][2][4][2];
#pragma unroll
    for (int a = 0; a < 2; ++a)
#pragma unroll
        for (int b = 0; b < 2; ++b)
#pragma unroll
            for (int m = 0; m < 4; ++m)
#pragma unroll
                for (int n = 0; n < 2; ++n) acc[a][b][m][n] = (f32x4){0.f, 0.f, 0.f, 0.f};
    bf16x8 At[4][2], B0[2][2], B1[2][2];
    const char* cA = (const char*)g.A + (size_t)cur.pm * tstep; const char* cB = (const char*)g.Bt + (size_t)cur.pn * tstep;
    S.a_ready(cur);
    if constexpr (SP2) {
        PG8_STAGE(PG8_SB(0, 0), cB, voffB); PG8_STAGE(PG8_SB(0, 1), cB + hstep, voffB); PG8_STAGE(PG8_SA(0, 0), cA, voffA); PG8_STAGE(PG8_SA(0, 1), cA + hstep, voffA);
        if (wr == 1) PG8_BAR;
        PG8_WAIT_V(2); PG8_BAR;
        PG8_STAGE(PG8_SB(1, 0), cB + kstep, voffB); PG8_STAGE(PG8_SA(1, 0), cA + kstep, voffA); PG8_STAGE(PG8_SB(1, 1), cB + hstep + kstep, voffB);
        PG8_WAIT_V(6); PG8_BAR;
    } else {
        PG8_STAGE(PG8_SB(0, 0), cB, voffB); PG8_STAGE(PG8_SA(0, 0), cA, voffA); PG8_STAGE(PG8_SB(0, 1), cB + hstep, voffB); PG8_STAGE(PG8_SA(0, 1), cA + hstep, voffA);
        if (wr == 1) PG8_BAR;
        PG8_WAIT_V(4); PG8_BAR;
        PG8_STAGE(PG8_SB(1, 0), cB + kstep, voffB); PG8_STAGE(PG8_SA(1, 0), cA + kstep, voffA); PG8_STAGE(PG8_SB(1, 1), cB + hstep + kstep, voffB);
        PG8_WAIT_V(6); PG8_BAR;
    }
    for (;;) {
        const bool has_next = S.next(ui + 1, nxt);
        const char* nA = has_next ? (const char*)g.A + (size_t)nxt.pm * tstep : cA; const char* nB = has_next ? (const char*)g.Bt + (size_t)nxt.pn * tstep : cB;
        for (int t = 0; t < nt; t += 2) {
            const bool last = (t == nt - 2);
            const char* a1 = cA + (size_t)(t + 1) * kstep;
            const char* a2 = last ? nA : cA + (size_t)(t + 2) * kstep; const char* b2 = last ? nB : cB + (size_t)(t + 2) * kstep;
            const char* a3 = a2 + kstep; const char* b3 = b2 + kstep;
            if (last && has_next) S.a_ready(nxt);
            if constexpr (SP2) {
            PG8_LDB(B0, 0, 0); PG8_LDB(B1, 0, 1); PG8_SCHED; PG8_LDA(At, 0, 0); PG8_STAGE(PG8_SA(1, 1), a1 + hstep, voffA);
            PG8_WAIT_V(8); PG8_WAIT_L(0); PG8_BAR; PG8_MMA(0, 0, At, B0); PG8_MMA(0, 1, At, B1); PG8_BAR; PG8_SCHED;
            PG8_LDA(At, 0, 1); PG8_STAGE(PG8_SB(0, 0), b2, voffB); PG8_STAGE(PG8_SB(0, 1), b2 + hstep, voffB); PG8_STAGE(PG8_SA(0, 0), a2, voffA);
            PG8_WAIT_V(8); PG8_WAIT_L(0); PG8_BAR; PG8_MMA(1, 0, At, B0); PG8_MMA(1, 1, At, B1); PG8_BAR; PG8_SCHED;
            PG8_LDB(B0, 1, 0); PG8_LDB(B1, 1, 1); PG8_SCHED; PG8_LDA(At, 1, 0); PG8_STAGE(PG8_SA(0, 1), a2 + hstep, voffA);
            PG8_WAIT_V(8); PG8_WAIT_L(0); PG8_BAR; PG8_MMA(0, 0, At, B0); PG8_MMA(0, 1, At, B1); PG8_BAR; PG8_SCHED;
            PG8_LDA(At, 1, 1); PG8_STAGE(PG8_SB(1, 0), b3, voffB); PG8_STAGE(PG8_SB(1, 1), b3 + hstep, voffB); PG8_STAGE(PG8_SA(1, 0), a3, voffA);
            PG8_WAIT_V(8); PG8_WAIT_L(0); PG8_BAR; PG8_MMA(1, 0, At, B0); PG8_MMA(1, 1, At, B1); PG8_BAR; PG8_SCHED;
            } else {
            PG8_LDB(B0, 0, 0); PG8_SCHED; PG8_LDA(At, 0, 0); PG8_STAGE(PG8_SA(1, 1), a1 + hstep, voffA);
            PG8_WAIT_L(8); PG8_BAR; PG8_WAIT_L(0); PG8_MMA(0, 0, At, B0); PG8_BAR; PG8_SCHED;
            PG8_LDB(B1, 0, 1); PG8_STAGE(PG8_SB(0, 0), b2, voffB);
            PG8_BAR; PG8_WAIT_L(0); PG8_MMA(0, 1, At, B1); PG8_BAR;
            PG8_LDA(At, 0, 1); PG8_STAGE(PG8_SA(0, 0), a2, voffA);
            PG8_BAR; PG8_WAIT_L(0); PG8_MMA(1, 0, At, B0); PG8_BAR; PG8_SCHED;
            PG8_STAGE(PG8_SB(0, 1), b2 + hstep, voffB);
            PG8_WAIT_V(6); PG8_BAR; PG8_MMA(1, 1, At, B1); PG8_BAR;
            PG8_LDB(B0, 1, 0); PG8_SCHED; PG8_LDA(At, 1, 0); PG8_STAGE(PG8_SA(0, 1), a2 + hstep, voffA);
            PG8_WAIT_L(8); PG8_BAR; PG8_WAIT_L(0); PG8_MMA(0, 0, At, B0); PG8_BAR; PG8_SCHED;
            PG8_LDB(B1, 1, 1); PG8_STAGE(PG8_SB(1, 0), b3, voffB);
            PG8_BAR; PG8_WAIT_L(0); PG8_MMA(0, 1, At, B1); PG8_BAR;
            PG8_LDA(At, 1, 1); PG8_STAGE(PG8_SA(1, 0), a3, voffA);
            PG8_BAR; PG8_WAIT_L(0); PG8_MMA(1, 0, At, B0); PG8_BAR; PG8_SCHED;
            PG8_STAGE(PG8_SB(1, 1), b3 + hstep, voffB);
            PG8_WAIT_V(6); PG8_BAR; PG8_MMA(1, 1, At, B1); PG8_BAR;
            }
        }
        if constexpr (ALIGN_EPI) { if (wr == 0) PG8_BAR; }
        if constexpr (!Epi::AFTER_DRAIN) { E(acc, cur, wr, wc, fr, fq); S.done(cur); }
        if (!has_next) break;
#pragma unroll
        for (int a = 0; a < 2; ++a)
#pragma unroll
            for (int b = 0; b < 2; ++b)
#pragma unroll
                for (int m = 0; m < 4; ++m)
#pragma unroll
                    for (int n = 0; n < 2; ++n) acc[a][b][m][n] = (f32x4){0.f, 0.f, 0.f, 0.f};
        cur = nxt; cA = nA; cB = nB; ++ui;
        if constexpr (ALIGN_EPI) { if (wr == 1) PG8_BAR; }
    }
    PG8_WAIT_V(0);
    if constexpr (!ALIGN_EPI) { if (wr == 0) PG8_BAR; }
    PG8_BAR;
    if constexpr (Epi::AFTER_DRAIN) { E.fused(acc, cur, wr, wc, fr, fq, lds, wid, lane); S.done(cur); }
#undef PG8_SA
#undef PG8_SB
#undef PG8_STAGE
#undef PG8_LDA
#undef PG8_LDB
#undef PG8_MMA
#undef PG8_WAIT_V
#undef PG8_WAIT_L
#undef PG8_BAR
#undef PG8_SCHED
}
}

#define LAS __attribute__((address_space(3)))
typedef unsigned short bf16_t;
typedef short bf16x8 __attribute__((ext_vector_type(8)));
typedef float f32x4 __attribute__((ext_vector_type(4)));
typedef float f32x16 __attribute__((ext_vector_type(16)));
typedef unsigned u32x4 __attribute__((ext_vector_type(4)));
typedef unsigned u32x2 __attribute__((ext_vector_type(2)));

#define XB_TMO      128
#define XB_XCNT(j)  (256  + 64 * (j))
#define XB_XSUB(j)  (1280 + 64 * (j))
#define XB_XGEN(j)  (2304 + 64 * (j))
#define XB_TOP      3328
#define XB_TOPGEN   3392
#define XCD_BAR_WORDS 3456
#define XB_SPIN_CAP (1u << 18)

__device__ __forceinline__ unsigned xb_ld(unsigned* p)              { return __hip_atomic_load(p, __ATOMIC_RELAXED, __HIP_MEMORY_SCOPE_AGENT); }
__device__ __forceinline__ unsigned xb_add(unsigned* p, unsigned v) { return __hip_atomic_fetch_add(p, v, __ATOMIC_RELAXED, __HIP_MEMORY_SCOPE_AGENT); }
__device__ __forceinline__ unsigned xb_xcc_id() { return (unsigned)__builtin_amdgcn_s_getreg((3 << 11) | 20) & 0xFu; }
#define XB_SPIN(cond, bar) do { unsigned _sp = 0; while (cond) { __builtin_amdgcn_s_sleep(1); \
    if ((++_sp & 255u) == 0u) { if (xb_ld(&(bar)[XB_TMO])) break; if (_sp > XB_SPIN_CAP) { atomicAdd(&(bar)[XB_TMO], 1u); break; } } } } while (0)

struct XcdBarrier {
    unsigned* bar; unsigned x;
    volatile LAS unsigned* st;
};

__device__ __forceinline__ XcdBarrier xcd_barrier_post(unsigned* bar, volatile LAS unsigned* st) {
    XcdBarrier b; b.bar = bar; b.x = xb_xcc_id(); b.st = st;
    if (threadIdx.x == 0) (void)xb_add(&bar[XB_XCNT(b.x)], 1u);
    return b;
}
__device__ __forceinline__ void xcd_barrier_complete(unsigned* bar, unsigned x, unsigned& nloc, unsigned& nx) {
    const unsigned G = gridDim.x * gridDim.y * gridDim.z;
    unsigned sum, cnt, mine, sp = 0u;
    for (;;) {
        sum = 0u; cnt = 0u; mine = 0u;
#pragma unroll
        for (unsigned j = 0; j < 16; ++j) { const unsigned c = xb_ld(&bar[XB_XCNT(j)]); sum += c; cnt += (c > 0u) ? 1u : 0u; mine = (j == x) ? c : mine; }
        if (sum == G) break;
        __builtin_amdgcn_s_sleep(1);
        if ((++sp & 255u) == 0u) { if (xb_ld(&bar[XB_TMO])) break; if (sp > XB_SPIN_CAP) { atomicAdd(&bar[XB_TMO], 1u); break; } }
    }
    nloc = mine > 0u ? mine : 1u; nx = cnt > 0u ? cnt : 1u;
}

__device__ __forceinline__ void xcd_barrier(const XcdBarrier& b) {
    asm volatile("s_waitcnt vmcnt(0)" ::: "memory");
    __syncthreads();
    if (threadIdx.x == 0) {
        unsigned* bar = b.bar;
        __builtin_amdgcn_s_waitcnt(0);
        unsigned nloc = b.st[0], nx = b.st[1];
        if (nloc == 0u) { xcd_barrier_complete(bar, b.x, nloc, nx); b.st[0] = nloc; b.st[1] = nx; }
        const unsigned old = xb_add(&bar[XB_XSUB(b.x)], 1u);
        const unsigned gen = old / nloc;
        if (old + 1u == (gen + 1u) * nloc) {
            __builtin_amdgcn_fence(__ATOMIC_RELEASE, "agent");
            asm volatile("s_waitcnt vmcnt(0)" ::: "memory");
            const unsigned og = xb_add(&bar[XB_TOP], 1u);
            const unsigned tg = og / nx;
            if (og + 1u == (tg + 1u) * nx) xb_add(&bar[XB_TOPGEN], 1u);
            else XB_SPIN(xb_ld(&bar[XB_TOPGEN]) == tg, bar);
            __builtin_amdgcn_fence(__ATOMIC_ACQUIRE, "agent");
            xb_add(&bar[XB_XGEN(b.x)], 1u);
            asm volatile("s_waitcnt vmcnt(0)" ::: "memory");
        } else {
            XB_SPIN(xb_ld(&bar[XB_XGEN(b.x)]) == gen, bar);
            __builtin_amdgcn_fence(__ATOMIC_ACQUIRE, "agent");
            asm volatile("s_waitcnt vmcnt(0)" ::: "memory");
        }
    }
    __syncthreads();
}


constexpr int DM = 1024, NTOK_P = 16384, NTOK = 17408, DIN = 3080, NPROJ = 3072, DFF = 2816, NGU = 5632;
constexpr int NWAVES = 8, NTHR = 512;
constexpr int PROBE = 0;
constexpr int LDS_BYTES = 147456;
constexpr size_t MiB = 1u << 20;
constexpr size_t WS_CTL = 0, CTL_BYTES = 1 * MiB, WS_SS1 = 65536;
constexpr size_t WS_WIN = 1 * MiB, WS_WOUT = 7 * MiB, WS_WGU = 9 * MiB, WS_WDN = 20 * MiB;
constexpr size_t WS_RGW = 25 * MiB + 512 * 1024;
constexpr size_t WS_BETA = 26 * MiB, WS_G = 26 * MiB + 512 * 1024, WS_GL = 26 * MiB + 896 * 1024;
constexpr size_t WS_SEGA = 27 * MiB, WS_SEGH = 27 * MiB + 512 * 1024;
constexpr size_t WS_HN = 28 * MiB, WS_WF = 28 * MiB, WS_QDF = 44 * MiB, WS_X1B = 28 * MiB;
constexpr size_t WS_PROJ = 62 * MiB, WS_ACT = 62 * MiB;
constexpr size_t WS_MIX = 164 * MiB, WS_GA = 198 * MiB, WS_KTF = 214 * MiB, WS_QKF = 230 * MiB, WS_UB = 238 * MiB, WS_END = 254 * MiB;
constexpr size_t OUT_Y = 0, OUT_PRC = 17825792, OUT_PRH = 17838080, OUT_PGC = 17842176, OUT_PGS = 17879040,
                 OUT_SRC = 18403328, OUT_SRH = 18599936, OUT_SGC = 18665472, OUT_SGS = 19255296;

struct Params { const float* in[25]; float* out; unsigned char* ws; };
enum { I_XP = 0, I_XS, I_SRC, I_SRH, I_SGC, I_SGS, I_NORM1, I_WIN, I_RCW, I_RCB, I_RWA, I_RBA, I_RWI, I_RBI, I_LAM, I_GCW, I_ALOG, I_DTB, I_GNW, I_WOUT, I_NORM2, I_WG, I_WU, I_WD, I_FN };

#define DI __device__ __forceinline__
#define KAS __attribute__((address_space(4)))
DI Params load_params() {
#if defined(__HIP_DEVICE_COMPILE__)
    const KAS unsigned char* ka = (const KAS unsigned char*)__builtin_amdgcn_kernarg_segment_ptr(); asm volatile("" : "+s"(ka)); return *(const KAS Params*)ka;
#else
    return Params{};
#endif
}
template <class T> DI T vlaunder(T p) { asm volatile("" : "+v"(p)); return p; }
DI int tid_() { int t = threadIdx.x; asm volatile("" : "+v"(t)); return t; }
DI unsigned f2bf(float f) { unsigned u = __float_as_uint(f); return (u + 0x7fffu + ((u >> 16) & 1u)) >> 16; }
DI unsigned pk2(float lo, float hi) { return f2bf(lo) | (f2bf(hi) << 16); }
DI float bf2f(bf16_t b) { return __uint_as_float(((unsigned)b) << 16); }
DI float wave_sum(float v) {
#pragma unroll
    for (int o = 1; o < 64; o <<= 1) v += __shfl_xor(v, o);
    return v;
}
DI float sigm(float x) { return 1.f / (1.f + __expf(-x)); }
DI float silu(float x) { return x / (1.f + __expf(-x)); }
DI float softplus(float x) { return x > 20.f ? x : log1pf(__expf(x)); }
DI float gelu_tanh(float x) { const float u = 0.7978845608028654f * (x + 0.044715f * x * x * x); const float t = 1.f - 2.f / (1.f + __expf(2.f * u)); return 0.5f * x * (1.f + t); }
DI int crow(int reg, int hh) { return (reg & 3) + 8 * (reg >> 2) + 4 * hh; }
DI bf16x8 pack8(f32x4 a, f32x4 b) { u32x4 p; p.x = pk2(a.x, a.y); p.y = pk2(a.z, a.w); p.z = pk2(b.x, b.y); p.w = pk2(b.z, b.w); return __builtin_bit_cast(bf16x8, p); }
DI bf16x8 pack8v(const float* v) { u32x4 p; p.x = pk2(v[0], v[1]); p.y = pk2(v[2], v[3]); p.z = pk2(v[4], v[5]); p.w = pk2(v[6], v[7]); return __builtin_bit_cast(bf16x8, p); }
#define MFMA32(a, b, c) __builtin_amdgcn_mfma_f32_32x32x16_bf16((a), (b), (c), 0, 0, 0)
DI bf16x8 pack_step(const f32x16& x, int s) {
    u32x4 p;
    p.x = pk2(x[8 * s + 0], x[8 * s + 1]); p.y = pk2(x[8 * s + 2], x[8 * s + 3]); p.z = pk2(x[8 * s + 4], x[8 * s + 5]); p.w = pk2(x[8 * s + 6], x[8 * s + 7]);
    return __builtin_bit_cast(bf16x8, p);
}
DI f32x16 zero16() { f32x16 z;
#pragma unroll
    for (int i = 0; i < 16; ++i) z[i] = 0.f;
    return z; }

struct EpiProj {
    static constexpr bool PERM = true, AFTER_DRAIN = false;
    bf16_t* O; int ldc;
    DI void operator()(const f32x4 (&acc)[2][2][4][2], const pg8::Unit& u, int wr, int wc, int fr, int fq) const {
        const int row0 = u.pm * 256 + wr * 64 + fr, col0 = u.pn * 256 + wc * 32 + 8 * fq;
#pragma unroll
        for (int ai = 0; ai < 2; ++ai)
#pragma unroll
            for (int m = 0; m < 4; ++m) { bf16_t* rowp = O + (size_t)(row0 + ai * 128 + m * 16) * ldc + col0;
#pragma unroll
                for (int bj = 0; bj < 2; ++bj) { const f32x4 v0 = acc[ai][bj][m][0], v1 = acc[ai][bj][m][1];
                    u32x4 w; w.x = pg8::cvt_pk_bf16(v0[0], v0[1]); w.y = pg8::cvt_pk_bf16(v0[2], v0[3]); w.z = pg8::cvt_pk_bf16(v1[0], v1[1]); w.w = pg8::cvt_pk_bf16(v1[2], v1[3]);
                    *(u32x4*)(rowp + bj * 128) = w; } }
    }
};
struct EpiX1 {
    static constexpr bool PERM = false, AFTER_DRAIN = false;
    const float* xp; const float* xs; float* Y; bf16_t* X1B; float* SS1;
    DI void operator()(const f32x4 (&acc)[2][2][4][2], const pg8::Unit& u, int wr, int wc, int fr, int fq) const {
        const int row0 = u.pm * 256 + wr * 64 + fr, col0 = u.pn * 256 + wc * 32 + 4 * fq;
#pragma unroll
        for (int ai = 0; ai < 2; ++ai)
#pragma unroll
            for (int m = 0; m < 4; ++m) { const int row = row0 + ai * 128 + m * 16;
                const float* xin = (row < NTOK_P ? xp + (size_t)row * DM : xs + (size_t)(row - NTOK_P) * DM) + col0;
                float* yp = Y + (size_t)row * DM + col0; bf16_t* bp = X1B + (size_t)row * DM + col0; float ss = 0.f;
#pragma unroll
                for (int bj = 0; bj < 2; ++bj)
#pragma unroll
                    for (int n = 0; n < 2; ++n) { const f32x4 v = acc[ai][bj][m][n] + *(const f32x4*)(xin + bj * 128 + n * 16);
                        *(f32x4*)(yp + bj * 128 + n * 16) = v; u32x2 w; w.x = pg8::cvt_pk_bf16(v[0], v[1]); w.y = pg8::cvt_pk_bf16(v[2], v[3]);
                        *(u32x2*)(bp + bj * 128 + n * 16) = w; ss += (v[0] * v[0] + v[1] * v[1]) + (v[2] * v[2] + v[3] * v[3]); }
                ss += __shfl_xor(ss, 16); ss += __shfl_xor(ss, 32);
                if (fq == 0) atomicAdd(SS1 + row, ss); }
    }
};
struct EpiAct {
    static constexpr bool PERM = true, AFTER_DRAIN = false;
    bf16_t* ACT; const float* SS1;
    DI void operator()(const f32x4 (&acc)[2][2][4][2], const pg8::Unit& u, int wr, int wc, int fr, int fq) const {
        const int row0 = u.pm * 256 + wr * 64 + fr, col0 = u.pn * 256 + wc * 32 + 8 * fq;
#pragma unroll
        for (int ai = 0; ai < 2; ++ai)
#pragma unroll
            for (int m = 0; m < 4; ++m) { const int row = row0 + ai * 128 + m * 16; const float rstd = rsqrtf(SS1[row] * (1.f / DM) + 1e-6f);
                bf16_t* rowp = ACT + (size_t)row * DFF + (col0 >> 1);
#pragma unroll
                for (int bj = 0; bj < 2; ++bj) { const f32x4 v0 = acc[ai][bj][m][0] * rstd, v1 = acc[ai][bj][m][1] * rstd;
                    u32x2 w; w.x = pg8::cvt_pk_bf16(silu(v0[0]) * v0[1], silu(v0[2]) * v0[3]); w.y = pg8::cvt_pk_bf16(silu(v1[0]) * v1[1], silu(v1[2]) * v1[3]);
                    *(u32x2*)(rowp + bj * 64) = w; } }
    }
};
struct EpiX2 {
    static constexpr bool PERM = false, AFTER_DRAIN = false;
    float* Y;
    DI void operator()(const f32x4 (&acc)[2][2][4][2], const pg8::Unit& u, int wr, int wc, int fr, int fq) const {
        const int row0 = u.pm * 256 + wr * 64 + fr, col0 = u.pn * 256 + wc * 32 + 4 * fq;
#pragma unroll
        for (int ai = 0; ai < 2; ++ai)
#pragma unroll
            for (int m = 0; m < 4; ++m) { float* yp = Y + (size_t)(row0 + ai * 128 + m * 16) * DM + col0;
#pragma unroll
                for (int bj = 0; bj < 2; ++bj)
#pragma unroll
                    for (int n = 0; n < 2; ++n) { f32x4* p = (f32x4*)(yp + bj * 128 + n * 16); *p = *p + acc[ai][bj][m][n]; } }
    }
};

DI void p0_transpose_item(const float* W, int ldw, int nblk, int K, bf16_t* WT, int rmul, int radd, const float* ksc, LAS float* scr, int item, int lane) {
    const int kb = item / nblk, nb = item % nblk, k0 = 64 * kb, n0 = 32 * nb;
#pragma unroll 8
    for (int i = 0; i < 32; ++i) { const int kk = 2 * i + (lane >> 5); float v = W[(size_t)(k0 + kk) * ldw + n0 + (lane & 31)]; if (ksc) v *= ksc[k0 + kk]; scr[kk * 33 + (lane & 31)] = v; }
    asm volatile("s_waitcnt lgkmcnt(0)" ::: "memory");
    const int c = lane & 7;
#pragma unroll
    for (int j = 0; j < 4; ++j) { const int n = (lane >> 3) + 8 * j; const LAS float* s = scr + (8 * c) * 33 + n;
        u32x4 o; o.x = pk2(s[0 * 33], s[1 * 33]); o.y = pk2(s[2 * 33], s[3 * 33]); o.z = pk2(s[4 * 33], s[5 * 33]); o.w = pk2(s[6 * 33], s[7 * 33]);
        *(u32x4*)(WT + (size_t)((n0 + n) * rmul + radd) * K + k0 + 8 * c) = o; }
    asm volatile("s_waitcnt lgkmcnt(0)" ::: "memory");
}
DI void phase0(const Params& P, LAS unsigned char* lds) {
    const int tid = tid_(), lane = tid & 63, wave = tid >> 6, G = gridDim.x;
    unsigned char* ws = P.ws;
    LAS float* scr = (LAS float*)(lds + wave * 16384);
    const int gw = blockIdx.x * NWAVES + wave, NGW = G * NWAVES;
    constexpr int I_IN = 16 * 96, I_OUT = 16 * 32, I_G = 16 * 88, I_D = 44 * 32, NIT = I_IN + I_OUT + 2 * I_G + I_D;
    for (int it = gw; it < NIT; it += NGW) {
        int r = it;
        if (r < I_IN) { p0_transpose_item(P.in[I_WIN], DIN, 96, DM, (bf16_t*)(ws + WS_WIN), 1, 0, nullptr, scr, r, lane); continue; } r -= I_IN;
        if (r < I_OUT) { p0_transpose_item(P.in[I_WOUT], DM, 32, DM, (bf16_t*)(ws + WS_WOUT), 1, 0, nullptr, scr, r, lane); continue; } r -= I_OUT;
        if (r < I_G) { p0_transpose_item(P.in[I_WG], DFF, 88, DM, (bf16_t*)(ws + WS_WGU), 2, 0, P.in[I_NORM2], scr, r, lane); continue; } r -= I_G;
        if (r < I_G) { p0_transpose_item(P.in[I_WU], DFF, 88, DM, (bf16_t*)(ws + WS_WGU), 2, 1, P.in[I_NORM2], scr, r, lane); continue; } r -= I_G;
        p0_transpose_item(P.in[I_WD], DM, 32, DFF, (bf16_t*)(ws + WS_WDN), 1, 0, nullptr, scr, r, lane);
    }
    for (int s = blockIdx.x * NTHR + tid; s < 8192; s += G * NTHR) {
        const int l = s & 63, f = s >> 6, ks = f & 3, nt = (f >> 2) & 1, hb = (f >> 3) & 7, mat = f >> 6;
        const float* w = (mat ? P.in[I_RWI] : P.in[I_RWA]) + hb * 4096 + (16 * ks + 8 * (l >> 5)) * 64 + 32 * nt + (l & 31);
        u32x4 o; o.x = pk2(w[0], w[64]); o.y = pk2(w[128], w[192]); o.z = pk2(w[256], w[320]); o.w = pk2(w[384], w[448]);
        *(u32x4*)(ws + WS_RGW + (size_t)s * 16) = o;
    }
    __syncthreads();
    LAS float* EXT = (LAS float*)lds;
    for (int i = tid; i < 8192; i += NTHR) { const int k = i >> 3, c = i & 7, l = (k & 255) >> 2, q = k & 3, j = k >> 8;
        EXT[(((j * 4 + q) * 64 + l) << 3) + c] = P.in[I_WIN][(size_t)k * DIN + NPROJ + c]; }
    __syncthreads();
    const float* n1 = P.in[I_NORM1];
    f32x4 nw[4];
#pragma unroll
    for (int j = 0; j < 4; ++j) nw[j] = *(const f32x4*)(n1 + 4 * lane + 256 * j);
    for (int m = gw; m < NTOK; m += NGW) {
        const float* xrow = (m < NTOK_P) ? P.in[I_XP] + (size_t)m * DM : P.in[I_XS] + (size_t)(m - NTOK_P) * DM;
        f32x4 v[4]; float s = 0.f;
#pragma unroll
        for (int j = 0; j < 4; ++j) { v[j] = *(const f32x4*)(xrow + 4 * lane + 256 * j); s += (v[j].x * v[j].x + v[j].y * v[j].y) + (v[j].z * v[j].z + v[j].w * v[j].w); }
        const float rstd = rsqrtf(wave_sum(s) * (1.f / DM) + 1e-6f);
        float e[8];
#pragma unroll
        for (int c = 0; c < 8; ++c) e[c] = 0.f;
        bf16_t* orow = (bf16_t*)(ws + WS_HN) + (size_t)m * DM;
#pragma unroll
        for (int j = 0; j < 4; ++j) { v[j] = v[j] * rstd * nw[j];
            u32x2 w; w.x = pk2(v[j].x, v[j].y); w.y = pk2(v[j].z, v[j].w); *(u32x2*)(orow + 4 * lane + 256 * j) = w;
#pragma unroll
            for (int q = 0; q < 4; ++q) { const LAS f32x4* ep = (const LAS f32x4*)(EXT + (((j * 4 + q) * 64 + lane) << 3)); const f32x4 e0 = ep[0], e1 = ep[1]; const float hv = v[j][q];
                e[0] += hv * e0.x; e[1] += hv * e0.y; e[2] += hv * e0.z; e[3] += hv * e0.w; e[4] += hv * e1.x; e[5] += hv * e1.y; e[6] += hv * e1.z; e[7] += hv * e1.w; } }
#pragma unroll
        for (int c = 0; c < 8; ++c) e[c] = wave_sum(e[c]);
        if (lane < 4) { float sv = lane == 0 ? e[0] : lane == 1 ? e[1] : lane == 2 ? e[2] : e[3]; ((float*)(ws + WS_BETA))[m * 4 + lane] = sigm(sv); }
        else if (lane < 8) { const int hh = lane - 4; float sv = hh == 0 ? e[4] : hh == 1 ? e[5] : hh == 2 ? e[6] : e[7];
            ((float*)(ws + WS_G))[m * 4 + hh] = -__expf(P.in[I_ALOG][hh]) * softplus(sv + P.in[I_DTB][hh]); }
    }
}

DI void gdn_chunk_item(const Params& P, LAS unsigned char* lds, int item) {
    const int tid = tid_(), lane = tid & 63, wave = tid >> 6;
    const int h = item & 3, bn = item >> 2, b = bn >> 5, n = bn & 31;
    const int m0 = b * 2048 + n * 64, cid = (b * 4 + h) * 32 + n;
    unsigned char* ws = P.ws;
    LAS float* QT = (LAS float*)lds; LAS float* KT = QT + 64 * 132; LAS float* VT = KT + 64 * 132;
    LAS float* LM = VT + 64 * 132; LAS float* QKM = LM + 64 * 68; LAS float* SM = QKM + 64 * 68;
    const bf16_t* PROJ = (const bf16_t*)(ws + WS_PROJ);
    if (tid < 384) {
        const int cg8 = tid % 48, tg = tid / 48, mat = cg8 >> 4, d0 = (cg8 & 15) * 8, ch = mat * 512 + h * 128 + d0;
        const bf16_t* src = PROJ + (size_t)(m0 + 8 * tg) * NPROJ + 1024 + ch;
        u32x4 raw[11];
        const bool hist = (n > 0 || tg > 0);
#pragma unroll
        for (int q = 0; q < 11; ++q) { if (q >= 3 || hist) raw[q] = *(const u32x4*)(src + (q - 3) * NPROJ); else raw[q] = (u32x4){0u, 0u, 0u, 0u}; }
        const float* cw = P.in[I_GCW] + ch;
        f32x4 wv[4][2];
#pragma unroll
        for (int j = 0; j < 4; ++j) { wv[j][0] = *(const f32x4*)(cw + j * 1536); wv[j][1] = *(const f32x4*)(cw + j * 1536 + 4); }
        LAS float* T = QT + mat * (64 * 132);
#pragma unroll
        for (int i = 0; i < 8; ++i) {
            f32x4 y0 = (f32x4){0.f, 0.f, 0.f, 0.f}, y1 = y0;
#pragma unroll
            for (int j = 0; j < 4; ++j) { const u32x4 x = raw[i + j];
                const f32x4 xa = (f32x4){__uint_as_float(x.x << 16), __uint_as_float(x.x & 0xffff0000u), __uint_as_float(x.y << 16), __uint_as_float(x.y & 0xffff0000u)};
                const f32x4 xb = (f32x4){__uint_as_float(x.z << 16), __uint_as_float(x.z & 0xffff0000u), __uint_as_float(x.w << 16), __uint_as_float(x.w & 0xffff0000u)};
                y0 += wv[j][0] * xa; y1 += wv[j][1] * xb; }
            f32x4 s0, s1;
#pragma unroll
            for (int e = 0; e < 4; ++e) { s0[e] = silu(y0[e]); s1[e] = silu(y1[e]); }
            *(LAS f32x4*)(T + (8 * tg + i) * 132 + d0) = s0; *(LAS f32x4*)(T + (8 * tg + i) * 132 + d0 + 4) = s1;
            if (n == 31 && tg == 7 && i >= 5) { const u32x4 x = raw[i + 3]; float* op = P.out + OUT_PGC + (size_t)(b * 3 + (i - 5)) * 1536 + ch;
                *(f32x4*)op = (f32x4){__uint_as_float(x.x << 16), __uint_as_float(x.x & 0xffff0000u), __uint_as_float(x.y << 16), __uint_as_float(x.y & 0xffff0000u)};
                *(f32x4*)(op + 4) = (f32x4){__uint_as_float(x.z << 16), __uint_as_float(x.z & 0xffff0000u), __uint_as_float(x.w << 16), __uint_as_float(x.w & 0xffff0000u)}; }
        }
    }
    if (tid < 64) {
        SM[128 + tid] = ((const float*)(ws + WS_BETA))[(m0 + tid) * 4 + h];
        float g = ((const float*)(ws + WS_G))[(m0 + tid) * 4 + h];
#pragma unroll
        for (int o = 1; o < 64; o <<= 1) { const float t = __shfl_up(g, o); if (lane >= o) g += t; }
        SM[tid] = g; SM[64 + tid] = __expf(g);
    }
    __syncthreads();
#pragma unroll 1
    for (int k = 0; k < 8; ++k) {
        const int i = 8 * wave + k;
        const float q0 = QT[i * 132 + lane], q1 = QT[i * 132 + 64 + lane], k0 = KT[i * 132 + lane], k1 = KT[i * 132 + 64 + lane];
        const float rq = rsqrtf(wave_sum(q0 * q0 + q1 * q1) + 1e-6f) * 0.08838834764831845f, rk = rsqrtf(wave_sum(k0 * k0 + k1 * k1) + 1e-6f);
        QT[i * 132 + lane] = q0 * rq; QT[i * 132 + 64 + lane] = q1 * rq; KT[i * 132 + lane] = k0 * rk; KT[i * 132 + 64 + lane] = k1 * rk;
    }
    __syncthreads();
    {
        const int which = wave >> 2, it = (wave >> 1) & 1, jt = wave & 1, r = lane & 31, hh = lane >> 5;
        LAS float* dst = which ? QKM : LM;
        f32x16 acc = zero16();
        if (!(it == 0 && jt == 1)) {
            const LAS float* Ar = (which ? QT : KT) + (32 * it + r) * 132 + 8 * hh;
            const LAS float* Br = KT + (32 * jt + r) * 132 + 8 * hh;
#pragma unroll
            for (int ks = 0; ks < 8; ++ks) {
                const bf16x8 a = pack8(*(const LAS f32x4*)(Ar + 16 * ks), *(const LAS f32x4*)(Ar + 16 * ks + 4));
                const bf16x8 bb = pack8(*(const LAS f32x4*)(Br + 16 * ks), *(const LAS f32x4*)(Br + 16 * ks + 4));
                acc = MFMA32(a, bb, acc);
            }
        }
        const int j = 32 * jt + r; const float gcj = SM[j];
#pragma unroll
        for (int reg = 0; reg < 16; ++reg) {
            const int i = 32 * it + crow(reg, hh); const float gci = SM[i];
            float v = 0.f;
            if (which == 0) { if (j < i) v = acc[reg] * SM[128 + i] * __expf(gci - gcj); }
            else { if (j <= i) v = acc[reg] * __expf(gci - gcj); }
            dst[i * 68 + j] = v;
        }
    }
    __syncthreads();
    {
        const float gcl = SM[63];
        bf16_t* QDF = (bf16_t*)(ws + WS_QDF) + (size_t)cid * 8192; bf16_t* KTF = (bf16_t*)(ws + WS_KTF) + (size_t)cid * 8192; bf16_t* QKF = (bf16_t*)(ws + WS_QKF) + (size_t)cid * 4096;
#pragma unroll 1
        for (int s = tid; s < 2560; s += NTHR) {
            const int l = s & 63, r = l & 31, hh = l >> 5, f = s >> 6;
            float v[8];
            if (f < 16) { const int mt = f >> 3, kk = f & 7, c = 32 * mt + r, db = 16 * kk + 4 * hh; const float sc = SM[64 + c];
#pragma unroll
                for (int e = 0; e < 8; ++e) v[e] = QT[c * 132 + db + 8 * (e >> 2) + (e & 3)] * sc;
                *(bf16x8*)(QDF + f * 512 + l * 8) = pack8v(v);
            } else if (f < 32) { const int f2 = f - 16, dmt = f2 >> 2, ks = f2 & 3, d = 32 * dmt + r, cb = 16 * ks + 4 * hh;
#pragma unroll
                for (int e = 0; e < 8; ++e) { const int c = cb + 8 * (e >> 2) + (e & 3); v[e] = KT[c * 132 + d] * __expf(gcl - SM[c]); }
                *(bf16x8*)(KTF + f2 * 512 + l * 8) = pack8v(v);
            } else { const int f3 = f - 32, mt = f3 >> 2, ks = f3 & 3, i = 32 * mt + r, cb = 16 * ks + 4 * hh;
#pragma unroll
                for (int e = 0; e < 8; ++e) v[e] = QKM[i * 68 + cb + 8 * (e >> 2) + (e & 3)];
                *(bf16x8*)(QKF + f3 * 512 + l * 8) = pack8v(v);
            }
        }
        if (tid == 0) ((float*)(ws + WS_GL))[cid] = __expf(gcl);
    }
    __syncthreads();
    if (tid < 256) {
        const bool isw = tid >= 128; const int ci = tid & 127;
        LAS float* Tc = vlaunder((isw ? KT : VT) + ci);
        const LAS float* LMv = vlaunder(LM); const LAS float* SMv = vlaunder(SM);
        float x[64];
#pragma unroll
        for (int i = 0; i < 64; ++i) {
            float rhs = Tc[i * 132] * SMv[128 + i]; if (isw) rhs *= SMv[64 + i];
            float a0 = rhs, a1 = 0.f, a2 = 0.f, a3 = 0.f;
#pragma unroll
            for (int j4 = 0; j4 < (i + 3) / 4; ++j4) { const f32x4 l4 = *(const LAS f32x4*)(LMv + i * 68 + 4 * j4);
                if (4 * j4 + 0 < i) a0 -= l4.x * x[4 * j4 + 0]; if (4 * j4 + 1 < i) a1 -= l4.y * x[4 * j4 + 1];
                if (4 * j4 + 2 < i) a2 -= l4.z * x[4 * j4 + 2]; if (4 * j4 + 3 < i) a3 -= l4.w * x[4 * j4 + 3]; }
            x[i] = (a0 + a1) + (a2 + a3); Tc[i * 132] = x[i];
        }
    }
    __syncthreads();
    {
        bf16_t* WF = (bf16_t*)(ws + WS_WF) + (size_t)cid * 8192; bf16_t* UB = (bf16_t*)(ws + WS_UB) + (size_t)cid * 8192;
#pragma unroll 1
        for (int s = tid; s < 2048; s += NTHR) {
            float v[8];
            if (s < 1024) { const int l = s & 63, r = l & 31, hh = l >> 5, f = s >> 6, mt = f >> 3, kk = f & 7, c = 32 * mt + r, db = 16 * kk + 4 * hh;
#pragma unroll
                for (int e = 0; e < 8; ++e) v[e] = -KT[c * 132 + db + 8 * (e >> 2) + (e & 3)];
                *(bf16x8*)(WF + f * 512 + l * 8) = pack8v(v);
            } else { const int s2 = s - 1024, esmt = s2 >> 7, l = (s2 >> 1) & 63, half = s2 & 1, es = esmt >> 1, mt = esmt & 1;
#pragma unroll
                for (int e = 0; e < 8; ++e) v[e] = VT[(32 * mt + crow(8 * half + e, l >> 5)) * 132 + 32 * es + (l & 31)];
                *(bf16x8*)(UB + (esmt * 64 + l) * 16 + 8 * half) = pack8v(v);
            }
        }
    }
    __syncthreads();
}

DI void rg_tile_item(const Params& P, LAS unsigned char* lds, int T) {
    const int tid = tid_(), lane = tid & 63, wave = tid >> 6, r = lane & 31, hh = lane >> 5;
    unsigned char* ws = P.ws;
    LAS bf16_t* XC = (LAS bf16_t*)lds + wave * (64 * 72);
    const bf16_t* PROJ = (const bf16_t*)(ws + WS_PROJ);
    const int m0 = 64 * T; const bool prm = T < 256; const int sq0 = prm ? 0 : (m0 - NTOK_P) / 8;
    {
        const int c = 64 * wave + lane;
        const float* cw = P.in[I_RCW]; const float w0 = cw[c], w1 = cw[512 + c], w2 = cw[1024 + c], w3 = cw[1536 + c], cb = P.in[I_RCB][c];
        const bf16_t* src = PROJ + (size_t)m0 * NPROJ + c;
        float x3 = 0.f, x2 = 0.f, x1 = 0.f;
        if (prm && (T & 31) != 0) { x3 = bf2f(src[-3 * NPROJ]); x2 = bf2f(src[-2 * NPROJ]); x1 = bf2f(src[-NPROJ]); }
        const float* rcs = P.in[I_SRC];
        float xr[64];
#pragma unroll
        for (int i = 0; i < 64; ++i) xr[i] = bf2f(src[i * NPROJ]);
#pragma unroll
        for (int i = 0; i < 64; ++i) {
            const int seq = sq0 + (i >> 3);
            if (!prm && (i & 7) == 0) { x3 = rcs[(size_t)(seq * 3 + 0) * 512 + c]; x2 = rcs[(size_t)(seq * 3 + 1) * 512 + c]; x1 = rcs[(size_t)(seq * 3 + 2) * 512 + c]; }
            const float x0 = xr[i];
            XC[i * 72 + lane] = (bf16_t)f2bf(w0 * x3 + w1 * x2 + w2 * x1 + w3 * x0 + cb);
            if (prm) { if ((T & 31) == 31 && i >= 61) P.out[OUT_PRC + (size_t)((T >> 5) * 3 + (i - 61)) * 512 + c] = x0; }
            else { if ((i & 7) >= 5) P.out[OUT_SRC + (size_t)(seq * 3 + (i & 7) - 5) * 512 + c] = x0; }
            x3 = x2; x2 = x1; x1 = x0;
        }
    }
    asm volatile("s_waitcnt lgkmcnt(0)" ::: "memory");
    const bf16x8* RGW = (const bf16x8*)(ws + WS_RGW);
#pragma unroll 1
    for (int nt = 0; nt < 2; ++nt) {
        f32x16 aa[2], ai[2]; aa[0] = zero16(); aa[1] = zero16(); ai[0] = zero16(); ai[1] = zero16();
#pragma unroll
        for (int ks = 0; ks < 4; ++ks) {
            const bf16x8 bfa = RGW[(((0 * 8 + wave) * 2 + nt) * 4 + ks) * 64 + lane], bfi = RGW[(((1 * 8 + wave) * 2 + nt) * 4 + ks) * 64 + lane];
#pragma unroll
            for (int mt = 0; mt < 2; ++mt) { const bf16x8 a = *(const LAS bf16x8*)(XC + (32 * mt + r) * 72 + 16 * ks + 8 * hh);
                aa[mt] = MFMA32(a, bfa, aa[mt]); ai[mt] = MFMA32(a, bfi, ai[mt]); }
        }
        const int j = 64 * wave + 32 * nt + r;
        const float ba = P.in[I_RBA][j], bi = P.in[I_RBI][j], spl = -8.f * softplus(-P.in[I_LAM][j]);
        float Cc = 0.f, Pp = 1.f;
        const bf16_t* projb = PROJ + (size_t)(m0 + 4 * hh) * NPROJ + 512 + j;
        bf16_t yv[32];
#pragma unroll
        for (int q = 0; q < 32; ++q) yv[q] = projb[(size_t)(32 * (q >> 4) + 8 * ((q >> 2) & 3) + (q & 3)) * NPROJ];
        bf16_t* mixb = (bf16_t*)(ws + WS_MIX) + (size_t)(m0 + 4 * hh) * DM + j;
        bf16_t* gab = (bf16_t*)(ws + WS_GA) + (size_t)(m0 + 4 * hh) * 512 + j;
#pragma unroll
        for (int Gi = 0; Gi < 8; ++Gi) {
            const int mt = Gi >> 2, g = Gi & 3;
            bf16_t* mb = vlaunder(mixb); bf16_t* gb = vlaunder(gab);
            float Hl[4], Ac[4];
#pragma unroll
            for (int k = 0; k < 4; ++k) { const int reg = 4 * g + k, t = 32 * mt + 8 * g + 4 * hh + k;
                const float rg_ = sigm(aa[mt][reg] + ba), ig = sigm(ai[mt][reg] + bi), la = spl * rg_, a = __expf(la), mult = sqrtf(-expm1f(2.f * la));
                const float u = mult * ig * bf2f(XC[t * 72 + 32 * nt + r]);
                if (k == 0) { Hl[0] = u; Ac[0] = a; } else { Hl[k] = a * Hl[k - 1] + u; Ac[k] = a * Ac[k - 1]; } }
            const float Ag = Ac[3], Hg = Hl[3], pA = __shfl_xor(Ag, 32), pH = __shfl_xor(Hg, 32);
            const int seq = sq0 + Gi;
            if (!prm) { Cc = P.in[I_SRH][(size_t)seq * 512 + j]; Pp = 1.f; }
            float cin, pin, Cn, Pn;
            if (hh == 0) { cin = Cc; pin = Pp; Cn = pA * (Ag * Cc + Hg) + pH; Pn = Pp * Ag * pA; }
            else { cin = pA * Cc + pH; pin = Pp * pA; Cn = Ag * cin + Hg; Pn = Pp * pA * Ag; }
#pragma unroll
            for (int k = 0; k < 4; ++k) { const int tt = 32 * mt + 8 * g + k;
                const float hv = Hl[k] + Ac[k] * cin, gy = gelu_tanh(bf2f(yv[4 * Gi + k]));
                mb[(size_t)tt * DM] = (bf16_t)f2bf(gy * hv);
                if (prm) gb[(size_t)tt * 512] = (bf16_t)f2bf(gy * Ac[k] * pin);
                else if (hh == 1 && k == 3) P.out[OUT_SRH + (size_t)seq * 512 + j] = hv; }
            Cc = Cn; Pp = Pn;
            asm volatile("" ::: "memory"); __builtin_amdgcn_sched_barrier(0);
        }
        if (prm && hh == 0) { ((float*)(ws + WS_SEGA))[T * 512 + j] = Pp; ((float*)(ws + WS_SEGH))[T * 512 + j] = Cc; }
    }
    asm volatile("s_waitcnt lgkmcnt(0)" ::: "memory");
}

constexpr int SEQ_BUF = 49152;
DI void gdn_seq_block(const Params& P, LAS unsigned char* lds, int bh) {
    const int tid = tid_(), lane = tid & 63, wave = tid >> 6, r = lane & 31, hh = lane >> 5;
    unsigned char* ws = P.ws;
    const unsigned char* gW = ws + WS_WF + (size_t)bh * 32 * 16384; const unsigned char* gK = ws + WS_KTF + (size_t)bh * 32 * 16384; const unsigned char* gU = ws + WS_UB + (size_t)bh * 32 * 16384;
    bf16_t* SNB = (bf16_t*)P.out; bf16_t* VNB = (bf16_t*)((unsigned char*)P.out + 32 * MiB);
    const float glv = (lane < 32) ? ((const float*)(ws + WS_GL))[bh * 32 + lane] : 0.f;
    f32x16 S[4]; S[0] = zero16(); S[1] = zero16(); S[2] = zero16(); S[3] = zero16();
    const int es = wave & 3, lt = tid - 256;
#define SEQ_STAGE(nn, bb) do { u32x4 tmp_[12]; \
        _Pragma("unroll") for (int q = 0; q < 12; ++q) { const unsigned char* g_ = (q < 4 ? gW : q < 8 ? gK : gU) + (size_t)(nn) * 16384 + ((q & 3) * 256 + lt) * 16; tmp_[q] = *(const u32x4*)g_; } \
        _Pragma("unroll") for (int q = 0; q < 12; ++q) *(LAS u32x4*)(lds + (bb) * SEQ_BUF + (q >> 2) * 16384 + ((q & 3) * 256 + lt) * 16) = tmp_[q]; } while (0)
    if (wave >= 4) SEQ_STAGE(0, 0);
    __syncthreads();
#pragma unroll 1
    for (int n = 0; n < 32; ++n) {
        if (wave >= 4) { if (n + 1 < 32) SEQ_STAGE(n + 1, (n + 1) & 1); }
        else {
            const int cid = bh * 32 + n;
            const LAS unsigned char* bw = lds + (n & 1) * SEQ_BUF;
            const float gl = __shfl(glv, n);
            bf16x8 Sb[8];
#pragma unroll
            for (int dt = 0; dt < 4; ++dt) { Sb[2 * dt] = pack_step(S[dt], 0); Sb[2 * dt + 1] = pack_step(S[dt], 1); }
#pragma unroll
            for (int kk = 0; kk < 8; ++kk) *(bf16x8*)(SNB + (size_t)cid * 16384 + (es * 8 + kk) * 512 + lane * 8) = Sb[kk];
            f32x16 vacc[2];
#pragma unroll
            for (int mt = 0; mt < 2; ++mt) { const LAS u32x4* up = (const LAS u32x4*)(bw + 32768 + ((es * 2 + mt) * 64 + lane) * 32); const u32x4 u0 = up[0], u1 = up[1];
#pragma unroll
                for (int i = 0; i < 4; ++i) { vacc[mt][2 * i] = __uint_as_float(u0[i] << 16); vacc[mt][2 * i + 1] = __uint_as_float(u0[i] & 0xffff0000u);
                    vacc[mt][8 + 2 * i] = __uint_as_float(u1[i] << 16); vacc[mt][8 + 2 * i + 1] = __uint_as_float(u1[i] & 0xffff0000u); } }
#pragma unroll
            for (int mt = 0; mt < 2; ++mt)
#pragma unroll
                for (int kk = 0; kk < 8; ++kk) vacc[mt] = MFMA32(*(const LAS bf16x8*)(bw + ((mt * 8 + kk) * 64 + lane) * 16), Sb[kk], vacc[mt]);
            bf16x8 vb[4];
#pragma unroll
            for (int ct = 0; ct < 2; ++ct) { vb[2 * ct] = pack_step(vacc[ct], 0); vb[2 * ct + 1] = pack_step(vacc[ct], 1); }
#pragma unroll
            for (int ks = 0; ks < 4; ++ks) *(bf16x8*)(VNB + (size_t)cid * 8192 + (es * 4 + ks) * 512 + lane * 8) = vb[ks];
#pragma unroll
            for (int dt = 0; dt < 4; ++dt) { S[dt] = S[dt] * gl;
#pragma unroll
                for (int ks = 0; ks < 4; ++ks) S[dt] = MFMA32(*(const LAS bf16x8*)(bw + 16384 + ((dt * 4 + ks) * 64 + lane) * 16), vb[ks], S[dt]); }
        }
        __syncthreads();
    }
#undef SEQ_STAGE
    if (wave < 4) {
        const int e0 = 32 * es;
#pragma unroll
        for (int dt = 0; dt < 4; ++dt)
#pragma unroll
            for (int reg = 0; reg < 16; ++reg) P.out[OUT_PGS + ((size_t)bh * 128 + 32 * dt + crow(reg, hh)) * 128 + e0 + r] = S[dt][reg];
    }
}

DI void gdn_out_item(const Params& P, LAS unsigned char* lds, int cid) {
    const int tid = tid_(), lane = tid & 63, wave = tid >> 6, r = lane & 31, hh = lane >> 5;
    unsigned char* ws = P.ws;
    const int bh = cid >> 5, n = cid & 31, b = bh >> 2, h = bh & 3, mt = wave >> 2, es = wave & 3;
    const bf16_t* SNB = (const bf16_t*)P.out; const bf16_t* VNB = (const bf16_t*)((const unsigned char*)P.out + 32 * MiB);
    const bf16_t* PROJ = (const bf16_t*)(ws + WS_PROJ);
    LAS float* OB = (LAS float*)lds;
    bf16x8 a1[8], b1[8], a2[4], b2[4];
#pragma unroll
    for (int kk = 0; kk < 8; ++kk) { a1[kk] = *(const bf16x8*)((const bf16_t*)(ws + WS_QDF) + (size_t)cid * 8192 + (mt * 8 + kk) * 512 + lane * 8); b1[kk] = *(const bf16x8*)(SNB + (size_t)cid * 16384 + (es * 8 + kk) * 512 + lane * 8); }
#pragma unroll
    for (int ks = 0; ks < 4; ++ks) { a2[ks] = *(const bf16x8*)((const bf16_t*)(ws + WS_QKF) + (size_t)cid * 4096 + (mt * 4 + ks) * 512 + lane * 8); b2[ks] = *(const bf16x8*)(VNB + (size_t)cid * 8192 + (es * 4 + ks) * 512 + lane * 8); }
    const size_t mb = (size_t)b * 2048 + 64 * n + 8 * wave;
    bf16_t zr[8][2];
#pragma unroll
    for (int k = 0; k < 8; ++k) { zr[k][0] = PROJ[(mb + k) * NPROJ + 2560 + 128 * h + lane]; zr[k][1] = PROJ[(mb + k) * NPROJ + 2560 + 128 * h + 64 + lane]; }
    f32x16 oacc = zero16();
#pragma unroll
    for (int kk = 0; kk < 8; ++kk) oacc = MFMA32(a1[kk], b1[kk], oacc);
#pragma unroll
    for (int ks = 0; ks < 4; ++ks) oacc = MFMA32(a2[ks], b2[ks], oacc);
#pragma unroll
    for (int reg = 0; reg < 16; ++reg) OB[(32 * mt + crow(reg, hh)) * 132 + 32 * es + r] = oacc[reg];
    __syncthreads();
    const float gw0 = P.in[I_GNW][lane], gw1 = P.in[I_GNW][lane + 64];
#pragma unroll
    for (int k = 0; k < 8; ++k) { const int c = 8 * wave + k;
        const float o0 = OB[c * 132 + lane], o1 = OB[c * 132 + 64 + lane];
        const float rstd = rsqrtf(wave_sum(o0 * o0 + o1 * o1) * (1.f / 128.f) + 1e-6f);
        bf16_t* mp = (bf16_t*)(ws + WS_MIX) + (mb + k) * DM + 512 + 128 * h;
        mp[lane] = (bf16_t)f2bf(o0 * rstd * gw0 * silu(bf2f(zr[k][0]))); mp[lane + 64] = (bf16_t)f2bf(o1 * rstd * gw1 * silu(bf2f(zr[k][1]))); }
    __syncthreads();
}

DI void gdn_sample_item(const Params& P, LAS unsigned char* lds, int s, int h) {
    const int tid = tid_(), lane = tid & 63, wave = tid >> 6;
    unsigned char* ws = P.ws;
    LAS float* Q = (LAS float*)lds; LAS float* K = Q + 1024; LAS float* V = K + 1024; LAS float* Uu = V + 1024; LAS float* Ww = Uu + 1024; LAS float* Oo = Ww + 1024;
    LAS float* RED = Oo + 1024;
    LAS float* SMs = RED + 8192;
    const bf16_t* PROJ = (const bf16_t*)(ws + WS_PROJ);
    const int m0 = NTOK_P + 8 * s;
    if (tid < 384) {
        const int mat = tid >> 7, d = tid & 127, ch = mat * 512 + h * 128 + d;
        const float* cw = P.in[I_GCW]; const float w0 = cw[ch], w1 = cw[1536 + ch], w2 = cw[3072 + ch], w3 = cw[4608 + ch];
        const float* st = P.in[I_SGC] + (size_t)s * 3 * 1536 + ch;
        float x3 = st[0], x2 = st[1536], x1 = st[3072];
        LAS float* T = Q + mat * 1024;
#pragma unroll
        for (int t = 0; t < 8; ++t) { const float x0 = bf2f(PROJ[(size_t)(m0 + t) * NPROJ + 1024 + ch]);
            T[t * 128 + d] = silu(w0 * x3 + w1 * x2 + w2 * x1 + w3 * x0);
            if (t >= 5) P.out[OUT_SGC + (size_t)(s * 3 + t - 5) * 1536 + ch] = x0;
            x3 = x2; x2 = x1; x1 = x0; }
    }
    if (tid == 511) { float acc = 0.f;
        for (int t = 0; t < 8; ++t) { acc += ((const float*)(ws + WS_G))[(m0 + t) * 4 + h]; SMs[t] = acc; SMs[8 + t] = __expf(acc); SMs[16 + t] = ((const float*)(ws + WS_BETA))[(m0 + t) * 4 + h]; }
        for (int t = 0; t < 8; ++t) SMs[24 + t] = __expf(acc - SMs[t]); }
    __syncthreads();
    {   const int i = wave;
        const float q0 = Q[i * 128 + lane], q1 = Q[i * 128 + 64 + lane], k0 = K[i * 128 + lane], k1 = K[i * 128 + 64 + lane];
        const float rq = rsqrtf(wave_sum(q0 * q0 + q1 * q1) + 1e-6f) * 0.08838834764831845f, rk = rsqrtf(wave_sum(k0 * k0 + k1 * k1) + 1e-6f);
        Q[i * 128 + lane] = q0 * rq; Q[i * 128 + 64 + lane] = q1 * rq; K[i * 128 + lane] = k0 * rk; K[i * 128 + 64 + lane] = k1 * rk; }
    __syncthreads();
    if (tid < 128) { const int which = tid >> 6, i = (tid >> 3) & 7, j = tid & 7;
        const LAS float* a = (which ? Q : K) + i * 128; const LAS float* bq = K + j * 128; float dot = 0.f;
        for (int d = 0; d < 128; ++d) dot += a[d] * bq[d];
        const float dec = __expf(SMs[i] - SMs[j]);
        if (which == 0) SMs[32 + i * 8 + j] = (j < i) ? dot * SMs[16 + i] * dec : 0.f;
        else SMs[96 + i * 8 + j] = (j <= i) ? dot * dec : 0.f; }
    __syncthreads();
    if (tid < 256) { const bool isw = tid >= 128; const int ci = tid & 127; float x[8];
#pragma unroll
        for (int i = 0; i < 8; ++i) { float acc = (isw ? K : V)[i * 128 + ci] * SMs[16 + i]; if (isw) acc *= SMs[8 + i];
#pragma unroll
            for (int j = 0; j < 8; ++j) if (j < i) acc -= SMs[32 + i * 8 + j] * x[j];
            x[i] = acc; (isw ? Ww : Uu)[i * 128 + ci] = acc; } }
    __syncthreads();
    {   const int e = tid & 127, dq = tid >> 7;
        const float* S0 = P.in[I_SGS] + ((size_t)(s * 4 + h) * 128 + 32 * dq) * 128 + e;
        float Sr[32];
#pragma unroll
        for (int k = 0; k < 32; ++k) Sr[k] = S0[(size_t)k * 128];
        float pv[8], po[8];
#pragma unroll
        for (int c = 0; c < 8; ++c) { pv[c] = 0.f; po[c] = 0.f; }
#pragma unroll
        for (int k = 0; k < 32; ++k) { const int d = 32 * dq + k;
#pragma unroll
            for (int c = 0; c < 8; ++c) { pv[c] += Ww[c * 128 + d] * Sr[k]; po[c] += Q[c * 128 + d] * Sr[k]; } }
#pragma unroll
        for (int c = 0; c < 8; ++c) { RED[(dq * 16 + c) * 128 + e] = pv[c]; RED[(dq * 16 + 8 + c) * 128 + e] = po[c] * SMs[8 + c]; }
        __syncthreads();
        float vn[8];
#pragma unroll
        for (int c = 0; c < 8; ++c) vn[c] = Uu[c * 128 + e] - ((RED[(0 * 16 + c) * 128 + e] + RED[(1 * 16 + c) * 128 + e]) + (RED[(2 * 16 + c) * 128 + e] + RED[(3 * 16 + c) * 128 + e]));
        const float gl = SMs[15];
        float* So = P.out + OUT_SGS + ((size_t)(s * 4 + h) * 128 + 32 * dq) * 128 + e;
#pragma unroll
        for (int k = 0; k < 32; ++k) { const int d = 32 * dq + k; float acc = Sr[k] * gl;
#pragma unroll
            for (int c = 0; c < 8; ++c) acc += K[c * 128 + d] * SMs[24 + c] * vn[c];
            So[(size_t)k * 128] = acc; }
        if (dq == 0) {
#pragma unroll
            for (int c = 0; c < 8; ++c) { float o = (RED[(0 * 16 + 8 + c) * 128 + e] + RED[(1 * 16 + 8 + c) * 128 + e]) + (RED[(2 * 16 + 8 + c) * 128 + e] + RED[(3 * 16 + 8 + c) * 128 + e]);
#pragma unroll
                for (int j = 0; j < 8; ++j) if (j <= c) o += SMs[96 + c * 8 + j] * vn[j];
                Oo[c * 128 + e] = o; } }
    }
    __syncthreads();
    {   const int c = wave; const size_t m = m0 + c;
        const float o0 = Oo[c * 128 + lane], o1 = Oo[c * 128 + 64 + lane];
        const float rstd = rsqrtf(wave_sum(o0 * o0 + o1 * o1) * (1.f / 128.f) + 1e-6f);
        const float z0 = bf2f(PROJ[m * NPROJ + 2560 + 128 * h + lane]), z1 = bf2f(PROJ[m * NPROJ + 2560 + 128 * h + 64 + lane]);
        bf16_t* mp = (bf16_t*)(ws + WS_MIX) + m * DM + 512 + 128 * h;
        mp[lane] = (bf16_t)f2bf(o0 * rstd * P.in[I_GNW][lane] * silu(z0)); mp[lane + 64] = (bf16_t)f2bf(o1 * rstd * P.in[I_GNW][lane + 64] * silu(z1)); }
    __syncthreads();
}

DI void rg_fix_item(const Params& P, int b, int n) {
    const int c = tid_(); unsigned char* ws = P.ws;
    const float* SA = (const float*)(ws + WS_SEGA); const float* SH = (const float*)(ws + WS_SEGH);
    float Cc = 0.f;
    for (int j = 0; j < n; ++j) { const int Tj = b * 32 + j; Cc = SA[Tj * 512 + c] * Cc + SH[Tj * 512 + c]; }
    bf16_t* MIX = (bf16_t*)(ws + WS_MIX); const bf16_t* GA = (const bf16_t*)(ws + WS_GA);
    const size_t mb = (size_t)b * 2048 + 64 * n;
#pragma unroll 32
    for (int i = 0; i < 64; ++i) { const size_t m = mb + i; MIX[m * DM + c] = (bf16_t)f2bf(bf2f(MIX[m * DM + c]) + bf2f(GA[m * 512 + c]) * Cc); }
    if (n == 31) { const int Tj = b * 32 + 31; P.out[OUT_PRH + (size_t)b * 512 + c] = SA[Tj * 512 + c] * Cc + SH[Tj * 512 + c]; }
}

__global__ void __launch_bounds__(NTHR, 2) hybrid_fwd(Params Pk) {
    extern __shared__ __attribute__((aligned(16))) unsigned char lds_raw[];
    LAS unsigned char* lds = (LAS unsigned char*)lds_raw;
    cg::grid_group grid = cg::this_grid();
    const int G = gridDim.x;
    volatile LAS unsigned* bst = (volatile LAS unsigned*)(lds + (LDS_BYTES - 64));
    if (threadIdx.x < 2) bst[threadIdx.x] = 0u;
    __syncthreads();
    XcdBarrier xb; { const Params P = load_params(); xb = xcd_barrier_post((unsigned*)(P.ws + WS_CTL), bst); }

    { const Params P = load_params(); phase0(P, lds); }
    if (PROBE == 10) { __syncthreads(); const Params P = load_params(); phase0(P, lds); }
    grid.sync();
    {   const Params P = load_params(); unsigned char* ws = P.ws;
        pg8::Gemm g{(const bf16_t*)(ws + WS_HN), (const bf16_t*)(ws + WS_WIN), NTOK, NPROJ, DM}; pg8::StaticOrder S; S.init(NTOK, NPROJ, G, (int)blockIdx.x);
        EpiProj E{(bf16_t*)(ws + WS_PROJ), NPROJ};
        pg8::gemm_phase<EpiProj, pg8::StaticOrder, true, true>(lds, g, S, E); }
    xcd_barrier(xb);
    for (int rep = 0; rep < (PROBE == 2 ? 2 : 1); ++rep)
    for (int it = blockIdx.x; it < 1024; it += G) { const Params P = load_params(); gdn_chunk_item(P, lds, it); }
    for (int rep = 0; rep < (PROBE == 3 ? 2 : 1); ++rep)
    for (int it = blockIdx.x; it < 272; it += G) { const Params P = load_params(); rg_tile_item(P, lds, it); __syncthreads(); }
    xcd_barrier(xb);
    if (blockIdx.x < 32) { for (int rep = 0; rep < (PROBE == 4 ? 2 : 1); ++rep) { const Params P = load_params(); gdn_seq_block(P, lds, blockIdx.x); } }
    else {
        for (int rep = 0; rep < (PROBE == 5 ? 3 : 1); ++rep)
        for (int it = blockIdx.x - 32; it < 512; it += G - 32) { const Params P = load_params(); gdn_sample_item(P, lds, it >> 2, it & 3); }
        for (int q = blockIdx.x - 32; q < 248; q += G - 32) { const Params P = load_params(); rg_fix_item(P, q / 31, 1 + q % 31); }
    }
    xcd_barrier(xb);
    for (int it = blockIdx.x; it < 1024; it += G) { const Params P = load_params(); gdn_out_item(P, lds, it); }
    xcd_barrier(xb);
    {   const Params P = load_params(); unsigned char* ws = P.ws;
        pg8::Gemm g{(const bf16_t*)(ws + WS_MIX), (const bf16_t*)(ws + WS_WOUT), NTOK, DM, DM}; pg8::StaticOrder S; S.init(NTOK, DM, G, (int)blockIdx.x);
        EpiX1 E{P.in[I_XP], P.in[I_XS], P.out + OUT_Y, (bf16_t*)(ws + WS_X1B), (float*)(ws + WS_SS1)};
        pg8::gemm_phase<EpiX1, pg8::StaticOrder, true, true>(lds, g, S, E); }
    xcd_barrier(xb);
    {   const Params P = load_params(); unsigned char* ws = P.ws;
        pg8::Gemm g{(const bf16_t*)(ws + WS_X1B), (const bf16_t*)(ws + WS_WGU), NTOK, NGU, DM}; pg8::StaticOrder S; S.init(NTOK, NGU, G, (int)blockIdx.x);
        EpiAct E{(bf16_t*)(ws + WS_ACT), (const float*)(ws + WS_SS1)};
        pg8::gemm_phase<EpiAct, pg8::StaticOrder, true, true>(lds, g, S, E); }
    xcd_barrier(xb);
    {   const Params P = load_params(); unsigned char* ws = P.ws;
        pg8::Gemm g{(const bf16_t*)(ws + WS_ACT), (const bf16_t*)(ws + WS_WDN), NTOK, DM, DFF}; pg8::StaticOrder S; S.init(NTOK, DM, G, (int)blockIdx.x);
        EpiX2 E{P.out + OUT_Y};
        pg8::gemm_phase<EpiX2, pg8::StaticOrder, true, true>(lds, g, S, E); }
    xcd_barrier(xb);
    {
        const Params P = load_params();
        const int tid = tid_(), lane = tid & 63, wave = tid >> 6; const float* fw = P.in[I_FN];
        f32x4 nw[4];
#pragma unroll
        for (int j = 0; j < 4; ++j) nw[j] = *(const f32x4*)(fw + 4 * lane + 256 * j);
        for (int m = blockIdx.x * NWAVES + wave; m < NTOK; m += G * NWAVES) {
            float* row = P.out + OUT_Y + (size_t)m * DM; f32x4 v[4]; float s = 0.f;
#pragma unroll
            for (int j = 0; j < 4; ++j) { v[j] = *(const f32x4*)(row + 4 * lane + 256 * j); s += (v[j].x * v[j].x + v[j].y * v[j].y) + (v[j].z * v[j].z + v[j].w * v[j].w); }
            const float rstd = rsqrtf(wave_sum(s) * (1.f / DM) + 1e-6f);
#pragma unroll
            for (int j = 0; j < 4; ++j) *(f32x4*)(row + 4 * lane + 256 * j) = v[j] * rstd * nw[j];
        }
    }
}

extern "C" void kernel_launch(void* const* d_in, const int* in_sizes, int n_in, void* d_out, int out_size, void* d_ws, size_t ws_size, hipStream_t stream) {
    static int grid = 0;
    if (grid == 0) {
        int dev = 0, cus = 0, per_cu = 0;
        if (n_in != 25 || ws_size < WS_END) { fprintf(stderr, "kernel_launch: unexpected n_in %d / ws_size %zu\n", n_in, ws_size); grid = -1; return; }
        hipGetDevice(&dev); hipDeviceGetAttribute(&cus, hipDeviceAttributeMultiprocessorCount, dev);
        hipFuncSetAttribute((const void*)hybrid_fwd, hipFuncAttributeMaxDynamicSharedMemorySize, LDS_BYTES);
        hipOccupancyMaxActiveBlocksPerMultiprocessor(&per_cu, (const void*)hybrid_fwd, NTHR, LDS_BYTES);
        (void)hipGetLastError();
        if (per_cu < 1) { fprintf(stderr, "kernel_launch: occupancy query says %d blocks per CU\n", per_cu); per_cu = 1; }
        grid = cus;
        if (grid > 256) grid = 256;
    }
    if (grid < 0) return;
    hipMemsetAsync((char*)d_ws + WS_CTL, 0, CTL_BYTES, stream);
    Params p{};
    for (int i = 0; i < 25; ++i) p.in[i] = (const float*)d_in[i];
    p.out = (float*)d_out; p.ws = (unsigned char*)d_ws;
    void* args[] = {&p};
    hipError_t e = hipLaunchCooperativeKernel((const void*)hybrid_fwd, dim3(grid), dim3(NTHR), args, LDS_BYTES, stream);
    if (e != hipSuccess) fprintf(stderr, "cooperative launch failed: %s (grid %d)\n", hipGetErrorString(e), grid);
}
```

```cpp
#include <hip/hip_runtime.h>
#include <hip/hip_cooperative_groups.h>
#include <cstdio>
#include <cstdint>
namespace cg = cooperative_groups;
namespace pg8 {
#define PG8_LAS __attribute__((address_space(3)))
typedef unsigned short bf16_t;
typedef short bf16x8 __attribute__((ext_vector_type(8)));
typedef float f32x4 __attribute__((ext_vector_type(4)));
typedef unsigned u32x4 __attribute__((ext_vector_type(4)));
constexpr int BM = 256, BK = 64, HALF = 128, HTB = HALF * BK * 2  , STAGE_BYTES = 8 * HTB, NXCD = 8, WGM = 8;

__host__ __device__ __forceinline__ int lds_byte(int r, int c) { const int st = (r >> 4) * 2 + (c >> 5), rr = r & 15, cc = c & 31, ob = rr * 64 + cc * 2; return st * 1024 + (ob ^ (((ob >> 9) & 1) << 5)); }
__host__ __device__ __forceinline__ void stage_rc(int b, int& R, int& C) { const int st = b / 1024, sb = b % 1024, swz = sb ^ (((sb >> 9) & 1) << 5); R = (st >> 1) * 16 + swz / 64; C = (st & 1) * 32 + (swz % 64) / 2; }
__host__ __device__ __forceinline__ int perm32(int rho) { const int n = rho >> 4, i = rho & 15; return 8 * (i >> 2) + 4 * n + (i & 3); }

struct Unit { int pm, pn, kb, ks; };
struct Gemm { const bf16_t* A; const bf16_t* Bt; int M, N, K, ld; };

struct StaticOrder {
    int nM, nN, nwg, G, c;
    __host__ __device__ void init(int M, int N, int G_, int c_) { nM = M / BM; nN = N / BM; nwg = nM * nN; G = G_; c = c_; }
    __host__ __device__ bool next(int i, Unit& u) const {
        const long L = (long)i * G + c; if (L >= nwg) return false;
        int wgid = (int)L; { const int q = nwg / NXCD, r = nwg % NXCD, xcd = wgid % NXCD, off = wgid / NXCD; wgid = (xcd < r ? xcd * (q + 1) : r * (q + 1) + (xcd - r) * q) + off; }
        const int nig = WGM * nN, gid = wgid / nig, fm = gid * WGM, gsz = (nM - fm) < WGM ? (nM - fm) : WGM;
        u.pm = fm + ((wgid % nig) % gsz); u.pn = (wgid % nig) / gsz; u.kb = 0; u.ks = 0; return true;
    }
    __device__ __forceinline__ void a_ready(const Unit&) const {}
    __device__ __forceinline__ void done(const Unit&) const {}
};
__device__ __forceinline__ unsigned cvt_pk_bf16(float lo, float hi) { unsigned r; asm volatile("v_cvt_pk_bf16_f32 %0, %1, %2" : "=v"(r) : "v"(lo), "v"(hi)); return r; }
template <class Epi, class Sched, bool ALIGN_EPI = false, bool SP2 = false>
__device__ __forceinline__ void gemm_phase(PG8_LAS unsigned char* lds, const Gemm g, const Sched& S, const Epi& E) {
    int tid = threadIdx.x; asm volatile("" : "+v"(tid)); const int wid = __builtin_amdgcn_readfirstlane(tid >> 6), lane = tid & 63, wr = wid >> 2, wc = wid & 3, fr = lane & 15, fq = lane >> 4;
    const int K = g.ld, nt = g.K / BK;
    unsigned voffA[2], voffB[2];
#pragma unroll
    for (int i = 0; i < 2; ++i) { int R, C; stage_rc(tid * 16 + i * 8192, R, C); const int Rb = Epi::PERM ? ((R & ~31) + perm32(R & 31)) : R;
        voffA[i] = (unsigned)(R * K + C) * 2u; voffB[i] = (unsigned)(Rb * K + C) * 2u; }
    const size_t kstep = (size_t)(BK * 2);
    const size_t hstep = (size_t)HALF * K * 2;
    const size_t tstep = 2 * hstep;
    const unsigned ldsw = (unsigned)wid * 1024u;
    const int aoff = lds_byte(wr * 64 + fr, fq * 8), boff = lds_byte(wc * 32 + fr, fq * 8);
#define PG8_SA(b, h) (((b) * 2 + (h)) * HTB)
#define PG8_SB(b, h) ((4 + (b) * 2 + (h)) * HTB)
#define PG8_STAGE(bufoff, gbase, voff) do { _Pragma("unroll") for (int _i = 0; _i < 2; ++_i) \
        __builtin_amdgcn_global_load_lds((const unsigned*)((const char*)(gbase) + (voff)[_i]), (PG8_LAS unsigned*)(lds + (bufoff) + ldsw + _i * 8192), 16, 0, 0); } while (0)
#define PG8_LDA(dst, b, h) do { _Pragma("unroll") for (int m = 0; m < 4; ++m) _Pragma("unroll") for (int k = 0; k < 2; ++k) dst[m][k] = *(const PG8_LAS bf16x8*)(lds + PG8_SA(b, h) + aoff + m * 2048 + k * 1024); } while (0)
#define PG8_LDB(dst, b, h) do { _Pragma("unroll") for (int n = 0; n < 2; ++n) _Pragma("unroll") for (int k = 0; k < 2; ++k) dst[n][k] = *(const PG8_LAS bf16x8*)(lds + PG8_SB(b, h) + boff + n * 2048 + k * 1024); } while (0)
#define PG8_MMA(ai, bj, At, Bt) do { __builtin_amdgcn_s_setprio(1); _Pragma("unroll") for (int m = 0; m < 4; ++m) _Pragma("unroll") for (int n = 0; n < 2; ++n) _Pragma("unroll") for (int k = 0; k < 2; ++k) \
        acc[ai][bj][m][n] = __builtin_amdgcn_mfma_f32_16x16x32_bf16(Bt[n][k], At[m][k], acc[ai][bj][m][n], 0, 0, 0); __builtin_amdgcn_s_setprio(0); } while (0)
#define PG8_WAIT_V(n) asm volatile("s_waitcnt vmcnt(" #n ")" ::: "memory")
#define PG8_WAIT_L(n) asm volatile("s_waitcnt lgkmcnt(" #n ")" ::: "memory")
#define PG8_BAR __builtin_amdgcn_s_barrier()
#define PG8_SCHED __builtin_amdgcn_sched_barrier(0)
    Unit cur, nxt; int ui = 0;
    if (!S.next(0, cur)) return;
    f32x4 acc[2][2][4][2];
#pragma unroll
    for (int a = 0; a < 2; ++a)
#pragma unroll
        for (int b = 0; b < 2; ++b)
#pragma unroll
            for (int m = 0; m < 4; ++m)
#pragma unroll
                for (int n = 0; n < 2; ++n) acc[a][b][m][n] = (f32x4){0.f, 0.f, 0.f, 0.f};
    bf16x8 At[4][2], B0[2][2], B1[2][2];
    const char* cA = (const char*)g.A + (size_t)cur.pm * tstep + cur.kb; const char* cB = (const char*)g.Bt + (size_t)cur.pn * tstep + cur.kb;
    S.a_ready(cur);
    if constexpr (SP2) {
        PG8_STAGE(PG8_SB(0, 0), cB, voffB); PG8_STAGE(PG8_SB(0, 1), cB + hstep, voffB); PG8_STAGE(PG8_SA(0, 0), cA, voffA); PG8_STAGE(PG8_SA(0, 1), cA + hstep, voffA);
        if (wr == 1) PG8_BAR;
        PG8_WAIT_V(2); PG8_BAR;
        PG8_STAGE(PG8_SB(1, 0), cB + kstep, voffB); PG8_STAGE(PG8_SA(1, 0), cA + kstep, voffA); PG8_STAGE(PG8_SB(1, 1), cB + hstep + kstep, voffB);
        PG8_WAIT_V(6); PG8_BAR;
    } else {
        PG8_STAGE(PG8_SB(0, 0), cB, voffB); PG8_STAGE(PG8_SA(0, 0), cA, voffA); PG8_STAGE(PG8_SB(0, 1), cB + hstep, voffB); PG8_STAGE(PG8_SA(0, 1), cA + hstep, voffA);
        if (wr == 1) PG8_BAR;
        PG8_WAIT_V(4); PG8_BAR;
        PG8_STAGE(PG8_SB(1, 0), cB + kstep, voffB); PG8_STAGE(PG8_SA(1, 0), cA + kstep, voffA); PG8_STAGE(PG8_SB(1, 1), cB + hstep + kstep, voffB);
        PG8_WAIT_V(6); PG8_BAR;
    }
    for (;;) {
        const bool has_next = S.next(ui + 1, nxt);
        const char* nA = has_next ? (const char*)g.A + (size_t)nxt.pm * tstep + nxt.kb : cA; const char* nB = has_next ? (const char*)g.Bt + (size_t)nxt.pn * tstep + nxt.kb : cB;
        for (int t = 0; t < nt; t += 2) {
            const bool last = (t == nt - 2);
            const char* a1 = cA + (size_t)(t + 1) * kstep;
            const char* a2 = last ? nA : cA + (size_t)(t + 2) * kstep; const char* b2 = last ? nB : cB + (size_t)(t + 2) * kstep;
            const char* a3 = a2 + kstep; const char* b3 = b2 + kstep;
            if (last && has_next) S.a_ready(nxt);
            if constexpr (SP2) {
            PG8_LDB(B0, 0, 0); PG8_LDB(B1, 0, 1); PG8_SCHED; PG8_LDA(At, 0, 0); PG8_STAGE(PG8_SA(1, 1), a1 + hstep, voffA);
            PG8_WAIT_V(8); PG8_WAIT_L(0); PG8_BAR; PG8_MMA(0, 0, At, B0); PG8_MMA(0, 1, At, B1); PG8_BAR; PG8_SCHED;
            PG8_LDA(At, 0, 1); PG8_STAGE(PG8_SB(0, 0), b2, voffB); PG8_STAGE(PG8_SB(0, 1), b2 + hstep, voffB); PG8_STAGE(PG8_SA(0, 0), a2, voffA);
            PG8_WAIT_V(8); PG8_WAIT_L(0); PG8_BAR; PG8_MMA(1, 0, At, B0); PG8_MMA(1, 1, At, B1); PG8_BAR; PG8_SCHED;
            PG8_LDB(B0, 1, 0); PG8_LDB(B1, 1, 1); PG8_SCHED; PG8_LDA(At, 1, 0); PG8_STAGE(PG8_SA(0, 1), a2 + hstep, voffA);
            PG8_WAIT_V(8); PG8_WAIT_L(0); PG8_BAR; PG8_MMA(0, 0, At, B0); PG8_MMA(0, 1, At, B1); PG8_BAR; PG8_SCHED;
            PG8_LDA(At, 1, 1); PG8_STAGE(PG8_SB(1, 0), b3, voffB); PG8_STAGE(PG8_SB(1, 1), b3 + hstep, voffB); PG8_STAGE(PG8_SA(1, 0), a3, voffA);
            PG8_WAIT_V(8); PG8_WAIT_L(0); PG8_BAR; PG8_MMA(1, 0, At, B0); PG8_MMA(1, 1, At, B1); PG8_BAR; PG8_SCHED;
            } else {
            PG8_LDB(B0, 0, 0); PG8_SCHED; PG8_LDA(At, 0, 0); PG8_STAGE(PG8_SA(1, 1), a1 + hstep, voffA);
            PG8_WAIT_L(8); PG8_BAR; PG8_WAIT_L(0); PG8_MMA(0, 0, At, B0); PG8_BAR; PG8_SCHED;
            PG8_LDB(B1, 0, 1); PG8_STAGE(PG8_SB(0, 0), b2, voffB);
            PG8_BAR; PG8_WAIT_L(0); PG8_MMA(0, 1, At, B1); PG8_BAR;
            PG8_LDA(At, 0, 1); PG8_STAGE(PG8_SA(0, 0), a2, voffA);
            PG8_BAR; PG8_WAIT_L(0); PG8_MMA(1, 0, At, B0); PG8_BAR; PG8_SCHED;
            PG8_STAGE(PG8_SB(0, 1), b2 + hstep, voffB);
            PG8_WAIT_V(6); PG8_BAR; PG8_MMA(1, 1, At, B1); PG8_BAR;
            PG8_LDB(B0, 1, 0); PG8_SCHED; PG8_LDA(At, 1, 0); PG8_STAGE(PG8_SA(0, 1), a2 + hstep, voffA);
            PG8_WAIT_L(8); PG8_BAR; PG8_WAIT_L(0); PG8_MMA(0, 0, At, B0); PG8_BAR; PG8_SCHED;
            PG8_LDB(B1, 1, 1); PG8_STAGE(PG8_SB(1, 0), b3, voffB);
            PG8_BAR; PG8_WAIT_L(0); PG8_MMA(0, 1, At, B1); PG8_BAR;
            PG8_LDA(At, 1, 1); PG8_STAGE(PG8_SA(1, 0), a3, voffA);
            PG8_BAR; PG8_WAIT_L(0); PG8_MMA(1, 0, At, B0); PG8_BAR; PG8_SCHED;
            PG8_STAGE(PG8_SB(1, 1), b3 + hstep, voffB);
            PG8_WAIT_V(6); PG8_BAR; PG8_MMA(1, 1, At, B1); PG8_BAR;
            }
        }
        if constexpr (ALIGN_EPI) { if (wr == 0) PG8_BAR; }
        if constexpr (!Epi::AFTER_DRAIN) { E(acc, cur, wr, wc, fr, fq); S.done(cur); }
        if (!has_next) break;
#pragma unroll
        for (int a = 0; a < 2; ++a)
#pragma unroll
            for (int b = 0; b < 2; ++b)
#pragma unroll
                for (int m = 0; m < 4; ++m)
#pragma unroll
                    for (int n = 0; n < 2; ++n) acc[a][b][m][n] = (f32x4){0.f, 0.f, 0.f, 0.f};
        cur = nxt; cA = nA; cB = nB; ++ui;
        if constexpr (ALIGN_EPI) { if (wr == 1) PG8_BAR; }
    }
    PG8_WAIT_V(0);
    if constexpr (!ALIGN_EPI) { if (wr == 0) PG8_BAR; }
    PG8_BAR;
    if constexpr (Epi::AFTER_DRAIN) { E.fused(acc, cur, wr, wc, fr, fq, lds, wid, lane); S.done(cur); }
#undef PG8_SA
#undef PG8_SB
#undef PG8_STAGE
#undef PG8_LDA
#undef PG8_LDB
#undef PG8_MMA
#undef PG8_WAIT_V
#undef PG8_WAIT_L
#undef PG8_BAR
#undef PG8_SCHED
}
}

#define LAS __attribute__((address_space(3)))
typedef unsigned short bf16_t;
typedef short bf16x8 __attribute__((ext_vector_type(8)));
typedef float f32x4 __attribute__((ext_vector_type(4)));
typedef float f32x16 __attribute__((ext_vector_type(16)));
typedef unsigned u32x4 __attribute__((ext_vector_type(4)));
typedef unsigned u32x2 __attribute__((ext_vector_type(2)));

#define XB_TMO      128
#define XB_XCNT(j)  (256  + 64 * (j))
#define XB_XSUB(j)  (1280 + 64 * (j))
#define XB_XGEN(j)  (2304 + 64 * (j))
#define XB_TOP      3328
#define XB_TOPGEN   3392
#define XCD_BAR_WORDS 3456
#define XB_SPIN_CAP (1u << 18)

__device__ __forceinline__ unsigned xb_ld(unsigned* p)              { return __hip_atomic_load(p, __ATOMIC_RELAXED, __HIP_MEMORY_SCOPE_AGENT); }
__device__ __forceinline__ unsigned xb_add(unsigned* p, unsigned v) { return __hip_atomic_fetch_add(p, v, __ATOMIC_RELAXED, __HIP_MEMORY_SCOPE_AGENT); }
__device__ __forceinline__ unsigned xb_xcc_id() { return (unsigned)__builtin_amdgcn_s_getreg((3 << 11) | 20) & 0xFu; }
#define XB_SPIN(cond, bar) do { unsigned _sp = 0; while (cond) { __builtin_amdgcn_s_sleep(1); \
    if ((++_sp & 255u) == 0u) { if (xb_ld(&(bar)[XB_TMO])) break; if (_sp > XB_SPIN_CAP) { atomicAdd(&(bar)[XB_TMO], 1u); break; } } } } while (0)

struct XcdBarrier {
    unsigned* bar; unsigned x;
    volatile LAS unsigned* st;
};

__device__ __forceinline__ XcdBarrier xcd_barrier_post(unsigned* bar, volatile LAS unsigned* st) {
    XcdBarrier b; b.bar = bar; b.x = xb_xcc_id(); b.st = st;
    if (threadIdx.x == 0) (void)xb_add(&bar[XB_XCNT(b.x)], 1u);
    return b;
}
__device__ __forceinline__ void xcd_barrier_complete(unsigned* bar, unsigned x, unsigned& nloc, unsigned& nx) {
    const unsigned G = gridDim.x * gridDim.y * gridDim.z;
    unsigned sum, cnt, mine, sp = 0u;
    for (;;) {
        sum = 0u; cnt = 0u; mine = 0u;
#pragma unroll
        for (unsigned j = 0; j < 16; ++j) { const unsigned c = xb_ld(&bar[XB_XCNT(j)]); sum += c; cnt += (c > 0u) ? 1u : 0u; mine = (j == x) ? c : mine; }
        if (sum == G) break;
        __builtin_amdgcn_s_sleep(1);
        if ((++sp & 255u) == 0u) { if (xb_ld(&bar[XB_TMO])) break; if (sp > XB_SPIN_CAP) { atomicAdd(&bar[XB_TMO], 1u); break; } }
    }
    nloc = mine > 0u ? mine : 1u; nx = cnt > 0u ? cnt : 1u;
}

__device__ __forceinline__ void xcd_barrier(const XcdBarrier& b) {
    asm volatile("s_waitcnt vmcnt(0)" ::: "memory");
    __syncthreads();
    if (threadIdx.x == 0) {
        unsigned* bar = b.bar;
        __builtin_amdgcn_s_waitcnt(0);
        unsigned nloc = b.st[0], nx = b.st[1];
        if (nloc == 0u) { xcd_barrier_complete(bar, b.x, nloc, nx); b.st[0] = nloc; b.st[1] = nx; }
        const unsigned old = xb_add(&bar[XB_XSUB(b.x)], 1u);
        const unsigned gen = old / nloc;
        if (old + 1u == (gen + 1u) * nloc) {
            __builtin_amdgcn_fence(__ATOMIC_RELEASE, "agent");
            asm volatile("s_waitcnt vmcnt(0)" ::: "memory");
            const unsigned og = xb_add(&bar[XB_TOP], 1u);
            const unsigned tg = og / nx;
            if (og + 1u == (tg + 1u) * nx) xb_add(&bar[XB_TOPGEN], 1u);
            else XB_SPIN(xb_ld(&bar[XB_TOPGEN]) == tg, bar);
            __builtin_amdgcn_fence(__ATOMIC_ACQUIRE, "agent");
            xb_add(&bar[XB_XGEN(b.x)], 1u);
            asm volatile("s_waitcnt vmcnt(0)" ::: "memory");
        } else {
            XB_SPIN(xb_ld(&bar[XB_XGEN(b.x)]) == gen, bar);
            __builtin_amdgcn_fence(__ATOMIC_ACQUIRE, "agent");
            asm volatile("s_waitcnt vmcnt(0)" ::: "memory");
        }
    }
    __syncthreads();
}


constexpr int DM = 1024, NTOK_P = 16384, NTOK = 17408, DIN = 3080, NPROJ = 3072, DFF = 2816, NGU = 5632;
constexpr int NWAVES = 8, NTHR = 512;
constexpr int PROBE = 0;
constexpr int LDS_BYTES = 148480;
constexpr size_t MiB = 1u << 20;
constexpr size_t WS_CTL = 0, CTL_BYTES = 1 * MiB, WS_SS1 = 65536;
constexpr size_t WS_WIN = 1 * MiB, WS_WOUT = 7 * MiB, WS_WGU = 9 * MiB, WS_WDN = 20 * MiB;
constexpr size_t WS_RGW = 25 * MiB + 512 * 1024;
constexpr size_t WS_BETA = 26 * MiB, WS_G = 26 * MiB + 512 * 1024, WS_GL = 26 * MiB + 896 * 1024;
constexpr size_t WS_SEGA = 27 * MiB, WS_SEGH = 27 * MiB + 512 * 1024;
constexpr size_t WS_HN = 28 * MiB, WS_WF = 28 * MiB, WS_QDF = 44 * MiB, WS_X1B = 28 * MiB;
constexpr size_t WS_PROJ = 62 * MiB, WS_ACT = 62 * MiB;
constexpr size_t WS_SLAB = 198 * MiB;
constexpr size_t WS_MIX = 164 * MiB, WS_GA = 198 * MiB, WS_KTF = 214 * MiB, WS_QKF = 230 * MiB, WS_UB = 238 * MiB, WS_END = 254 * MiB;
constexpr size_t OUT_Y = 0, OUT_PRC = 17825792, OUT_PRH = 17838080, OUT_PGC = 17842176, OUT_PGS = 17879040,
                 OUT_SRC = 18403328, OUT_SRH = 18599936, OUT_SGC = 18665472, OUT_SGS = 19255296;

struct Params { const float* in[25]; float* out; unsigned char* ws; };
enum { I_XP = 0, I_XS, I_SRC, I_SRH, I_SGC, I_SGS, I_NORM1, I_WIN, I_RCW, I_RCB, I_RWA, I_RBA, I_RWI, I_RBI, I_LAM, I_GCW, I_ALOG, I_DTB, I_GNW, I_WOUT, I_NORM2, I_WG, I_WU, I_WD, I_FN };

#define DI __device__ __forceinline__
#define KAS __attribute__((address_space(4)))
DI Params load_params() {
#if defined(__HIP_DEVICE_COMPILE__)
    const KAS unsigned char* ka = (const KAS unsigned char*)__builtin_amdgcn_kernarg_segment_ptr(); asm volatile("" : "+s"(ka)); return *(const KAS Params*)ka;
#else
    return Params{};
#endif
}
template <class T> DI T vlaunder(T p) { asm volatile("" : "+v"(p)); return p; }
DI int tid_() { int t = threadIdx.x; asm volatile("" : "+v"(t)); return t; }
DI unsigned f2bf(float f) { unsigned u = __float_as_uint(f); return (u + 0x7fffu + ((u >> 16) & 1u)) >> 16; }
DI unsigned pk2(float lo, float hi) { return f2bf(lo) | (f2bf(hi) << 16); }
DI float bf2f(bf16_t b) { return __uint_as_float(((unsigned)b) << 16); }
DI float wave_sum(float v) {
#pragma unroll
    for (int o = 1; o < 64; o <<= 1) v += __shfl_xor(v, o);
    return v;
}
DI float sigm(float x) { return 1.f / (1.f + __expf(-x)); }
DI float silu(float x) { return x / (1.f + __expf(-x)); }
DI float softplus(float x) { return x > 20.f ? x : log1pf(__expf(x)); }
DI float gelu_tanh(float x) { const float u = 0.7978845608028654f * (x + 0.044715f * x * x * x); const float t = 1.f - 2.f / (1.f + __expf(2.f * u)); return 0.5f * x * (1.f + t); }
DI int crow(int reg, int hh) { return (reg & 3) + 8 * (reg >> 2) + 4 * hh; }
DI bf16x8 pack8(f32x4 a, f32x4 b) { u32x4 p; p.x = pk2(a.x, a.y); p.y = pk2(a.z, a.w); p.z = pk2(b.x, b.y); p.w = pk2(b.z, b.w); return __builtin_bit_cast(bf16x8, p); }
DI bf16x8 pack8v(const float* v) { u32x4 p; p.x = pk2(v[0], v[1]); p.y = pk2(v[2], v[3]); p.z = pk2(v[4], v[5]); p.w = pk2(v[6], v[7]); return __builtin_bit_cast(bf16x8, p); }
#define MFMA32(a, b, c) __builtin_amdgcn_mfma_f32_32x32x16_bf16((a), (b), (c), 0, 0, 0)
DI bf16x8 pack_step(const f32x16& x, int s) {
    u32x4 p;
    p.x = pk2(x[8 * s + 0], x[8 * s + 1]); p.y = pk2(x[8 * s + 2], x[8 * s + 3]); p.z = pk2(x[8 * s + 4], x[8 * s + 5]); p.w = pk2(x[8 * s + 6], x[8 * s + 7]);
    return __builtin_bit_cast(bf16x8, p);
}
DI f32x16 zero16() { f32x16 z;
#pragma unroll
    for (int i = 0; i < 16; ++i) z[i] = 0.f;
    return z; }

struct EpiProj {
    static constexpr bool PERM = true, AFTER_DRAIN = false;
    bf16_t* O; int ldc;
    DI void operator()(const f32x4 (&acc)[2][2][4][2], const pg8::Unit& u, int wr, int wc, int fr, int fq) const {
        const int row0 = u.pm * 256 + wr * 64 + fr, col0 = u.pn * 256 + wc * 32 + 8 * fq;
#pragma unroll
        for (int ai = 0; ai < 2; ++ai)
#pragma unroll
            for (int m = 0; m < 4; ++m) { bf16_t* rowp = O + (size_t)(row0 + ai * 128 + m * 16) * ldc + col0;
#pragma unroll
                for (int bj = 0; bj < 2; ++bj) { const f32x4 v0 = acc[ai][bj][m][0], v1 = acc[ai][bj][m][1];
                    u32x4 w; w.x = pg8::cvt_pk_bf16(v0[0], v0[1]); w.y = pg8::cvt_pk_bf16(v0[2], v0[3]); w.z = pg8::cvt_pk_bf16(v1[0], v1[1]); w.w = pg8::cvt_pk_bf16(v1[2], v1[3]);
                    *(u32x4*)(rowp + bj * 128) = w; } }
    }
};
struct EpiX1 {
    static constexpr bool PERM = false, AFTER_DRAIN = false;
    const float* xp; const float* xs; float* Y; bf16_t* X1B; float* SS1;
    DI void operator()(const f32x4 (&acc)[2][2][4][2], const pg8::Unit& u, int wr, int wc, int fr, int fq) const {
        const int row0 = u.pm * 256 + wr * 64 + fr, col0 = u.pn * 256 + wc * 32 + 4 * fq;
        const float* xbase = (u.pm < 64 ? xp + (size_t)row0 * DM : xs + (size_t)(row0 - NTOK_P) * DM) + col0;
        f32x4 cur[4], nxt[4];
#pragma unroll
        for (int k = 0; k < 4; ++k) cur[k] = *(const f32x4*)(xbase + (k >> 1) * 128 + (k & 1) * 16);
#pragma unroll
        for (int gi = 0; gi < 8; ++gi) { const int ai = gi >> 2, m = gi & 3, row = row0 + ai * 128 + m * 16;
            if (gi < 7) { const int a2 = (gi + 1) >> 2, m2 = (gi + 1) & 3; const float* xn = xbase + (size_t)(a2 * 128 + m2 * 16) * DM;
#pragma unroll
                for (int k = 0; k < 4; ++k) nxt[k] = *(const f32x4*)(xn + (k >> 1) * 128 + (k & 1) * 16); }
            float* yp = Y + (size_t)row * DM + col0; bf16_t* bp = X1B + (size_t)row * DM + col0; float ss = 0.f;
#pragma unroll
            for (int k = 0; k < 4; ++k) { const int bj = k >> 1, n = k & 1; const f32x4 v = acc[ai][bj][m][n] + cur[k];
                *(f32x4*)(yp + bj * 128 + n * 16) = v; u32x2 w; w.x = pg8::cvt_pk_bf16(v[0], v[1]); w.y = pg8::cvt_pk_bf16(v[2], v[3]);
                *(u32x2*)(bp + bj * 128 + n * 16) = w; ss += (v[0] * v[0] + v[1] * v[1]) + (v[2] * v[2] + v[3] * v[3]); }
            ss += __shfl_xor(ss, 16); ss += __shfl_xor(ss, 32);
            if (fq == 0) atomicAdd(SS1 + row, ss);
#pragma unroll
            for (int k = 0; k < 4; ++k) cur[k] = nxt[k]; }
    }
};
struct EpiAct {
    static constexpr bool PERM = true, AFTER_DRAIN = false;
    bf16_t* ACT; const float* SS1;
    DI void operator()(const f32x4 (&acc)[2][2][4][2], const pg8::Unit& u, int wr, int wc, int fr, int fq) const {
        const int row0 = u.pm * 256 + wr * 64 + fr, col0 = u.pn * 256 + wc * 32 + 8 * fq;
        float ssv[8];
#pragma unroll
        for (int gi = 0; gi < 8; ++gi) ssv[gi] = SS1[row0 + (gi >> 2) * 128 + (gi & 3) * 16];
#pragma unroll
        for (int ai = 0; ai < 2; ++ai)
#pragma unroll
            for (int m = 0; m < 4; ++m) { const int row = row0 + ai * 128 + m * 16; const float rstd = rsqrtf(ssv[ai * 4 + m] * (1.f / DM) + 1e-6f);
                bf16_t* rowp = ACT + (size_t)row * DFF + (col0 >> 1);
#pragma unroll
                for (int bj = 0; bj < 2; ++bj) { const f32x4 v0 = acc[ai][bj][m][0] * rstd, v1 = acc[ai][bj][m][1] * rstd;
                    u32x2 w; w.x = pg8::cvt_pk_bf16(silu(v0[0]) * v0[1], silu(v0[2]) * v0[3]); w.y = pg8::cvt_pk_bf16(silu(v1[0]) * v1[1], silu(v1[2]) * v1[3]);
                    *(u32x2*)(rowp + bj * 64) = w; } }
    }
};
struct EpiX2 {
    static constexpr bool PERM = false, AFTER_DRAIN = false;
    float* Y;
    DI void operator()(const f32x4 (&acc)[2][2][4][2], const pg8::Unit& u, int wr, int wc, int fr, int fq) const {
        const int row0 = u.pm * 256 + wr * 64 + fr, col0 = u.pn * 256 + wc * 32 + 4 * fq;
        float* ybase = Y + (size_t)row0 * DM + col0;
        f32x4 cur[4], nxt[4];
#pragma unroll
        for (int k = 0; k < 4; ++k) cur[k] = *(const f32x4*)(ybase + (k >> 1) * 128 + (k & 1) * 16);
#pragma unroll
        for (int gi = 0; gi < 8; ++gi) { const int ai = gi >> 2, m = gi & 3;
            if (gi < 7) { const int a2 = (gi + 1) >> 2, m2 = (gi + 1) & 3; const float* yn = ybase + (size_t)(a2 * 128 + m2 * 16) * DM;
#pragma unroll
                for (int k = 0; k < 4; ++k) nxt[k] = *(const f32x4*)(yn + (k >> 1) * 128 + (k & 1) * 16); }
            float* yp = ybase + (size_t)(ai * 128 + m * 16) * DM;
#pragma unroll
            for (int k = 0; k < 4; ++k) *(f32x4*)(yp + (k >> 1) * 128 + (k & 1) * 16) = cur[k] + acc[ai][k >> 1][m][k & 1];
#pragma unroll
            for (int k = 0; k < 4; ++k) cur[k] = nxt[k]; }
    }
};
struct SplitOrder {
    int G, c;
    DI bool next(int i, pg8::Unit& u) const { const int L = i * G + c; if (L >= 176) return false; const int ks = L % 11, t = L / 11; u.pm = 64 + (t >> 2); u.pn = t & 3; u.kb = ks * 512; u.ks = ks; return true; }
    DI void a_ready(const pg8::Unit&) const {}
    DI void done(const pg8::Unit&) const {}
};
struct EpiX2Split {
    static constexpr bool PERM = false, AFTER_DRAIN = false;
    float* SLAB;
    DI void operator()(const f32x4 (&acc)[2][2][4][2], const pg8::Unit& u, int wr, int wc, int fr, int fq) const {
        const int row0 = u.pm * 256 + wr * 64 + fr, col0 = u.pn * 256 + wc * 32 + 4 * fq;
        float* base = SLAB + (size_t)u.ks * (1024 * 1024) - (size_t)NTOK_P * DM;
#pragma unroll
        for (int ai = 0; ai < 2; ++ai)
#pragma unroll
            for (int m = 0; m < 4; ++m) { float* yp = base + (size_t)(row0 + ai * 128 + m * 16) * DM + col0;
#pragma unroll
                for (int bj = 0; bj < 2; ++bj)
#pragma unroll
                    for (int n = 0; n < 2; ++n) { f32x4* p = (f32x4*)(yp + bj * 128 + n * 16); *p = acc[ai][bj][m][n]; } }
    }
};

DI void p0_transpose_item(const float* W, int ldw, int nblk, int K, bf16_t* WT, int rmul, int radd, const float* ksc, LAS float* scr, int item, int lane) {
    const int kb = item / nblk, nb = item % nblk, k0 = 64 * kb, n0 = 32 * nb;
#pragma unroll 8
    for (int i = 0; i < 32; ++i) { const int kk = 2 * i + (lane >> 5); float v = W[(size_t)(k0 + kk) * ldw + n0 + (lane & 31)]; if (ksc) v *= ksc[k0 + kk]; scr[kk * 33 + (lane & 31)] = v; }
    asm volatile("s_waitcnt lgkmcnt(0)" ::: "memory");
    const int c = lane & 7;
#pragma unroll
    for (int j = 0; j < 4; ++j) { const int n = (lane >> 3) + 8 * j; const LAS float* s = scr + (8 * c) * 33 + n;
        u32x4 o; o.x = pk2(s[0 * 33], s[1 * 33]); o.y = pk2(s[2 * 33], s[3 * 33]); o.z = pk2(s[4 * 33], s[5 * 33]); o.w = pk2(s[6 * 33], s[7 * 33]);
        *(u32x4*)(WT + (size_t)((n0 + n) * rmul + radd) * K + k0 + 8 * c) = o; }
    asm volatile("s_waitcnt lgkmcnt(0)" ::: "memory");
}
DI void phase0(const Params& P, LAS unsigned char* lds) {
    const int tid = tid_(), lane = tid & 63, wave = tid >> 6, G = gridDim.x;
    unsigned char* ws = P.ws;
    LAS float* scr = (LAS float*)(lds + wave * 16384);
    const int gw = blockIdx.x * NWAVES + wave, NGW = G * NWAVES;
    constexpr int I_IN = 16 * 96, I_OUT = 16 * 32, I_G = 16 * 88, I_D = 44 * 32, NIT = I_IN + I_OUT + 2 * I_G + I_D;
    for (int it = gw; it < NIT; it += NGW) {
        int r = it;
        if (r < I_IN) { p0_transpose_item(P.in[I_WIN], DIN, 96, DM, (bf16_t*)(ws + WS_WIN), 1, 0, nullptr, scr, r, lane); continue; } r -= I_IN;
        if (r < I_OUT) { p0_transpose_item(P.in[I_WOUT], DM, 32, DM, (bf16_t*)(ws + WS_WOUT), 1, 0, nullptr, scr, r, lane); continue; } r -= I_OUT;
        if (r < I_G) { p0_transpose_item(P.in[I_WG], DFF, 88, DM, (bf16_t*)(ws + WS_WGU), 2, 0, P.in[I_NORM2], scr, r, lane); continue; } r -= I_G;
        if (r < I_G) { p0_transpose_item(P.in[I_WU], DFF, 88, DM, (bf16_t*)(ws + WS_WGU), 2, 1, P.in[I_NORM2], scr, r, lane); continue; } r -= I_G;
        p0_transpose_item(P.in[I_WD], DM, 32, DFF, (bf16_t*)(ws + WS_WDN), 1, 0, nullptr, scr, r, lane);
    }
    for (int s = blockIdx.x * NTHR + tid; s < 8192; s += G * NTHR) {
        const int l = s & 63, f = s >> 6, ks = f & 3, nt = (f >> 2) & 1, hb = (f >> 3) & 7, mat = f >> 6;
        const float* w = (mat ? P.in[I_RWI] : P.in[I_RWA]) + hb * 4096 + (16 * ks + 8 * (l >> 5)) * 64 + 32 * nt + (l & 31);
        u32x4 o; o.x = pk2(w[0], w[64]); o.y = pk2(w[128], w[192]); o.z = pk2(w[256], w[320]); o.w = pk2(w[384], w[448]);
        *(u32x4*)(ws + WS_RGW + (size_t)s * 16) = o;
    }
    __syncthreads();
    LAS float* EXT = (LAS float*)lds;
    for (int i = tid; i < 8192; i += NTHR) { const int k = i >> 3, c = i & 7, l = (k & 255) >> 2, q = k & 3, j = k >> 8;
        EXT[(((j * 4 + q) * 64 + l) << 3) + c] = P.in[I_WIN][(size_t)k * DIN + NPROJ + c]; }
    __syncthreads();
    const float* n1 = P.in[I_NORM1];
    f32x4 nw[4];
#pragma unroll
    for (int j = 0; j < 4; ++j) nw[j] = *(const f32x4*)(n1 + 4 * lane + 256 * j);
    for (int m = gw; m < NTOK; m += NGW) {
        const float* xrow = (m < NTOK_P) ? P.in[I_XP] + (size_t)m * DM : P.in[I_XS] + (size_t)(m - NTOK_P) * DM;
        f32x4 v[4]; float s = 0.f;
#pragma unroll
        for (int j = 0; j < 4; ++j) { v[j] = *(const f32x4*)(xrow + 4 * lane + 256 * j); s += (v[j].x * v[j].x + v[j].y * v[j].y) + (v[j].z * v[j].z + v[j].w * v[j].w); }
        const float rstd = rsqrtf(wave_sum(s) * (1.f / DM) + 1e-6f);
        float e[8];
#pragma unroll
        for (int c = 0; c < 8; ++c) e[c] = 0.f;
        bf16_t* orow = (bf16_t*)(ws + WS_HN) + (size_t)m * DM;
#pragma unroll
        for (int j = 0; j < 4; ++j) { v[j] = v[j] * rstd * nw[j];
            u32x2 w; w.x = pk2(v[j].x, v[j].y); w.y = pk2(v[j].z, v[j].w); *(u32x2*)(orow + 4 * lane + 256 * j) = w;
#pragma unroll
            for (int q = 0; q < 4; ++q) { const LAS f32x4* ep = (const LAS f32x4*)(EXT + (((j * 4 + q) * 64 + lane) << 3)); const f32x4 e0 = ep[0], e1 = ep[1]; const float hv = v[j][q];
                e[0] += hv * e0.x; e[1] += hv * e0.y; e[2] += hv * e0.z; e[3] += hv * e0.w; e[4] += hv * e1.x; e[5] += hv * e1.y; e[6] += hv * e1.z; e[7] += hv * e1.w; } }
#pragma unroll
        for (int c = 0; c < 8; ++c) e[c] = wave_sum(e[c]);
        if (lane < 4) { float sv = lane == 0 ? e[0] : lane == 1 ? e[1] : lane == 2 ? e[2] : e[3]; ((float*)(ws + WS_BETA))[m * 4 + lane] = sigm(sv); }
        else if (lane < 8) { const int hh = lane - 4; float sv = hh == 0 ? e[4] : hh == 1 ? e[5] : hh == 2 ? e[6] : e[7];
            ((float*)(ws + WS_G))[m * 4 + hh] = -__expf(P.in[I_ALOG][hh]) * softplus(sv + P.in[I_DTB][hh]); }
    }
}

DI void gdn_chunk_item(const Params& P, LAS unsigned char* lds, int item) {
    const int tid = tid_(), lane = tid & 63, wave = tid >> 6;
    const int h = item & 3, bn = item >> 2, b = bn >> 5, n = bn & 31;
    const int m0 = b * 2048 + n * 64, cid = (b * 4 + h) * 32 + n;
    unsigned char* ws = P.ws;
    LAS float* QT = (LAS float*)lds; LAS float* KT = QT + 64 * 132; LAS float* VT = KT + 64 * 132;
    LAS float* LM = VT + 64 * 132; LAS float* QKM = LM + 64 * 68; LAS float* SM = QKM + 64 * 68;
    const bf16_t* PROJ = (const bf16_t*)(ws + WS_PROJ);
    if (tid < 384) {
        const int cg8 = tid % 48, tg = tid / 48, mat = cg8 >> 4, d0 = (cg8 & 15) * 8, ch = mat * 512 + h * 128 + d0;
        const bf16_t* src = PROJ + (size_t)(m0 + 8 * tg) * NPROJ + 1024 + ch;
        u32x4 raw[11];
        const bool hist = (n > 0 || tg > 0);
#pragma unroll
        for (int q = 0; q < 11; ++q) { if (q >= 3 || hist) raw[q] = *(const u32x4*)(src + (q - 3) * NPROJ); else raw[q] = (u32x4){0u, 0u, 0u, 0u}; }
        const float* cw = P.in[I_GCW] + ch;
        f32x4 wv[4][2];
#pragma unroll
        for (int j = 0; j < 4; ++j) { wv[j][0] = *(const f32x4*)(cw + j * 1536); wv[j][1] = *(const f32x4*)(cw + j * 1536 + 4); }
        LAS float* T = QT + mat * (64 * 132);
#pragma unroll
        for (int i = 0; i < 8; ++i) {
            f32x4 y0 = (f32x4){0.f, 0.f, 0.f, 0.f}, y1 = y0;
#pragma unroll
            for (int j = 0; j < 4; ++j) { const u32x4 x = raw[i + j];
                const f32x4 xa = (f32x4){__uint_as_float(x.x << 16), __uint_as_float(x.x & 0xffff0000u), __uint_as_float(x.y << 16), __uint_as_float(x.y & 0xffff0000u)};
                const f32x4 xb = (f32x4){__uint_as_float(x.z << 16), __uint_as_float(x.z & 0xffff0000u), __uint_as_float(x.w << 16), __uint_as_float(x.w & 0xffff0000u)};
                y0 += wv[j][0] * xa; y1 += wv[j][1] * xb; }
            f32x4 s0, s1;
#pragma unroll
            for (int e = 0; e < 4; ++e) { s0[e] = silu(y0[e]); s1[e] = silu(y1[e]); }
            *(LAS f32x4*)(T + (8 * tg + i) * 132 + d0) = s0; *(LAS f32x4*)(T + (8 * tg + i) * 132 + d0 + 4) = s1;
            if (n == 31 && tg == 7 && i >= 5) { const u32x4 x = raw[i + 3]; float* op = P.out + OUT_PGC + (size_t)(b * 3 + (i - 5)) * 1536 + ch;
                *(f32x4*)op = (f32x4){__uint_as_float(x.x << 16), __uint_as_float(x.x & 0xffff0000u), __uint_as_float(x.y << 16), __uint_as_float(x.y & 0xffff0000u)};
                *(f32x4*)(op + 4) = (f32x4){__uint_as_float(x.z << 16), __uint_as_float(x.z & 0xffff0000u), __uint_as_float(x.w << 16), __uint_as_float(x.w & 0xffff0000u)}; }
        }
    }
    if (tid < 64) {
        SM[128 + tid] = ((const float*)(ws + WS_BETA))[(m0 + tid) * 4 + h];
        float g = ((const float*)(ws + WS_G))[(m0 + tid) * 4 + h];
#pragma unroll
        for (int o = 1; o < 64; o <<= 1) { const float t = __shfl_up(g, o); if (lane >= o) g += t; }
        SM[tid] = g; SM[64 + tid] = __expf(g);
    }
    __syncthreads();
#pragma unroll 1
    for (int k = 0; k < 8; ++k) {
        const int i = 8 * wave + k;
        const float q0 = QT[i * 132 + lane], q1 = QT[i * 132 + 64 + lane], k0 = KT[i * 132 + lane], k1 = KT[i * 132 + 64 + lane];
        const float rq = rsqrtf(wave_sum(q0 * q0 + q1 * q1) + 1e-6f) * 0.08838834764831845f, rk = rsqrtf(wave_sum(k0 * k0 + k1 * k1) + 1e-6f);
        QT[i * 132 + lane] = q0 * rq; QT[i * 132 + 64 + lane] = q1 * rq; KT[i * 132 + lane] = k0 * rk; KT[i * 132 + 64 + lane] = k1 * rk;
    }
    __syncthreads();
    {
        const int which = wave >> 2, it = (wave >> 1) & 1, jt = wave & 1, r = lane & 31, hh = lane >> 5;
        LAS float* dst = which ? QKM : LM;
        f32x16 acc = zero16();
        if (!(it == 0 && jt == 1)) {
            const LAS float* Ar = (which ? QT : KT) + (32 * it + r) * 132 + 8 * hh;
            const LAS float* Br = KT + (32 * jt + r) * 132 + 8 * hh;
#pragma unroll
            for (int ks = 0; ks < 8; ++ks) {
                const bf16x8 a = pack8(*(const LAS f32x4*)(Ar + 16 * ks), *(const LAS f32x4*)(Ar + 16 * ks + 4));
                const bf16x8 bb = pack8(*(const LAS f32x4*)(Br + 16 * ks), *(const LAS f32x4*)(Br + 16 * ks + 4));
                acc = MFMA32(a, bb, acc);
            }
        }
        const int j = 32 * jt + r; const float gcj = SM[j];
#pragma unroll
        for (int reg = 0; reg < 16; ++reg) {
            const int i = 32 * it + crow(reg, hh); const float gci = SM[i];
            float v = 0.f;
            if (which == 0) { if (j < i) v = acc[reg] * SM[128 + i] * __expf(gci - gcj); }
            else { if (j <= i) v = acc[reg] * __expf(gci - gcj); }
            dst[i * 68 + j] = v;
        }
    }
    __syncthreads();
    {
        const float gcl = SM[63];
        bf16_t* QDF = (bf16_t*)(ws + WS_QDF) + (size_t)cid * 8192; bf16_t* KTF = (bf16_t*)(ws + WS_KTF) + (size_t)cid * 8192; bf16_t* QKF = (bf16_t*)(ws + WS_QKF) + (size_t)cid * 4096;
#pragma unroll 1
        for (int s = tid; s < 2560; s += NTHR) {
            const int l = s & 63, r = l & 31, hh = l >> 5, f = s >> 6;
            float v[8];
            if (f < 16) { const int mt = f >> 3, kk = f & 7, c = 32 * mt + r, db = 16 * kk + 4 * hh; const float sc = SM[64 + c];
#pragma unroll
                for (int e = 0; e < 8; ++e) v[e] = QT[c * 132 + db + 8 * (e >> 2) + (e & 3)] * sc;
                *(bf16x8*)(QDF + f * 512 + l * 8) = pack8v(v);
            } else if (f < 32) { const int f2 = f - 16, dmt = f2 >> 2, ks = f2 & 3, d = 32 * dmt + r, cb = 16 * ks + 4 * hh;
#pragma unroll
                for (int e = 0; e < 8; ++e) { const int c = cb + 8 * (e >> 2) + (e & 3); v[e] = KT[c * 132 + d] * __expf(gcl - SM[c]); }
                *(bf16x8*)(KTF + f2 * 512 + l * 8) = pack8v(v);
            } else { const int f3 = f - 32, mt = f3 >> 2, ks = f3 & 3, i = 32 * mt + r, cb = 16 * ks + 4 * hh;
#pragma unroll
                for (int e = 0; e < 8; ++e) v[e] = QKM[i * 68 + cb + 8 * (e >> 2) + (e & 3)];
                *(bf16x8*)(QKF + f3 * 512 + l * 8) = pack8v(v);
            }
        }
        if (tid == 0) ((float*)(ws + WS_GL))[cid] = __expf(gcl);
    }
    __syncthreads();
    if (tid < 256) {
        const bool isw = tid >= 128; const int ci = tid & 127;
        LAS float* Tc = vlaunder((isw ? KT : VT) + ci);
        const LAS float* LMv = vlaunder(LM); const LAS float* SMv = vlaunder(SM);
        float x[64];
#pragma unroll
        for (int i = 0; i < 64; ++i) { const float sc = isw ? SMv[64 + i] : 1.f; x[i] = Tc[i * 132] * SMv[128 + i] * sc; }
#pragma unroll
        for (int ip = 1; ip < 64; ip += 2) {
            f32x4 la[16], lb[16];
#pragma unroll
            for (int j4 = 0; j4 < (ip + 3) / 4; ++j4) la[j4] = *(const LAS f32x4*)(LMv + ip * 68 + 4 * j4);
            if (ip + 1 < 64) {
#pragma unroll
                for (int j4 = 0; j4 < (ip + 4) / 4; ++j4) lb[j4] = *(const LAS f32x4*)(LMv + (ip + 1) * 68 + 4 * j4); }
            {   const int i = ip; float a0 = 0.f, a1 = 0.f, a2 = 0.f, a3 = 0.f;
#pragma unroll
                for (int j4 = 0; j4 < (i + 3) / 4; ++j4) { const f32x4 l4 = la[j4];
                    if (4 * j4 + 0 < i) a0 += l4.x * x[4 * j4 + 0]; if (4 * j4 + 1 < i) a1 += l4.y * x[4 * j4 + 1];
                    if (4 * j4 + 2 < i) a2 += l4.z * x[4 * j4 + 2]; if (4 * j4 + 3 < i) a3 += l4.w * x[4 * j4 + 3]; }
                x[i] -= (a0 + a1) + (a2 + a3); }
            if (ip + 1 < 64) { const int i = ip + 1; float a0 = 0.f, a1 = 0.f, a2 = 0.f, a3 = 0.f;
#pragma unroll
                for (int j4 = 0; j4 < (i + 3) / 4; ++j4) { const f32x4 l4 = lb[j4];
                    if (4 * j4 + 0 < i) a0 += l4.x * x[4 * j4 + 0]; if (4 * j4 + 1 < i) a1 += l4.y * x[4 * j4 + 1];
                    if (4 * j4 + 2 < i) a2 += l4.z * x[4 * j4 + 2]; if (4 * j4 + 3 < i) a3 += l4.w * x[4 * j4 + 3]; }
                x[i] -= (a0 + a1) + (a2 + a3); }
            asm volatile("" ::: "memory"); __builtin_amdgcn_sched_barrier(0);
        }
#pragma unroll
        for (int i = 0; i < 64; ++i) Tc[i * 132] = x[i];
    }
    __syncthreads();
    {
        bf16_t* WF = (bf16_t*)(ws + WS_WF) + (size_t)cid * 8192; bf16_t* UB = (bf16_t*)(ws + WS_UB) + (size_t)cid * 8192;
#pragma unroll 1
        for (int s = tid; s < 2048; s += NTHR) {
            float v[8];
            if (s < 1024) { const int l = s & 63, r = l & 31, hh = l >> 5, f = s >> 6, mt = f >> 3, kk = f & 7, c = 32 * mt + r, db = 16 * kk + 4 * hh;
#pragma unroll
                for (int e = 0; e < 8; ++e) v[e] = -KT[c * 132 + db + 8 * (e >> 2) + (e & 3)];
                *(bf16x8*)(WF + f * 512 + l * 8) = pack8v(v);
            } else { const int s2 = s - 1024, esmt = s2 >> 7, l = (s2 >> 1) & 63, half = s2 & 1, es = esmt >> 1, mt = esmt & 1;
#pragma unroll
                for (int e = 0; e < 8; ++e) v[e] = VT[(32 * mt + crow(8 * half + e, l >> 5)) * 132 + 32 * es + (l & 31)];
                *(bf16x8*)(UB + (esmt * 64 + l) * 16 + 8 * half) = pack8v(v);
            }
        }
    }
    __syncthreads();
}

DI void rg_tile_item(const Params& P, LAS unsigned char* lds, int T) {
    const int tid = tid_(), lane = tid & 63, wave = tid >> 6, r = lane & 31, hh = lane >> 5;
    unsigned char* ws = P.ws;
    LAS bf16_t* XC = (LAS bf16_t*)lds + wave * (64 * 72);
    const bf16_t* PROJ = (const bf16_t*)(ws + WS_PROJ);
    const int m0 = 64 * T; const bool prm = T < 256; const int sq0 = prm ? 0 : (m0 - NTOK_P) / 8;
    {
        const int c = 64 * wave + lane;
        const float* cw = P.in[I_RCW]; const float w0 = cw[c], w1 = cw[512 + c], w2 = cw[1024 + c], w3 = cw[1536 + c], cb = P.in[I_RCB][c];
        const bf16_t* src = PROJ + (size_t)m0 * NPROJ + c;
        float x3 = 0.f, x2 = 0.f, x1 = 0.f;
        if (prm && (T & 31) != 0) { x3 = bf2f(src[-3 * NPROJ]); x2 = bf2f(src[-2 * NPROJ]); x1 = bf2f(src[-NPROJ]); }
        const float* rcs = P.in[I_SRC];
        float xr[64];
#pragma unroll
        for (int i = 0; i < 64; ++i) xr[i] = bf2f(src[i * NPROJ]);
#pragma unroll
        for (int i = 0; i < 64; ++i) {
            const int seq = sq0 + (i >> 3);
            if (!prm && (i & 7) == 0) { x3 = rcs[(size_t)(seq * 3 + 0) * 512 + c]; x2 = rcs[(size_t)(seq * 3 + 1) * 512 + c]; x1 = rcs[(size_t)(seq * 3 + 2) * 512 + c]; }
            const float x0 = xr[i];
            XC[i * 72 + lane] = (bf16_t)f2bf(w0 * x3 + w1 * x2 + w2 * x1 + w3 * x0 + cb);
            if (prm) { if ((T & 31) == 31 && i >= 61) P.out[OUT_PRC + (size_t)((T >> 5) * 3 + (i - 61)) * 512 + c] = x0; }
            else { if ((i & 7) >= 5) P.out[OUT_SRC + (size_t)(seq * 3 + (i & 7) - 5) * 512 + c] = x0; }
            x3 = x2; x2 = x1; x1 = x0;
        }
    }
    asm volatile("s_waitcnt lgkmcnt(0)" ::: "memory");
    const bf16x8* RGW = (const bf16x8*)(ws + WS_RGW);
#pragma unroll 1
    for (int nt = 0; nt < 2; ++nt) {
        f32x16 aa[2], ai[2]; aa[0] = zero16(); aa[1] = zero16(); ai[0] = zero16(); ai[1] = zero16();
#pragma unroll
        for (int ks = 0; ks < 4; ++ks) {
            const bf16x8 bfa = RGW[(((0 * 8 + wave) * 2 + nt) * 4 + ks) * 64 + lane], bfi = RGW[(((1 * 8 + wave) * 2 + nt) * 4 + ks) * 64 + lane];
#pragma unroll
            for (int mt = 0; mt < 2; ++mt) { const bf16x8 a = *(const LAS bf16x8*)(XC + (32 * mt + r) * 72 + 16 * ks + 8 * hh);
                aa[mt] = MFMA32(a, bfa, aa[mt]); ai[mt] = MFMA32(a, bfi, ai[mt]); }
        }
        const int j = 64 * wave + 32 * nt + r;
        const float ba = P.in[I_RBA][j], bi = P.in[I_RBI][j], spl = -8.f * softplus(-P.in[I_LAM][j]);
        float Cc = 0.f, Pp = 1.f;
        const bf16_t* projb = PROJ + (size_t)(m0 + 4 * hh) * NPROJ + 512 + j;
        bf16_t yv[32];
#pragma unroll
        for (int q = 0; q < 32; ++q) yv[q] = projb[(size_t)(32 * (q >> 4) + 8 * ((q >> 2) & 3) + (q & 3)) * NPROJ];
        bf16_t* mixb = (bf16_t*)(ws + WS_MIX) + (size_t)(m0 + 4 * hh) * DM + j;
        bf16_t* gab = (bf16_t*)(ws + WS_GA) + (size_t)(m0 + 4 * hh) * 512 + j;
#pragma unroll
        for (int Gi = 0; Gi < 8; ++Gi) {
            const int mt = Gi >> 2, g = Gi & 3;
            bf16_t* mb = vlaunder(mixb); bf16_t* gb = vlaunder(gab);
            float Hl[4], Ac[4];
#pragma unroll
            for (int k = 0; k < 4; ++k) { const int reg = 4 * g + k, t = 32 * mt + 8 * g + 4 * hh + k;
                const float rg_ = sigm(aa[mt][reg] + ba), ig = sigm(ai[mt][reg] + bi), la = spl * rg_, a = __expf(la), mult = sqrtf(-expm1f(2.f * la));
                const float u = mult * ig * bf2f(XC[t * 72 + 32 * nt + r]);
                if (k == 0) { Hl[0] = u; Ac[0] = a; } else { Hl[k] = a * Hl[k - 1] + u; Ac[k] = a * Ac[k - 1]; } }
            const float Ag = Ac[3], Hg = Hl[3], pA = __shfl_xor(Ag, 32), pH = __shfl_xor(Hg, 32);
            const int seq = sq0 + Gi;
            if (!prm) { Cc = P.in[I_SRH][(size_t)seq * 512 + j]; Pp = 1.f; }
            float cin, pin, Cn, Pn;
            if (hh == 0) { cin = Cc; pin = Pp; Cn = pA * (Ag * Cc + Hg) + pH; Pn = Pp * Ag * pA; }
            else { cin = pA * Cc + pH; pin = Pp * pA; Cn = Ag * cin + Hg; Pn = Pp * pA * Ag; }
#pragma unroll
            for (int k = 0; k < 4; ++k) { const int tt = 32 * mt + 8 * g + k;
                const float hv = Hl[k] + Ac[k] * cin, gy = gelu_tanh(bf2f(yv[4 * Gi + k]));
                mb[(size_t)tt * DM] = (bf16_t)f2bf(gy * hv);
                if (prm) gb[(size_t)tt * 512] = (bf16_t)f2bf(gy * Ac[k] * pin);
                else if (hh == 1 && k == 3) P.out[OUT_SRH + (size_t)seq * 512 + j] = hv; }
            Cc = Cn; Pp = Pn;
            asm volatile("" ::: "memory"); __builtin_amdgcn_sched_barrier(0);
        }
        if (prm && hh == 0) { ((float*)(ws + WS_SEGA))[T * 512 + j] = Pp; ((float*)(ws + WS_SEGH))[T * 512 + j] = Cc; }
    }
    asm volatile("s_waitcnt lgkmcnt(0)" ::: "memory");
}

constexpr int SEQ_BUF = 49152;
DI void seq_step(f32x16 (&S)[4], const LAS unsigned char* bw, bf16_t* SNB, bf16_t* VNB, int cid, int es, int lane, float gl) {
    bf16x8 Sb[8];
#pragma unroll
    for (int dt = 0; dt < 4; ++dt) { Sb[2 * dt] = pack_step(S[dt], 0); Sb[2 * dt + 1] = pack_step(S[dt], 1); }
#pragma unroll
    for (int kk = 0; kk < 8; ++kk) *(bf16x8*)(SNB + (size_t)cid * 16384 + (es * 8 + kk) * 512 + lane * 8) = Sb[kk];
    f32x16 vacc[2];
#pragma unroll
    for (int mt = 0; mt < 2; ++mt) { const LAS u32x4* up = (const LAS u32x4*)(bw + 32768 + ((es * 2 + mt) * 64 + lane) * 32); const u32x4 u0 = up[0], u1 = up[1];
#pragma unroll
        for (int i = 0; i < 4; ++i) { vacc[mt][2 * i] = __uint_as_float(u0[i] << 16); vacc[mt][2 * i + 1] = __uint_as_float(u0[i] & 0xffff0000u);
            vacc[mt][8 + 2 * i] = __uint_as_float(u1[i] << 16); vacc[mt][8 + 2 * i + 1] = __uint_as_float(u1[i] & 0xffff0000u); } }
#pragma unroll
    for (int mt = 0; mt < 2; ++mt)
#pragma unroll
        for (int kk = 0; kk < 8; ++kk) vacc[mt] = MFMA32(*(const LAS bf16x8*)(bw + ((mt * 8 + kk) * 64 + lane) * 16), Sb[kk], vacc[mt]);
    bf16x8 vb[4];
#pragma unroll
    for (int ct = 0; ct < 2; ++ct) { vb[2 * ct] = pack_step(vacc[ct], 0); vb[2 * ct + 1] = pack_step(vacc[ct], 1); }
#pragma unroll
    for (int ks = 0; ks < 4; ++ks) *(bf16x8*)(VNB + (size_t)cid * 8192 + (es * 4 + ks) * 512 + lane * 8) = vb[ks];
#pragma unroll
    for (int dt = 0; dt < 4; ++dt) { S[dt] = S[dt] * gl;
#pragma unroll
        for (int ks = 0; ks < 4; ++ks) S[dt] = MFMA32(*(const LAS bf16x8*)(bw + 16384 + ((dt * 4 + ks) * 64 + lane) * 16), vb[ks], S[dt]); }
}
DI void gdn_seq_block(const Params& P, LAS unsigned char* lds, int bh) {
    const int tid = tid_(), lane = tid & 63, wave = __builtin_amdgcn_readfirstlane(tid >> 6), r = lane & 31, hh = lane >> 5;
    unsigned char* ws = P.ws;
    const unsigned char* gW = ws + WS_WF + (size_t)bh * 32 * 16384; const unsigned char* gK = ws + WS_KTF + (size_t)bh * 32 * 16384; const unsigned char* gU = ws + WS_UB + (size_t)bh * 32 * 16384;
    bf16_t* SNB = (bf16_t*)P.out; bf16_t* VNB = (bf16_t*)((unsigned char*)P.out + 32 * MiB);
    const float glv = (lane < 32) ? ((const float*)(ws + WS_GL))[bh * 32 + lane] : 0.f;
    f32x16 S[4]; S[0] = zero16(); S[1] = zero16(); S[2] = zero16(); S[3] = zero16();
    const int es = wave & 3, lt = tid - 256;
#define SEQ_STAGE(nn, bb) do { _Pragma("unroll") for (int q = 0; q < 12; ++q) { const unsigned char* g_ = (q < 4 ? gW : q < 8 ? gK : gU) + (size_t)(nn) * 16384 + ((q & 3) * 256 + lt) * 16; \
        __builtin_amdgcn_global_load_lds((const unsigned*)g_, (LAS unsigned*)(lds + (bb) * SEQ_BUF + (q >> 2) * 16384 + (q & 3) * 4096 + (wave - 4) * 1024), 16, 0, 0); } } while (0)
    if (wave >= 4) { SEQ_STAGE(0, 0); SEQ_STAGE(1, 1); asm volatile("s_waitcnt vmcnt(12)" ::: "memory"); }
    asm volatile("s_waitcnt lgkmcnt(0)" ::: "memory"); __builtin_amdgcn_s_barrier(); asm volatile("" ::: "memory");
    int bc = 0, bn = 2;
#pragma unroll 1
    for (int n = 0; n < 32; ++n) {
        if (wave >= 4) { const int ns = (n + 2 < 32) ? n + 2 : 31; SEQ_STAGE(ns, bn); asm volatile("s_waitcnt vmcnt(12)" ::: "memory"); }
        else seq_step(S, lds + bc * SEQ_BUF, SNB, VNB, bh * 32 + n, es, lane, __shfl(glv, n));
        asm volatile("s_waitcnt lgkmcnt(0)" ::: "memory"); __builtin_amdgcn_s_barrier(); asm volatile("" ::: "memory");
        bc = (bc == 2) ? 0 : bc + 1; bn = (bn == 2) ? 0 : bn + 1;
    }
    if (wave >= 4) asm volatile("s_waitcnt vmcnt(0)" ::: "memory");
    __syncthreads();
#undef SEQ_STAGE
    if (wave < 4) {
        const int e0 = 32 * es;
#pragma unroll
        for (int dt = 0; dt < 4; ++dt)
#pragma unroll
            for (int reg = 0; reg < 16; ++reg) P.out[OUT_PGS + ((size_t)bh * 128 + 32 * dt + crow(reg, hh)) * 128 + e0 + r] = S[dt][reg];
    }
}

DI void gdn_out_item(const Params& P, LAS unsigned char* lds, int cid) {
    const int tid = tid_(), lane = tid & 63, wave = tid >> 6, r = lane & 31, hh = lane >> 5;
    unsigned char* ws = P.ws;
    const int bh = cid >> 5, n = cid & 31, b = bh >> 2, h = bh & 3, mt = wave >> 2, es = wave & 3;
    const bf16_t* SNB = (const bf16_t*)P.out; const bf16_t* VNB = (const bf16_t*)((const unsigned char*)P.out + 32 * MiB);
    const bf16_t* PROJ = (const bf16_t*)(ws + WS_PROJ);
    LAS float* OB = (LAS float*)lds;
    bf16x8 a1[8], b1[8], a2[4], b2[4];
#pragma unroll
    for (int kk = 0; kk < 8; ++kk) { a1[kk] = *(const bf16x8*)((const bf16_t*)(ws + WS_QDF) + (size_t)cid * 8192 + (mt * 8 + kk) * 512 + lane * 8); b1[kk] = *(const bf16x8*)(SNB + (size_t)cid * 16384 + (es * 8 + kk) * 512 + lane * 8); }
#pragma unroll
    for (int ks = 0; ks < 4; ++ks) { a2[ks] = *(const bf16x8*)((const bf16_t*)(ws + WS_QKF) + (size_t)cid * 4096 + (mt * 4 + ks) * 512 + lane * 8); b2[ks] = *(const bf16x8*)(VNB + (size_t)cid * 8192 + (es * 4 + ks) * 512 + lane * 8); }
    const size_t mb = (size_t)b * 2048 + 64 * n + 8 * wave;
    bf16_t zr[8][2];
#pragma unroll
    for (int k = 0; k < 8; ++k) { zr[k][0] = PROJ[(mb + k) * NPROJ + 2560 + 128 * h + lane]; zr[k][1] = PROJ[(mb + k) * NPROJ + 2560 + 128 * h + 64 + lane]; }
    f32x16 oacc = zero16();
#pragma unroll
    for (int kk = 0; kk < 8; ++kk) oacc = MFMA32(a1[kk], b1[kk], oacc);
#pragma unroll
    for (int ks = 0; ks < 4; ++ks) oacc = MFMA32(a2[ks], b2[ks], oacc);
#pragma unroll
    for (int reg = 0; reg < 16; ++reg) OB[(32 * mt + crow(reg, hh)) * 132 + 32 * es + r] = oacc[reg];
    __syncthreads();
    const float gw0 = P.in[I_GNW][lane], gw1 = P.in[I_GNW][lane + 64];
#pragma unroll
    for (int k = 0; k < 8; ++k) { const int c = 8 * wave + k;
        const float o0 = OB[c * 132 + lane], o1 = OB[c * 132 + 64 + lane];
        const float rstd = rsqrtf(wave_sum(o0 * o0 + o1 * o1) * (1.f / 128.f) + 1e-6f);
        bf16_t* mp = (bf16_t*)(ws + WS_MIX) + (mb + k) * DM + 512 + 128 * h;
        mp[lane] = (bf16_t)f2bf(o0 * rstd * gw0 * silu(bf2f(zr[k][0]))); mp[lane + 64] = (bf16_t)f2bf(o1 * rstd * gw1 * silu(bf2f(zr[k][1]))); }
    __syncthreads();
}

DI void gdn_sample_item(const Params& P, LAS unsigned char* lds, int s, int h) {
    const int tid = tid_(), lane = tid & 63, wave = tid >> 6;
    unsigned char* ws = P.ws;
    LAS float* Q = (LAS float*)lds; LAS float* K = Q + 1024; LAS float* V = K + 1024; LAS float* Uu = V + 1024; LAS float* Ww = Uu + 1024; LAS float* Oo = Ww + 1024;
    LAS float* RED = Oo + 1024;
    LAS float* SMs = RED + 8192;
    const bf16_t* PROJ = (const bf16_t*)(ws + WS_PROJ);
    const int m0 = NTOK_P + 8 * s;
    if (tid < 384) {
        const int mat = tid >> 7, d = tid & 127, ch = mat * 512 + h * 128 + d;
        const float* cw = P.in[I_GCW]; const float w0 = cw[ch], w1 = cw[1536 + ch], w2 = cw[3072 + ch], w3 = cw[4608 + ch];
        const float* st = P.in[I_SGC] + (size_t)s * 3 * 1536 + ch;
        float x3 = st[0], x2 = st[1536], x1 = st[3072];
        LAS float* T = Q + mat * 1024;
#pragma unroll
        for (int t = 0; t < 8; ++t) { const float x0 = bf2f(PROJ[(size_t)(m0 + t) * NPROJ + 1024 + ch]);
            T[t * 128 + d] = silu(w0 * x3 + w1 * x2 + w2 * x1 + w3 * x0);
            if (t >= 5) P.out[OUT_SGC + (size_t)(s * 3 + t - 5) * 1536 + ch] = x0;
            x3 = x2; x2 = x1; x1 = x0; }
    }
    if (tid >= 448) {
        const int t = lane & 7;
        float g = ((const float*)(ws + WS_G))[(m0 + t) * 4 + h]; const float bt = ((const float*)(ws + WS_BETA))[(m0 + t) * 4 + h];
#pragma unroll
        for (int o = 1; o < 8; o <<= 1) { const float v = __shfl_up(g, o); if (t >= o) g += v; }
        const float tot = __shfl(g, 7);
        if (lane < 8) { SMs[t] = g; SMs[8 + t] = __expf(g); SMs[16 + t] = bt; SMs[24 + t] = __expf(tot - g); } }
    __syncthreads();
    {   const int i = wave;
        const float q0 = Q[i * 128 + lane], q1 = Q[i * 128 + 64 + lane], k0 = K[i * 128 + lane], k1 = K[i * 128 + 64 + lane];
        const float rq = rsqrtf(wave_sum(q0 * q0 + q1 * q1) + 1e-6f) * 0.08838834764831845f, rk = rsqrtf(wave_sum(k0 * k0 + k1 * k1) + 1e-6f);
        Q[i * 128 + lane] = q0 * rq; Q[i * 128 + 64 + lane] = q1 * rq; K[i * 128 + lane] = k0 * rk; K[i * 128 + 64 + lane] = k1 * rk; }
    __syncthreads();
    if (tid < 128) { const int which = tid >> 6, i = (tid >> 3) & 7, j = tid & 7;
        const LAS float* a = (which ? Q : K) + i * 128; const LAS float* bq = K + j * 128; float dot = 0.f;
        for (int d = 0; d < 128; ++d) dot += a[d] * bq[d];
        const float dec = __expf(SMs[i] - SMs[j]);
        if (which == 0) SMs[32 + i * 8 + j] = (j < i) ? dot * SMs[16 + i] * dec : 0.f;
        else SMs[96 + i * 8 + j] = (j <= i) ? dot * dec : 0.f; }
    __syncthreads();
    if (tid < 256) { const bool isw = tid >= 128; const int ci = tid & 127; float x[8];
#pragma unroll
        for (int i = 0; i < 8; ++i) { float acc = (isw ? K : V)[i * 128 + ci] * SMs[16 + i]; if (isw) acc *= SMs[8 + i];
#pragma unroll
            for (int j = 0; j < 8; ++j) if (j < i) acc -= SMs[32 + i * 8 + j] * x[j];
            x[i] = acc; (isw ? Ww : Uu)[i * 128 + ci] = acc; } }
    __syncthreads();
    {   const int e = tid & 127, dq = tid >> 7;
        const float* S0 = P.in[I_SGS] + ((size_t)(s * 4 + h) * 128 + 32 * dq) * 128 + e;
        float Sr[32];
#pragma unroll
        for (int k = 0; k < 32; ++k) Sr[k] = S0[(size_t)k * 128];
        float pv[8], po[8];
#pragma unroll
        for (int c = 0; c < 8; ++c) { pv[c] = 0.f; po[c] = 0.f; }
#pragma unroll
        for (int k = 0; k < 32; ++k) { const int d = 32 * dq + k;
#pragma unroll
            for (int c = 0; c < 8; ++c) { pv[c] += Ww[c * 128 + d] * Sr[k]; po[c] += Q[c * 128 + d] * Sr[k]; } }
#pragma unroll
        for (int c = 0; c < 8; ++c) { RED[(dq * 16 + c) * 128 + e] = pv[c]; RED[(dq * 16 + 8 + c) * 128 + e] = po[c] * SMs[8 + c]; }
        __syncthreads();
        float vn[8];
#pragma unroll
        for (int c = 0; c < 8; ++c) vn[c] = Uu[c * 128 + e] - ((RED[(0 * 16 + c) * 128 + e] + RED[(1 * 16 + c) * 128 + e]) + (RED[(2 * 16 + c) * 128 + e] + RED[(3 * 16 + c) * 128 + e]));
        const float gl = SMs[15];
        float* So = P.out + OUT_SGS + ((size_t)(s * 4 + h) * 128 + 32 * dq) * 128 + e;
#pragma unroll
        for (int k = 0; k < 32; ++k) { const int d = 32 * dq + k; float acc = Sr[k] * gl;
#pragma unroll
            for (int c = 0; c < 8; ++c) acc += K[c * 128 + d] * SMs[24 + c] * vn[c];
            So[(size_t)k * 128] = acc; }
        if (dq == 0) {
#pragma unroll
            for (int c = 0; c < 8; ++c) { float o = (RED[(0 * 16 + 8 + c) * 128 + e] + RED[(1 * 16 + 8 + c) * 128 + e]) + (RED[(2 * 16 + 8 + c) * 128 + e] + RED[(3 * 16 + 8 + c) * 128 + e]);
#pragma unroll
                for (int j = 0; j < 8; ++j) if (j <= c) o += SMs[96 + c * 8 + j] * vn[j];
                Oo[c * 128 + e] = o; } }
    }
    __syncthreads();
    {   const int c = wave; const size_t m = m0 + c;
        const float o0 = Oo[c * 128 + lane], o1 = Oo[c * 128 + 64 + lane];
        const float rstd = rsqrtf(wave_sum(o0 * o0 + o1 * o1) * (1.f / 128.f) + 1e-6f);
        const float z0 = bf2f(PROJ[m * NPROJ + 2560 + 128 * h + lane]), z1 = bf2f(PROJ[m * NPROJ + 2560 + 128 * h + 64 + lane]);
        bf16_t* mp = (bf16_t*)(ws + WS_MIX) + m * DM + 512 + 128 * h;
        mp[lane] = (bf16_t)f2bf(o0 * rstd * P.in[I_GNW][lane] * silu(z0)); mp[lane + 64] = (bf16_t)f2bf(o1 * rstd * P.in[I_GNW][lane + 64] * silu(z1)); }
    __syncthreads();
}

DI void rg_fix_item(const Params& P, int b, int n) {
    const int c = tid_(); unsigned char* ws = P.ws;
    const float* SA = (const float*)(ws + WS_SEGA); const float* SH = (const float*)(ws + WS_SEGH);
    float Cc = 0.f;
    for (int j = 0; j < n; ++j) { const int Tj = b * 32 + j; Cc = SA[Tj * 512 + c] * Cc + SH[Tj * 512 + c]; }
    bf16_t* MIX = (bf16_t*)(ws + WS_MIX); const bf16_t* GA = (const bf16_t*)(ws + WS_GA);
    const size_t mb = (size_t)b * 2048 + 64 * n;
#pragma unroll 1
    for (int i0 = 0; i0 < 64; i0 += 32) {
        bf16_t mx[32], ga[32];
#pragma unroll
        for (int i = 0; i < 32; ++i) { const size_t m = mb + i0 + i; mx[i] = MIX[m * DM + c]; ga[i] = GA[m * 512 + c]; }
#pragma unroll
        for (int i = 0; i < 32; ++i) { const size_t m = mb + i0 + i; MIX[m * DM + c] = (bf16_t)f2bf(bf2f(mx[i]) + bf2f(ga[i]) * Cc); }
    }
    if (n == 31) { const int Tj = b * 32 + 31; P.out[OUT_PRH + (size_t)b * 512 + c] = SA[Tj * 512 + c] * Cc + SH[Tj * 512 + c]; }
}

__global__ void __launch_bounds__(NTHR, 2) hybrid_fwd(Params Pk) {
    extern __shared__ __attribute__((aligned(16))) unsigned char lds_raw[];
    LAS unsigned char* lds = (LAS unsigned char*)lds_raw;
    cg::grid_group grid = cg::this_grid();
    const int G = gridDim.x;
    volatile LAS unsigned* bst = (volatile LAS unsigned*)(lds + (LDS_BYTES - 64));
    if (threadIdx.x < 2) bst[threadIdx.x] = 0u;
    __syncthreads();
    XcdBarrier xb; { const Params P = load_params(); xb = xcd_barrier_post((unsigned*)(P.ws + WS_CTL), bst); }

    { const Params P = load_params(); phase0(P, lds); }
    if (PROBE == 10) { __syncthreads(); const Params P = load_params(); phase0(P, lds); }
    grid.sync();
    {   const Params P = load_params(); unsigned char* ws = P.ws;
        pg8::Gemm g{(const bf16_t*)(ws + WS_HN), (const bf16_t*)(ws + WS_WIN), NTOK, NPROJ, DM, DM}; pg8::StaticOrder S; S.init(NTOK, NPROJ, G, (int)blockIdx.x);
        EpiProj E{(bf16_t*)(ws + WS_PROJ), NPROJ};
        pg8::gemm_phase<EpiProj, pg8::StaticOrder, true, true>(lds, g, S, E);
        if (PROBE == 11) pg8::gemm_phase<EpiProj, pg8::StaticOrder, true, true>(lds, g, S, E); }
    xcd_barrier(xb);
    for (int rep = 0; rep < (PROBE == 2 ? 2 : 1); ++rep)
    for (int it = blockIdx.x; it < 1024; it += G) { const Params P = load_params(); gdn_chunk_item(P, lds, it); }
    for (int rep = 0; rep < (PROBE == 3 ? 2 : 1); ++rep)
    for (int it = blockIdx.x; it < 272; it += G) { const Params P = load_params(); rg_tile_item(P, lds, it); __syncthreads(); }
    xcd_barrier(xb);
    if (blockIdx.x < 32) { for (int rep = 0; rep < (PROBE == 4 ? 2 : 1); ++rep) { const Params P = load_params(); gdn_seq_block(P, lds, blockIdx.x); } }
    else {
        for (int rep = 0; rep < (PROBE == 5 ? 3 : 1); ++rep)
        for (int it = blockIdx.x - 32; it < 512; it += G - 32) { const Params P = load_params(); gdn_sample_item(P, lds, it >> 2, it & 3); }
        for (int q = blockIdx.x - 32; q < 248; q += G - 32) { const Params P = load_params(); rg_fix_item(P, q / 31, 1 + q % 31); }
    }
    xcd_barrier(xb);
    for (int rep = 0; rep < (PROBE == 6 ? 2 : 1); ++rep)
    for (int it = blockIdx.x; it < 1024; it += G) { const Params P = load_params(); gdn_out_item(P, lds, it); }
    xcd_barrier(xb);
    {   const Params P = load_params(); unsigned char* ws = P.ws;
        pg8::Gemm g{(const bf16_t*)(ws + WS_MIX), (const bf16_t*)(ws + WS_WOUT), NTOK, DM, DM, DM}; pg8::StaticOrder S; S.init(NTOK, DM, G, (int)blockIdx.x);
        EpiX1 E{P.in[I_XP], P.in[I_XS], P.out + OUT_Y, (bf16_t*)(ws + WS_X1B), (float*)(ws + WS_SS1)};
        pg8::gemm_phase<EpiX1, pg8::StaticOrder, true, true>(lds, g, S, E); }
    xcd_barrier(xb);
    {   const Params P = load_params(); unsigned char* ws = P.ws;
        pg8::Gemm g{(const bf16_t*)(ws + WS_X1B), (const bf16_t*)(ws + WS_WGU), NTOK, NGU, DM, DM}; pg8::StaticOrder S; S.init(NTOK, NGU, G, (int)blockIdx.x);
        EpiAct E{(bf16_t*)(ws + WS_ACT), (const float*)(ws + WS_SS1)};
        pg8::gemm_phase<EpiAct, pg8::StaticOrder, true, true>(lds, g, S, E);
        if (PROBE == 15) pg8::gemm_phase<EpiAct, pg8::StaticOrder, true, true>(lds, g, S, E); }
    xcd_barrier(xb);
    {   const Params P = load_params(); unsigned char* ws = P.ws;
        {   pg8::Gemm g{(const bf16_t*)(ws + WS_ACT), (const bf16_t*)(ws + WS_WDN), NTOK_P, DM, DFF, DFF}; pg8::StaticOrder S; S.init(NTOK_P, DM, G, (int)blockIdx.x);
            EpiX2 E{P.out + OUT_Y};
            pg8::gemm_phase<EpiX2, pg8::StaticOrder, true, true>(lds, g, S, E); }
        {   pg8::Gemm g{(const bf16_t*)(ws + WS_ACT), (const bf16_t*)(ws + WS_WDN), NTOK, DM, 256, DFF}; SplitOrder S{G, (int)blockIdx.x};
            EpiX2Split E{(float*)(ws + WS_SLAB)};
            pg8::gemm_phase<EpiX2Split, SplitOrder, true, true>(lds, g, S, E); } }
    xcd_barrier(xb);
    {
        const Params P = load_params();
        const int tid = tid_(), lane = tid & 63, wave = tid >> 6; const float* fw = P.in[I_FN];
        f32x4 nw[4];
#pragma unroll
        for (int j = 0; j < 4; ++j) nw[j] = *(const f32x4*)(fw + 4 * lane + 256 * j);
        for (int m = blockIdx.x * NWAVES + wave; m < NTOK; m += G * NWAVES) {
            float* row = P.out + OUT_Y + (size_t)m * DM; f32x4 v[4]; float s = 0.f;
#pragma unroll
            for (int j = 0; j < 4; ++j) v[j] = *(const f32x4*)(row + 4 * lane + 256 * j);
            if (m >= NTOK_P) { const float* sl = (const float*)(P.ws + WS_SLAB) + (size_t)(m - NTOK_P) * DM + 4 * lane;
#pragma unroll
                for (int q = 0; q < 11; ++q)
#pragma unroll
                    for (int j = 0; j < 4; ++j) v[j] += *(const f32x4*)(sl + (size_t)q * (1024 * 1024) + 256 * j); }
#pragma unroll
            for (int j = 0; j < 4; ++j) s += (v[j].x * v[j].x + v[j].y * v[j].y) + (v[j].z * v[j].z + v[j].w * v[j].w);
            const float rstd = rsqrtf(wave_sum(s) * (1.f / DM) + 1e-6f);
#pragma unroll
            for (int j = 0; j < 4; ++j) *(f32x4*)(row + 4 * lane + 256 * j) = v[j] * rstd * nw[j];
        }
    }
}

extern "C" void kernel_launch(void* const* d_in, const int* in_sizes, int n_in, void* d_out, int out_size, void* d_ws, size_t ws_size, hipStream_t stream) {
    static int grid = 0;
    if (grid == 0) {
        int dev = 0, cus = 0, per_cu = 0;
        if (n_in != 25 || ws_size < WS_END) { fprintf(stderr, "kernel_launch: unexpected n_in %d / ws_size %zu\n", n_in, ws_size); grid = -1; return; }
        hipGetDevice(&dev); hipDeviceGetAttribute(&cus, hipDeviceAttributeMultiprocessorCount, dev);
        hipFuncSetAttribute((const void*)hybrid_fwd, hipFuncAttributeMaxDynamicSharedMemorySize, LDS_BYTES);
        hipOccupancyMaxActiveBlocksPerMultiprocessor(&per_cu, (const void*)hybrid_fwd, NTHR, LDS_BYTES);
        (void)hipGetLastError();
        if (per_cu < 1) { fprintf(stderr, "kernel_launch: occupancy query says %d blocks per CU\n", per_cu); per_cu = 1; }
        grid = cus;
        if (grid > 256) grid = 256;
    }
    if (grid < 0) return;
    hipMemsetAsync((char*)d_ws + WS_CTL, 0, CTL_BYTES, stream);
    Params p{};
    for (int i = 0; i < 25; ++i) p.in[i] = (const float*)d_in[i];
    p.out = (float*)d_out; p.ws = (unsigned char*)d_ws;
    void* args[] = {&p};
    hipError_t e = hipLaunchCooperativeKernel((const void*)hybrid_fwd, dim3(grid), dim3(NTHR), args, LDS_BYTES, stream);
    if (e != hipSuccess) fprintf(stderr, "cooperative launch failed: %s (grid %d)\n", hipGetErrorString(e), grid);
}
```

```cpp
#include <hip/hip_runtime.h>
#include <hip/hip_cooperative_groups.h>
#include <cstdio>
#include <cstdint>
namespace cg = cooperative_groups;
namespace pg8 {
#define PG8_LAS __attribute__((address_space(3)))
typedef unsigned short bf16_t;
typedef short bf16x8 __attribute__((ext_vector_type(8)));
typedef float f32x4 __attribute__((ext_vector_type(4)));
typedef unsigned u32x4 __attribute__((ext_vector_type(4)));
constexpr int BM = 256, BK = 64, HALF = 128, HTB = HALF * BK * 2  , STAGE_BYTES = 8 * HTB, NXCD = 8, WGM = 8;

__host__ __device__ __forceinline__ int lds_byte(int r, int c) { const int st = (r >> 4) * 2 + (c >> 5), rr = r & 15, cc = c & 31, ob = rr * 64 + cc * 2; return st * 1024 + (ob ^ (((ob >> 9) & 1) << 5)); }
__host__ __device__ __forceinline__ void stage_rc(int b, int& R, int& C) { const int st = b / 1024, sb = b % 1024, swz = sb ^ (((sb >> 9) & 1) << 5); R = (st >> 1) * 16 + swz / 64; C = (st & 1) * 32 + (swz % 64) / 2; }
__host__ __device__ __forceinline__ int perm32(int rho) { const int n = rho >> 4, i = rho & 15; return 8 * (i >> 2) + 4 * n + (i & 3); }

struct Unit { int pm, pn, kb, ks; };
struct Gemm { const bf16_t* A; const bf16_t* Bt; int M, N, K, ld; };

struct StaticOrder {
    int nM, nN, nwg, G, c;
    __host__ __device__ void init(int M, int N, int G_, int c_) { nM = M / BM; nN = N / BM; nwg = nM * nN; G = G_; c = c_; }
    __host__ __device__ bool next(int i, Unit& u) const {
        const long L = (long)i * G + c; if (L >= nwg) return false;
        int wgid = (int)L; { const int q = nwg / NXCD, r = nwg % NXCD, xcd = wgid % NXCD, off = wgid / NXCD; wgid = (xcd < r ? xcd * (q + 1) : r * (q + 1) + (xcd - r) * q) + off; }
        const int nig = WGM * nN, gid = wgid / nig, fm = gid * WGM, gsz = (nM - fm) < WGM ? (nM - fm) : WGM;
        u.pm = fm + ((wgid % nig) % gsz); u.pn = (wgid % nig) / gsz; u.kb = 0; u.ks = 0; return true;
    }
    __device__ __forceinline__ void a_ready(const Unit&) const {}
    __device__ __forceinline__ void done(const Unit&) const {}
};
__device__ __forceinline__ unsigned cvt_pk_bf16(float lo, float hi) { unsigned r; asm volatile("v_cvt_pk_bf16_f32 %0, %1, %2" : "=v"(r) : "v"(lo), "v"(hi)); return r; }
template <class Epi, class Sched, bool ALIGN_EPI = false, bool SP2 = false>
__device__ __forceinline__ void gemm_phase(PG8_LAS unsigned char* lds, const Gemm g, const Sched& S, const Epi& E) {
    int tid = threadIdx.x; asm volatile("" : "+v"(tid)); const int wid = __builtin_amdgcn_readfirstlane(tid >> 6), lane = tid & 63, wr = wid >> 2, wc = wid & 3, fr = lane & 15, fq = lane >> 4;
    const int K = g.ld, nt = g.K / BK;
    unsigned voffA[2], voffB[2];
#pragma unroll
    for (int i = 0; i < 2; ++i) { int R, C; stage_rc(tid * 16 + i * 8192, R, C); const int Rb = Epi::PERM ? ((R & ~31) + perm32(R & 31)) : R;
        voffA[i] = (unsigned)(R * K + C) * 2u; voffB[i] = (unsigned)(Rb * K + C) * 2u; }
    const size_t kstep = (size_t)(BK * 2);
    const size_t hstep = (size_t)HALF * K * 2;
    const size_t tstep = 2 * hstep;
    const unsigned ldsw = (unsigned)wid * 1024u;
    const int aoff = lds_byte(wr * 64 + fr, fq * 8), boff = lds_byte(wc * 32 + fr, fq * 8);
#define PG8_SA(b, h) (((b) * 2 + (h)) * HTB)
#define PG8_SB(b, h) ((4 + (b) * 2 + (h)) * HTB)
#define PG8_STAGE(bufoff, gbase, voff) do { _Pragma("unroll") for (int _i = 0; _i < 2; ++_i) \
        __builtin_amdgcn_global_load_lds((const unsigned*)((const char*)(gbase) + (voff)[_i]), (PG8_LAS unsigned*)(lds + (bufoff) + ldsw + _i * 8192), 16, 0, 0); } while (0)
#define PG8_LDA(dst, b, h) do { _Pragma("unroll") for (int m = 0; m < 4; ++m) _Pragma("unroll") for (int k = 0; k < 2; ++k) dst[m][k] = *(const PG8_LAS bf16x8*)(lds + PG8_SA(b, h) + aoff + m * 2048 + k * 1024); } while (0)
#define PG8_LDB(dst, b, h) do { _Pragma("unroll") for (int n = 0; n < 2; ++n) _Pragma("unroll") for (int k = 0; k < 2; ++k) dst[n][k] = *(const PG8_LAS bf16x8*)(lds + PG8_SB(b, h) + boff + n * 2048 + k * 1024); } while (0)
#define PG8_MMA(ai, bj, At, Bt) do { __builtin_amdgcn_s_setprio(1); _Pragma("unroll") for (int m = 0; m < 4; ++m) _Pragma("unroll") for (int n = 0; n < 2; ++n) _Pragma("unroll") for (int k = 0; k < 2; ++k) \
        acc[ai][bj][m][n] = __builtin_amdgcn_mfma_f32_16x16x32_bf16(Bt[n][k], At[m][k], acc[ai][bj][m][n], 0, 0, 0); __builtin_amdgcn_s_setprio(0); } while (0)
#define PG8_WAIT_V(n) asm volatile("s_waitcnt vmcnt(" #n ")" ::: "memory")
#define PG8_WAIT_L(n) asm volatile("s_waitcnt lgkmcnt(" #n ")" ::: "memory")
#define PG8_BAR __builtin_amdgcn_s_barrier()
#define PG8_SCHED __builtin_amdgcn_sched_barrier(0)
    Unit cur, nxt; int ui = 0;
    if (!S.next(0, cur)) return;
    f32x4 acc[2][2][4][2];
#pragma unroll
    for (int a = 0; a < 2; ++a)
#pragma unroll
        for (int b = 0; b < 2; ++b)
#pragma unroll
            for (int m = 0; m < 4; ++m)
#pragma unroll
                for (int n = 0; n < 2; ++n) acc[a][b][m][n] = (f32x4){0.f, 0.f, 0.f, 0.f};
    bf16x8 At[4][2], B0[2][2], B1[2][2];
    const char* cA = (const char*)g.A + (size_t)cur.pm * tstep + cur.kb; const char* cB = (const char*)g.Bt + (size_t)cur.pn * tstep + cur.kb;
    S.a_ready(cur);
    if constexpr (SP2) {
        PG8_STAGE(PG8_SB(0, 0), cB, voffB); PG8_STAGE(PG8_SB(0, 1), cB + hstep, voffB); PG8_STAGE(PG8_SA(0, 0), cA, voffA); PG8_STAGE(PG8_SA(0, 1), cA + hstep, voffA);
        if (wr == 1) PG8_BAR;
        PG8_WAIT_V(2); PG8_BAR;
        PG8_STAGE(PG8_SB(1, 0), cB + kstep, voffB); PG8_STAGE(PG8_SA(1, 0), cA + kstep, voffA); PG8_STAGE(PG8_SB(1, 1), cB + hstep + kstep, voffB);
        PG8_WAIT_V(6); PG8_BAR;
    } else {
        PG8_STAGE(PG8_SB(0, 0), cB, voffB); PG8_STAGE(PG8_SA(0, 0), cA, voffA); PG8_STAGE(PG8_SB(0, 1), cB + hstep, voffB); PG8_STAGE(PG8_SA(0, 1), cA + hstep, voffA);
        if (wr == 1) PG8_BAR;
        PG8_WAIT_V(4); PG8_BAR;
        PG8_STAGE(PG8_SB(1, 0), cB + kstep, voffB); PG8_STAGE(PG8_SA(1, 0), cA + kstep, voffA); PG8_STAGE(PG8_SB(1, 1), cB + hstep + kstep, voffB);
        PG8_WAIT_V(6); PG8_BAR;
    }
    for (;;) {
        const bool has_next = S.next(ui + 1, nxt);
        const char* nA = has_next ? (const char*)g.A + (size_t)nxt.pm * tstep + nxt.kb : cA; const char* nB = has_next ? (const char*)g.Bt + (size_t)nxt.pn * tstep + nxt.kb : cB;
        for (int t = 0; t < nt; t += 2) {
            const bool last = (t == nt - 2);
            const char* a1 = cA + (size_t)(t + 1) * kstep;
            const char* a2 = last ? nA : cA + (size_t)(t + 2) * kstep; const char* b2 = last ? nB : cB + (size_t)(t + 2) * kstep;
            const char* a3 = a2 + kstep; const char* b3 = b2 + kstep;
            if (last && has_next) S.a_ready(nxt);
            if constexpr (SP2) {
            PG8_LDB(B0, 0, 0); PG8_LDB(B1, 0, 1); PG8_SCHED; PG8_LDA(At, 0, 0); PG8_STAGE(PG8_SA(1, 1), a1 + hstep, voffA);
            PG8_WAIT_V(8); PG8_WAIT_L(0); PG8_BAR; PG8_MMA(0, 0, At, B0); PG8_MMA(0, 1, At, B1); PG8_BAR; PG8_SCHED;
            PG8_LDA(At, 0, 1); PG8_STAGE(PG8_SB(0, 0), b2, voffB); PG8_STAGE(PG8_SB(0, 1), b2 + hstep, voffB); PG8_STAGE(PG8_SA(0, 0), a2, voffA);
            PG8_WAIT_V(8); PG8_WAIT_L(0); PG8_BAR; PG8_MMA(1, 0, At, B0); PG8_MMA(1, 1, At, B1); PG8_BAR; PG8_SCHED;
            PG8_LDB(B0, 1, 0); PG8_LDB(B1, 1, 1); PG8_SCHED; PG8_LDA(At, 1, 0); PG8_STAGE(PG8_SA(0, 1), a2 + hstep, voffA);
            PG8_WAIT_V(8); PG8_WAIT_L(0); PG8_BAR; PG8_MMA(0, 0, At, B0); PG8_MMA(0, 1, At, B1); PG8_BAR; PG8_SCHED;
            PG8_LDA(At, 1, 1); PG8_STAGE(PG8_SB(1, 0), b3, voffB); PG8_STAGE(PG8_SB(1, 1), b3 + hstep, voffB); PG8_STAGE(PG8_SA(1, 0), a3, voffA);
            PG8_WAIT_V(8); PG8_WAIT_L(0); PG8_BAR; PG8_MMA(1, 0, At, B0); PG8_MMA(1, 1, At, B1); PG8_BAR; PG8_SCHED;
            } else {
            PG8_LDB(B0, 0, 0); PG8_SCHED; PG8_LDA(At, 0, 0); PG8_STAGE(PG8_SA(1, 1), a1 + hstep, voffA);
            PG8_WAIT_L(8); PG8_BAR; PG8_WAIT_L(0); PG8_MMA(0, 0, At, B0); PG8_BAR; PG8_SCHED;
            PG8_LDB(B1, 0, 1); PG8_STAGE(PG8_SB(0, 0), b2, voffB);
            PG8_BAR; PG8_WAIT_L(0); PG8_MMA(0, 1, At, B1); PG8_BAR;
            PG8_LDA(At, 0, 1); PG8_STAGE(PG8_SA(0, 0), a2, voffA);
            PG8_BAR; PG8_WAIT_L(0); PG8_MMA(1, 0, At, B0); PG8_BAR; PG8_SCHED;
            PG8_STAGE(PG8_SB(0, 1), b2 + hstep, voffB);
            PG8_WAIT_V(6); PG8_BAR; PG8_MMA(1, 1, At, B1); PG8_BAR;
            PG8_LDB(B0, 1, 0); PG8_SCHED; PG8_LDA(At, 1, 0); PG8_STAGE(PG8_SA(0, 1), a2 + hstep, voffA);
            PG8_WAIT_L(8); PG8_BAR; PG8_WAIT_L(0); PG8_MMA(0, 0, At, B0); PG8_BAR; PG8_SCHED;
            PG8_LDB(B1, 1, 1); PG8_STAGE(PG8_SB(1, 0), b3, voffB);
            PG8_BAR; PG8_WAIT_L(0); PG8_MMA(0, 1, At, B1); PG8_BAR;
            PG8_LDA(At, 1, 1); PG8_STAGE(PG8_SA(1, 0), a3, voffA);
            PG8_BAR; PG8_WAIT_L(0); PG8_MMA(1, 0, At, B0); PG8_BAR; PG8_SCHED;
            PG8_STAGE(PG8_SB(1, 1), b3 + hstep, voffB);
            PG8_WAIT_V(6); PG8_BAR; PG8_MMA(1, 1, At, B1); PG8_BAR;
            }
        }
        if constexpr (ALIGN_EPI) { if (wr == 0) PG8_BAR; }
        if constexpr (!Epi::AFTER_DRAIN) { E(acc, cur, wr, wc, fr, fq); S.done(cur); }
        if (!has_next) break;
#pragma unroll
        for (int a = 0; a < 2; ++a)
#pragma unroll
            for (int b = 0; b < 2; ++b)
#pragma unroll
                for (int m = 0; m < 4; ++m)
#pragma unroll
                    for (int n = 0; n < 2; ++n) acc[a][b][m][n] = (f32x4){0.f, 0.f, 0.f, 0.f};
        cur = nxt; cA = nA; cB = nB; ++ui;
        if constexpr (ALIGN_EPI) { if (wr == 1) PG8_BAR; }
    }
    PG8_WAIT_V(0);
    if constexpr (!ALIGN_EPI) { if (wr == 0) PG8_BAR; }
    PG8_BAR;
    if constexpr (Epi::AFTER_DRAIN) { E.fused(acc, cur, wr, wc, fr, fq, lds, wid, lane); S.done(cur); }
#undef PG8_SA
#undef PG8_SB
#undef PG8_STAGE
#undef PG8_LDA
#undef PG8_LDB
#undef PG8_MMA
#undef PG8_WAIT_V
#undef PG8_WAIT_L
#undef PG8_BAR
#undef PG8_SCHED
}
}

#define LAS __attribute__((address_space(3)))
typedef unsigned short bf16_t;
typedef short bf16x8 __attribute__((ext_vector_type(8)));
typedef float f32x4 __attribute__((ext_vector_type(4)));
typedef float f32x16 __attribute__((ext_vector_type(16)));
typedef unsigned u32x4 __attribute__((ext_vector_type(4)));
typedef unsigned u32x2 __attribute__((ext_vector_type(2)));

#define XB_TMO      128
#define XB_XCNT(j)  (256  + 64 * (j))
#define XB_XSUB(j)  (1280 + 64 * (j))
#define XB_XGEN(j)  (2304 + 64 * (j))
#define XB_TOP      3328
#define XB_TOPGEN   3392
#define XCD_BAR_WORDS 3456
#define XB_SPIN_CAP (1u << 18)

__device__ __forceinline__ unsigned xb_ld(unsigned* p)              { return __hip_atomic_load(p, __ATOMIC_RELAXED, __HIP_MEMORY_SCOPE_AGENT); }
__device__ __forceinline__ unsigned xb_add(unsigned* p, unsigned v) { return __hip_atomic_fetch_add(p, v, __ATOMIC_RELAXED, __HIP_MEMORY_SCOPE_AGENT); }
__device__ __forceinline__ unsigned xb_xcc_id() { return (unsigned)__builtin_amdgcn_s_getreg((3 << 11) | 20) & 0xFu; }
#define XB_SPIN(cond, bar) do { unsigned _sp = 0; while (cond) { __builtin_amdgcn_s_sleep(1); \
    if ((++_sp & 255u) == 0u) { if (xb_ld(&(bar)[XB_TMO])) break; if (_sp > XB_SPIN_CAP) { atomicAdd(&(bar)[XB_TMO], 1u); break; } } } } while (0)

struct XcdBarrier {
    unsigned* bar; unsigned x;
    volatile LAS unsigned* st;
};

__device__ __forceinline__ XcdBarrier xcd_barrier_post(unsigned* bar, volatile LAS unsigned* st) {
    XcdBarrier b; b.bar = bar; b.x = xb_xcc_id(); b.st = st;
    if (threadIdx.x == 0) (void)xb_add(&bar[XB_XCNT(b.x)], 1u);
    return b;
}
__device__ __forceinline__ void xcd_barrier_complete(unsigned* bar, unsigned x, unsigned& nloc, unsigned& nx) {
    const unsigned G = gridDim.x * gridDim.y * gridDim.z;
    unsigned sum, cnt, mine, sp = 0u;
    for (;;) {
        sum = 0u; cnt = 0u; mine = 0u;
#pragma unroll
        for (unsigned j = 0; j < 16; ++j) { const unsigned c = xb_ld(&bar[XB_XCNT(j)]); sum += c; cnt += (c > 0u) ? 1u : 0u; mine = (j == x) ? c : mine; }
        if (sum == G) break;
        __builtin_amdgcn_s_sleep(1);
        if ((++sp & 255u) == 0u) { if (xb_ld(&bar[XB_TMO])) break; if (sp > XB_SPIN_CAP) { atomicAdd(&bar[XB_TMO], 1u); break; } }
    }
    nloc = mine > 0u ? mine : 1u; nx = cnt > 0u ? cnt : 1u;
}

__device__ __forceinline__ void xcd_barrier(const XcdBarrier& b) {
    asm volatile("s_waitcnt vmcnt(0)" ::: "memory");
    __syncthreads();
    if (threadIdx.x == 0) {
        unsigned* bar = b.bar;
        __builtin_amdgcn_s_waitcnt(0);
        unsigned nloc = b.st[0], nx = b.st[1];
        if (nloc == 0u) { xcd_barrier_complete(bar, b.x, nloc, nx); b.st[0] = nloc; b.st[1] = nx; }
        const unsigned old = xb_add(&bar[XB_XSUB(b.x)], 1u);
        const unsigned gen = old / nloc;
        if (old + 1u == (gen + 1u) * nloc) {
            __builtin_amdgcn_fence(__ATOMIC_RELEASE, "agent");
            asm volatile("s_waitcnt vmcnt(0)" ::: "memory");
            const unsigned og = xb_add(&bar[XB_TOP], 1u);
            const unsigned tg = og / nx;
            if (og + 1u == (tg + 1u) * nx) xb_add(&bar[XB_TOPGEN], 1u);
            else XB_SPIN(xb_ld(&bar[XB_TOPGEN]) == tg, bar);
            __builtin_amdgcn_fence(__ATOMIC_ACQUIRE, "agent");
            xb_add(&bar[XB_XGEN(b.x)], 1u);
            asm volatile("s_waitcnt vmcnt(0)" ::: "memory");
        } else {
            XB_SPIN(xb_ld(&bar[XB_XGEN(b.x)]) == gen, bar);
            __builtin_amdgcn_fence(__ATOMIC_ACQUIRE, "agent");
            asm volatile("s_waitcnt vmcnt(0)" ::: "memory");
        }
    }
    __syncthreads();
}


constexpr int DM = 1024, NTOK_P = 16384, NTOK = 17408, DIN = 3080, NPROJ = 3072, DFF = 2816, NGU = 5632;
constexpr int NWAVES = 8, NTHR = 512;
constexpr int PROBE = 0;
constexpr int PROBE_T = 0; constexpr float PROBE_SC = 1e-6f;
constexpr int LDS_BYTES = 148480;
constexpr size_t MiB = 1u << 20;
constexpr size_t WS_CTL = 0, CTL_BYTES = 160 * 1024, WS_SS1 = 65536;
constexpr size_t WS_WIN = 1 * MiB, WS_WOUT = 7 * MiB, WS_WGU = 9 * MiB, WS_WDN = 20 * MiB;
constexpr size_t WS_RGW = 25 * MiB + 512 * 1024;
constexpr size_t WS_BETA = 26 * MiB, WS_G = 26 * MiB + 512 * 1024, WS_GL = 26 * MiB + 896 * 1024;
constexpr size_t WS_SEGA = 27 * MiB, WS_SEGH = 27 * MiB + 512 * 1024;
constexpr size_t WS_HN = 28 * MiB, WS_WF = 28 * MiB, WS_QDF = 44 * MiB, WS_X1B = 28 * MiB;
constexpr size_t WS_PROJ = 62 * MiB, WS_ACT = 62 * MiB;
constexpr size_t WS_SLAB2 = 198 * MiB;
constexpr size_t WS_SLAB = 198 * MiB;
constexpr size_t WS_MIX = 164 * MiB, WS_GA = 198 * MiB, WS_KTF = 214 * MiB, WS_QKF = 230 * MiB, WS_UB = 238 * MiB, WS_END = 254 * MiB;
constexpr size_t OUT_Y = 0, OUT_PRC = 17825792, OUT_PRH = 17838080, OUT_PGC = 17842176, OUT_PGS = 17879040,
                 OUT_SRC = 18403328, OUT_SRH = 18599936, OUT_SGC = 18665472, OUT_SGS = 19255296;

struct Params { const float* in[25]; float* out; unsigned char* ws; };
enum { I_XP = 0, I_XS, I_SRC, I_SRH, I_SGC, I_SGS, I_NORM1, I_WIN, I_RCW, I_RCB, I_RWA, I_RBA, I_RWI, I_RBI, I_LAM, I_GCW, I_ALOG, I_DTB, I_GNW, I_WOUT, I_NORM2, I_WG, I_WU, I_WD, I_FN };

#define DI __device__ __forceinline__
#define KAS __attribute__((address_space(4)))
DI Params load_params() {
#if defined(__HIP_DEVICE_COMPILE__)
    const KAS unsigned char* ka = (const KAS unsigned char*)__builtin_amdgcn_kernarg_segment_ptr(); asm volatile("" : "+s"(ka)); return *(const KAS Params*)ka;
#else
    return Params{};
#endif
}
template <class T> DI T vlaunder(T p) { asm volatile("" : "+v"(p)); return p; }
DI int tid_() { int t = threadIdx.x; asm volatile("" : "+v"(t)); return t; }
typedef __bf16 hbf2 __attribute__((ext_vector_type(2)));
typedef float f32x2 __attribute__((ext_vector_type(2)));
DI unsigned pk2(float lo, float hi) { const f32x2 v = {lo, hi}; return __builtin_bit_cast(unsigned, __builtin_convertvector(v, hbf2)); }
DI unsigned f2bf(float f) { return pk2(f, 0.f) & 0xffffu; }
DI float bf2f(bf16_t b) { return __uint_as_float(((unsigned)b) << 16); }
DI float dpp_add(float v, const int ctrl_sel) {
    const int x = __float_as_int(v); int y;
    if (ctrl_sel == 0) y = __builtin_amdgcn_update_dpp(x, x, 0xB1, 0xf, 0xf, false);
    else if (ctrl_sel == 1) y = __builtin_amdgcn_update_dpp(x, x, 0x4E, 0xf, 0xf, false);
    else if (ctrl_sel == 2) y = __builtin_amdgcn_update_dpp(x, x, 0x141, 0xf, 0xf, false);
    else y = __builtin_amdgcn_update_dpp(x, x, 0x140, 0xf, 0xf, false);
    return v + __int_as_float(y);
}
DI float wave_sum(float v) {
    v = dpp_add(v, 0); v = dpp_add(v, 1); v = dpp_add(v, 2); v = dpp_add(v, 3);
    v += __shfl_xor(v, 16); v += __shfl_xor(v, 32);
    return v;
}
DI float sigm(float x) { return __builtin_amdgcn_rcpf(1.f + __expf(-x)); }
DI float silu(float x) { return x * __builtin_amdgcn_rcpf(1.f + __expf(-x)); }
DI float one_minus_exp(float y, float e) { const float p = -y * (1.f + y * (0.5f + y * (0.16666667f + y * (0.041666668f + y * 0.0083333338f)))); return y > -0.3f ? p : 1.f - e; }
DI float softplus(float x) { return x > 20.f ? x : log1pf(__expf(x)); }
DI float gelu_tanh(float x) { const float u = 0.7978845608028654f * (x + 0.044715f * x * x * x); return x * __builtin_amdgcn_rcpf(1.f + __expf(-2.f * u)); }
DI int xmap(int it) { const int bx = it & 255, k = it >> 8; return (bx & 7) * 128 + (bx >> 3) + 32 * k; }
DI int crow(int reg, int hh) { return (reg & 3) + 8 * (reg >> 2) + 4 * hh; }
DI bf16x8 pack8(f32x4 a, f32x4 b) { u32x4 p; p.x = pk2(a.x, a.y); p.y = pk2(a.z, a.w); p.z = pk2(b.x, b.y); p.w = pk2(b.z, b.w); return __builtin_bit_cast(bf16x8, p); }
DI bf16x8 pack8v(const float* v) { u32x4 p; p.x = pk2(v[0], v[1]); p.y = pk2(v[2], v[3]); p.z = pk2(v[4], v[5]); p.w = pk2(v[6], v[7]); return __builtin_bit_cast(bf16x8, p); }
#define MFMA32(a, b, c) __builtin_amdgcn_mfma_f32_32x32x16_bf16((a), (b), (c), 0, 0, 0)
DI bf16x8 pack_step(const f32x16& x, int s) {
    u32x4 p;
    p.x = pk2(x[8 * s + 0], x[8 * s + 1]); p.y = pk2(x[8 * s + 2], x[8 * s + 3]); p.z = pk2(x[8 * s + 4], x[8 * s + 5]); p.w = pk2(x[8 * s + 6], x[8 * s + 7]);
    return __builtin_bit_cast(bf16x8, p);
}
DI f32x16 zero16() { f32x16 z;
#pragma unroll
    for (int i = 0; i < 16; ++i) z[i] = 0.f;
    return z; }

struct EpiProj {
    static constexpr bool PERM = true, AFTER_DRAIN = false;
    bf16_t* O; int ldc;
    DI void operator()(const f32x4 (&acc)[2][2][4][2], const pg8::Unit& u, int wr, int wc, int fr, int fq) const {
        const int row0 = u.pm * 256 + wr * 64 + fr, col0 = u.pn * 256 + wc * 32 + 8 * fq;
#pragma unroll
        for (int ai = 0; ai < 2; ++ai)
#pragma unroll
            for (int m = 0; m < 4; ++m) { bf16_t* rowp = O + (size_t)(row0 + ai * 128 + m * 16) * ldc + col0;
#pragma unroll
                for (int bj = 0; bj < 2; ++bj) { const f32x4 v0 = acc[ai][bj][m][0], v1 = acc[ai][bj][m][1];
                    u32x4 w; w.x = pg8::cvt_pk_bf16(v0[0], v0[1]); w.y = pg8::cvt_pk_bf16(v0[2], v0[3]); w.z = pg8::cvt_pk_bf16(v1[0], v1[1]); w.w = pg8::cvt_pk_bf16(v1[2], v1[3]);
                    *(u32x4*)(rowp + bj * 128) = w; } }
    }
};
template <bool ATOM> struct EpiX1T {
    static constexpr bool PERM = false, AFTER_DRAIN = false;
    const float* xp; const float* xs; bf16_t* X1B; float* SS1;
    DI void operator()(const f32x4 (&acc)[2][2][4][2], const pg8::Unit& u, int wr, int wc, int fr, int fq) const {
        const int row0 = u.pm * 256 + wr * 64 + fr, col0 = u.pn * 256 + wc * 32 + 4 * fq;
        const float* xbase = (u.pm < 64 ? xp + (size_t)row0 * DM : xs + (size_t)(row0 - NTOK_P) * DM) + col0;
        f32x4 xv[3][4];
#pragma unroll
        for (int g0 = 0; g0 < 2; ++g0) { const float* xn = xbase + (size_t)((g0 >> 2) * 128 + (g0 & 3) * 16) * DM;
#pragma unroll
            for (int k = 0; k < 4; ++k) xv[g0][k] = *(const f32x4*)(xn + (k >> 1) * 128 + (k & 1) * 16); }
#pragma unroll
        for (int gi = 0; gi < 8; ++gi) { const int ai = gi >> 2, m = gi & 3, row = row0 + ai * 128 + m * 16;
            if (gi + 2 < 8) { const int g2 = gi + 2; const float* xn = xbase + (size_t)((g2 >> 2) * 128 + (g2 & 3) * 16) * DM;
#pragma unroll
                for (int k = 0; k < 4; ++k) xv[g2 % 3][k] = *(const f32x4*)(xn + (k >> 1) * 128 + (k & 1) * 16); }
            bf16_t* bp = X1B + (size_t)row * DM + col0; float ss = 0.f;
#pragma unroll
            for (int k = 0; k < 4; ++k) { const int bj = k >> 1, n = k & 1; const f32x4 v = acc[ai][bj][m][n] + xv[gi % 3][k];
                u32x2 w; w.x = pk2(v[0], v[1]); w.y = pk2(v[2], v[3]);
                *(u32x2*)(bp + bj * 128 + n * 16) = w; ss += (v[0] * v[0] + v[1] * v[1]) + (v[2] * v[2] + v[3] * v[3]); }
            ss += __shfl_xor(ss, 16); ss += __shfl_xor(ss, 32);
            if (ATOM && fq == 0) atomicAdd(SS1 + row, ss); }
    }
};
struct EpiAct {
    static constexpr bool PERM = true, AFTER_DRAIN = false;
    bf16_t* ACT; const float* SS1;
    DI void operator()(const f32x4 (&acc)[2][2][4][2], const pg8::Unit& u, int wr, int wc, int fr, int fq) const {
        const int row0 = u.pm * 256 + wr * 64 + fr, col0 = u.pn * 256 + wc * 32 + 8 * fq;
        float ssv[8];
#pragma unroll
        for (int gi = 0; gi < 8; ++gi) ssv[gi] = SS1[row0 + (gi >> 2) * 128 + (gi & 3) * 16];
#pragma unroll
        for (int ai = 0; ai < 2; ++ai)
#pragma unroll
            for (int m = 0; m < 4; ++m) { const int row = row0 + ai * 128 + m * 16; const float rstd = rsqrtf(ssv[ai * 4 + m] * (1.f / DM) + 1e-6f);
                bf16_t* rowp = ACT + (size_t)row * DFF + (col0 >> 1);
#pragma unroll
                for (int bj = 0; bj < 2; ++bj) { const f32x4 v0 = acc[ai][bj][m][0] * rstd, v1 = acc[ai][bj][m][1] * rstd;
                    u32x2 w; w.x = pg8::cvt_pk_bf16(silu(v0[0]) * v0[1], silu(v0[2]) * v0[3]); w.y = pg8::cvt_pk_bf16(silu(v1[0]) * v1[1], silu(v1[2]) * v1[3]);
                    *(u32x2*)(rowp + bj * 64) = w; } }
    }
};
struct EpiX2 {
    static constexpr bool PERM = false, AFTER_DRAIN = false;
    float* Y; const bf16_t* X1B;
    DI void operator()(const f32x4 (&acc)[2][2][4][2], const pg8::Unit& u, int wr, int wc, int fr, int fq) const {
        const int row0 = u.pm * 256 + wr * 64 + fr, col0 = u.pn * 256 + wc * 32 + 4 * fq;
        const bf16_t* xbase = X1B + (size_t)row0 * DM + col0; float* ybase = Y + (size_t)row0 * DM + col0;
        u32x2 xv[3][4];
#pragma unroll
        for (int g0 = 0; g0 < 2; ++g0) { const bf16_t* xn = xbase + (size_t)((g0 >> 2) * 128 + (g0 & 3) * 16) * DM;
#pragma unroll
            for (int k = 0; k < 4; ++k) xv[g0][k] = *(const u32x2*)(xn + (k >> 1) * 128 + (k & 1) * 16); }
#pragma unroll
        for (int gi = 0; gi < 8; ++gi) { const int ai = gi >> 2, m = gi & 3;
            if (gi + 2 < 8) { const int g2 = gi + 2; const bf16_t* xn = xbase + (size_t)((g2 >> 2) * 128 + (g2 & 3) * 16) * DM;
#pragma unroll
                for (int k = 0; k < 4; ++k) xv[g2 % 3][k] = *(const u32x2*)(xn + (k >> 1) * 128 + (k & 1) * 16); }
            float* yp = ybase + (size_t)(ai * 128 + m * 16) * DM;
#pragma unroll
            for (int k = 0; k < 4; ++k) { const u32x2 x = xv[gi % 3][k];
                const f32x4 xf = (f32x4){__uint_as_float(x.x << 16), __uint_as_float(x.x & 0xffff0000u), __uint_as_float(x.y << 16), __uint_as_float(x.y & 0xffff0000u)};
                *(f32x4*)(yp + (k >> 1) * 128 + (k & 1) * 16) = xf + acc[ai][k >> 1][m][k & 1]; } }
    }
};
struct SplitOrder {
    int G, c;
    DI bool next(int i, pg8::Unit& u) const { const int L = i * G + c; if (L >= 176) return false; const int ks = L % 11, t = L / 11; u.pm = 64 + (t >> 2); u.pn = t & 3; u.kb = ks * 512; u.ks = ks; return true; }
    DI void a_ready(const pg8::Unit&) const {}
    DI void done(const pg8::Unit&) const {}
};
struct SampleOrder3 {
    int c;
    DI bool next(int i, pg8::Unit& u) const { if (i != 0 || c >= 48) return false; u.pm = 64 + c / 12; u.pn = c % 12; u.kb = 0; u.ks = 0; return true; }
    DI void a_ready(const pg8::Unit&) const {}
    DI void done(const pg8::Unit&) const {}
};
struct SplitOrder2 {
    int G, c;
    DI bool next(int i, pg8::Unit& u) const { const int L = i * G + c; if (L >= 64) return false; const int ks = L & 3, t = L >> 2; u.pm = 64 + (t >> 2); u.pn = t & 3; u.kb = ks * 512; u.ks = ks; return true; }
    DI void a_ready(const pg8::Unit&) const {}
    DI void done(const pg8::Unit&) const {}
};
struct EpiX2Split {
    static constexpr bool PERM = false, AFTER_DRAIN = false;
    float* SLAB;
    DI void operator()(const f32x4 (&acc)[2][2][4][2], const pg8::Unit& u, int wr, int wc, int fr, int fq) const {
        const int row0 = u.pm * 256 + wr * 64 + fr, col0 = u.pn * 256 + wc * 32 + 4 * fq;
        float* base = SLAB + (size_t)u.ks * (1024 * 1024) - (size_t)NTOK_P * DM;
#pragma unroll
        for (int ai = 0; ai < 2; ++ai)
#pragma unroll
            for (int m = 0; m < 4; ++m) { float* yp = base + (size_t)(row0 + ai * 128 + m * 16) * DM + col0;
#pragma unroll
                for (int bj = 0; bj < 2; ++bj)
#pragma unroll
                    for (int n = 0; n < 2; ++n) { f32x4* p = (f32x4*)(yp + bj * 128 + n * 16); *p = acc[ai][bj][m][n]; } }
    }
};

DI void p0_transpose_item(const float* W, int ldw, int nblk, int K, bf16_t* WT, int rmul, int radd, const float* ksc, LAS float* scr, int item, int lane) {
    const int kb = item / nblk, nb = item % nblk, k0 = 64 * kb, n0 = 32 * nb;
#pragma unroll
    for (int i = 0; i < 32; ++i) { const int kk = 2 * i + (lane >> 5); scr[kk * 33 + (lane & 31)] = W[(size_t)(k0 + kk) * ldw + n0 + (lane & 31)]; }
    const int c = lane & 7;
    f32x4 sa = (f32x4){1.f, 1.f, 1.f, 1.f}, sb = sa;
    if (ksc) { sa = *(const f32x4*)(ksc + k0 + 8 * c); sb = *(const f32x4*)(ksc + k0 + 8 * c + 4); }
    asm volatile("s_waitcnt lgkmcnt(0)" ::: "memory");
#pragma unroll
    for (int j = 0; j < 4; ++j) { const int n = (lane >> 3) + 8 * j; const LAS float* s = scr + (8 * c) * 33 + n;
        u32x4 o; o.x = pk2(s[0 * 33] * sa.x, s[1 * 33] * sa.y); o.y = pk2(s[2 * 33] * sa.z, s[3 * 33] * sa.w); o.z = pk2(s[4 * 33] * sb.x, s[5 * 33] * sb.y); o.w = pk2(s[6 * 33] * sb.z, s[7 * 33] * sb.w);
        *(u32x4*)(WT + (size_t)((n0 + n) * rmul + radd) * K + k0 + 8 * c) = o; }
    asm volatile("s_waitcnt lgkmcnt(0)" ::: "memory");
}
DI void phase0(const Params& P, LAS unsigned char* lds) {
    const int tid = tid_(), lane = tid & 63, wave = tid >> 6, G = gridDim.x;
    unsigned char* ws = P.ws;
    LAS float* scr = (LAS float*)(lds + wave * 16384);
    const int gw = blockIdx.x * NWAVES + wave, NGW = G * NWAVES;
    constexpr int I_IN = 16 * 96;
    for (int it = gw; it < I_IN + 512; it += NGW) {
        if (it < I_IN) p0_transpose_item(P.in[I_WIN], DIN, 96, DM, (bf16_t*)(ws + WS_WIN), 1, 0, nullptr, scr, it, lane);
        else p0_transpose_item(P.in[I_WOUT], DM, 32, DM, (bf16_t*)(ws + WS_WOUT), 1, 0, nullptr, scr, it - I_IN, lane); }
    for (int s = blockIdx.x * NTHR + tid; s < 8192; s += G * NTHR) {
        const int l = s & 63, f = s >> 6, ks = f & 3, nt = (f >> 2) & 1, hb = (f >> 3) & 7, mat = f >> 6;
        const float* w = (mat ? P.in[I_RWI] : P.in[I_RWA]) + hb * 4096 + (16 * ks + 8 * (l >> 5)) * 64 + 32 * nt + (l & 31);
        u32x4 o; o.x = pk2(w[0], w[64]); o.y = pk2(w[128], w[192]); o.z = pk2(w[256], w[320]); o.w = pk2(w[384], w[448]);
        *(u32x4*)(ws + WS_RGW + (size_t)s * 16) = o;
    }
    __syncthreads();
    LAS float* EXT = (LAS float*)lds;
    for (int i = tid; i < 8192; i += NTHR) { const int k = i >> 3, c = i & 7, l = (k & 255) >> 2, q = k & 3, j = k >> 8;
        EXT[(((j * 4 + q) * 64 + l) << 3) + c] = P.in[I_WIN][(size_t)k * DIN + NPROJ + c]; }
    __syncthreads();
    const float* n1 = P.in[I_NORM1];
    f32x4 nw[4];
#pragma unroll
    for (int j = 0; j < 4; ++j) nw[j] = *(const f32x4*)(n1 + 4 * lane + 256 * j);
    for (int m = gw; m < NTOK; m += NGW) {
        const float* xrow = (m < NTOK_P) ? P.in[I_XP] + (size_t)m * DM : P.in[I_XS] + (size_t)(m - NTOK_P) * DM;
        f32x4 v[4]; float s = 0.f;
#pragma unroll
        for (int j = 0; j < 4; ++j) { v[j] = *(const f32x4*)(xrow + 4 * lane + 256 * j); s += (v[j].x * v[j].x + v[j].y * v[j].y) + (v[j].z * v[j].z + v[j].w * v[j].w); }
        const float rstd = rsqrtf(wave_sum(s) * (1.f / DM) + 1e-6f);
        float e[8];
#pragma unroll
        for (int c = 0; c < 8; ++c) e[c] = 0.f;
        bf16_t* orow = (bf16_t*)(ws + WS_HN) + (size_t)m * DM;
#pragma unroll
        for (int j = 0; j < 4; ++j) { v[j] = v[j] * rstd * nw[j];
            u32x2 w; w.x = pk2(v[j].x, v[j].y); w.y = pk2(v[j].z, v[j].w); *(u32x2*)(orow + 4 * lane + 256 * j) = w;
#pragma unroll
            for (int q = 0; q < 4; ++q) { const LAS f32x4* ep = (const LAS f32x4*)(EXT + (((j * 4 + q) * 64 + lane) << 3)); const f32x4 e0 = ep[0], e1 = ep[1]; const float hv = v[j][q];
                e[0] += hv * e0.x; e[1] += hv * e0.y; e[2] += hv * e0.z; e[3] += hv * e0.w; e[4] += hv * e1.x; e[5] += hv * e1.y; e[6] += hv * e1.z; e[7] += hv * e1.w; } }
        {
            const bool b0 = lane & 1, b1 = lane & 2, b2 = lane & 4;
            float k4[4], k2[2];
#pragma unroll
            for (int q = 0; q < 4; ++q) { const float snd = b0 ? e[q] : e[q + 4]; k4[q] = (b0 ? e[q + 4] : e[q]) + __shfl_xor(snd, 1); }
#pragma unroll
            for (int q = 0; q < 2; ++q) { const float snd = b1 ? k4[q] : k4[q + 2]; k2[q] = (b1 ? k4[q + 2] : k4[q]) + __shfl_xor(snd, 2); }
            const float snd = b2 ? k2[0] : k2[1]; float sv = (b2 ? k2[1] : k2[0]) + __shfl_xor(snd, 4);
            sv += __shfl_xor(sv, 8); sv += __shfl_xor(sv, 16); sv += __shfl_xor(sv, 32);
            const int col = (b0 ? 4 : 0) + (b1 ? 2 : 0) + (b2 ? 1 : 0);
            if (lane < 8) {
                if (col < 4) ((float*)(ws + WS_BETA))[m * 4 + col] = sigm(sv);
                else ((float*)(ws + WS_G))[m * 4 + col - 4] = -__expf(P.in[I_ALOG][col - 4]) * softplus(sv + P.in[I_DTB][col - 4]); } }
    }
}

DI void late_weights(const Params& P, LAS unsigned char* lds, int vb, int nb) {
    const int tid = tid_(), lane = tid & 63, wave = tid >> 6;
    unsigned char* ws = P.ws;
    LAS float* scr = (LAS float*)(lds + wave * 16384);
    constexpr int I_G = 16 * 88, I_D = 44 * 32, NIT = 2 * I_G + I_D;
    for (int it = vb * NWAVES + wave; it < NIT; it += nb * NWAVES) {
        int r = it;
        if (r < I_G) { p0_transpose_item(P.in[I_WG], DFF, 88, DM, (bf16_t*)(ws + WS_WGU), 2, 0, P.in[I_NORM2], scr, r, lane); continue; } r -= I_G;
        if (r < I_G) { p0_transpose_item(P.in[I_WU], DFF, 88, DM, (bf16_t*)(ws + WS_WGU), 2, 1, P.in[I_NORM2], scr, r, lane); continue; } r -= I_G;
        p0_transpose_item(P.in[I_WD], DM, 32, DFF, (bf16_t*)(ws + WS_WDN), 1, 0, nullptr, scr, r, lane);
    }
}

DI void gdn_chunk_item(const Params& P, LAS unsigned char* lds, int item) {
    const int tid = tid_(), lane = tid & 63, wave = tid >> 6;
    const int h = item & 3, bn = item >> 2, b = bn >> 5, n = bn & 31;
    const int m0 = b * 2048 + n * 64, cid = (b * 4 + h) * 32 + n;
    unsigned char* ws = P.ws;
    LAS float* QT = (LAS float*)lds; LAS float* KT = QT + 64 * 132; LAS float* VT = KT + 64 * 132;
    LAS float* LM = VT + 64 * 132; LAS float* QKM = LM + 64 * 68; LAS float* SM = QKM + 64 * 68;
    const bf16_t* PROJ = (const bf16_t*)(ws + WS_PROJ);
    if (tid < 384) {
        const int cg8 = tid % 48, tg = tid / 48, mat = cg8 >> 4, d0 = (cg8 & 15) * 8, ch = mat * 512 + h * 128 + d0;
        const bf16_t* src = PROJ + (size_t)(m0 + 8 * tg) * NPROJ + 1024 + ch;
        u32x4 raw[11];
        const bool hist = (n > 0 || tg > 0);
#pragma unroll
        for (int q = 0; q < 11; ++q) { if (q >= 3 || hist) raw[q] = *(const u32x4*)(src + (q - 3) * NPROJ); else raw[q] = (u32x4){0u, 0u, 0u, 0u}; }
        const float* cw = P.in[I_GCW] + ch;
        f32x4 wv[4][2];
#pragma unroll
        for (int j = 0; j < 4; ++j) { wv[j][0] = *(const f32x4*)(cw + j * 1536); wv[j][1] = *(const f32x4*)(cw + j * 1536 + 4); }
        LAS float* T = QT + mat * (64 * 132);
#pragma unroll
        for (int i = 0; i < 8; ++i) {
            f32x4 y0 = (f32x4){0.f, 0.f, 0.f, 0.f}, y1 = y0;
#pragma unroll
            for (int j = 0; j < 4; ++j) { const u32x4 x = raw[i + j];
                const f32x4 xa = (f32x4){__uint_as_float(x.x << 16), __uint_as_float(x.x & 0xffff0000u), __uint_as_float(x.y << 16), __uint_as_float(x.y & 0xffff0000u)};
                const f32x4 xb = (f32x4){__uint_as_float(x.z << 16), __uint_as_float(x.z & 0xffff0000u), __uint_as_float(x.w << 16), __uint_as_float(x.w & 0xffff0000u)};
                y0 += wv[j][0] * xa; y1 += wv[j][1] * xb; }
            f32x4 s0, s1;
#pragma unroll
            for (int e = 0; e < 4; ++e) { s0[e] = silu(y0[e]); s1[e] = silu(y1[e]); }
            *(LAS f32x4*)(T + (8 * tg + i) * 132 + d0) = s0; *(LAS f32x4*)(T + (8 * tg + i) * 132 + d0 + 4) = s1;
            if (n == 31 && tg == 7 && i >= 5) { const u32x4 x = raw[i + 3]; float* op = P.out + OUT_PGC + (size_t)(b * 3 + (i - 5)) * 1536 + ch;
                *(f32x4*)op = (f32x4){__uint_as_float(x.x << 16), __uint_as_float(x.x & 0xffff0000u), __uint_as_float(x.y << 16), __uint_as_float(x.y & 0xffff0000u)};
                *(f32x4*)(op + 4) = (f32x4){__uint_as_float(x.z << 16), __uint_as_float(x.z & 0xffff0000u), __uint_as_float(x.w << 16), __uint_as_float(x.w & 0xffff0000u)}; }
        }
    }
    if (tid < 64) {
        SM[128 + tid] = ((const float*)(ws + WS_BETA))[(m0 + tid) * 4 + h];
        float g = ((const float*)(ws + WS_G))[(m0 + tid) * 4 + h];
#pragma unroll
        for (int o = 1; o < 64; o <<= 1) { const float t = __shfl_up(g, o); if (lane >= o) g += t; }
        SM[tid] = g; SM[64 + tid] = __expf(g);
    }
    __syncthreads();
#pragma unroll 1
    for (int k = 0; k < 8; ++k) {
        const int i = 8 * wave + k;
        const float q0 = QT[i * 132 + lane], q1 = QT[i * 132 + 64 + lane], k0 = KT[i * 132 + lane], k1 = KT[i * 132 + 64 + lane];
        const float rq = rsqrtf(wave_sum(q0 * q0 + q1 * q1) + 1e-6f) * 0.08838834764831845f, rk = rsqrtf(wave_sum(k0 * k0 + k1 * k1) + 1e-6f);
        QT[i * 132 + lane] = q0 * rq; QT[i * 132 + 64 + lane] = q1 * rq; KT[i * 132 + lane] = k0 * rk; KT[i * 132 + 64 + lane] = k1 * rk;
    }
    __syncthreads();
    {
        const int which = wave >> 2, it = (wave >> 1) & 1, jt = wave & 1, r = lane & 31, hh = lane >> 5;
        LAS float* dst = which ? QKM : LM;
        f32x16 acc = zero16();
        if (!(it == 0 && jt == 1)) {
            const LAS float* Ar = (which ? QT : KT) + (32 * it + r) * 132 + 8 * hh;
            const LAS float* Br = KT + (32 * jt + r) * 132 + 8 * hh;
#pragma unroll
            for (int ks = 0; ks < 8; ++ks) {
                const bf16x8 a = pack8(*(const LAS f32x4*)(Ar + 16 * ks), *(const LAS f32x4*)(Ar + 16 * ks + 4));
                const bf16x8 bb = pack8(*(const LAS f32x4*)(Br + 16 * ks), *(const LAS f32x4*)(Br + 16 * ks + 4));
                acc = MFMA32(a, bb, acc);
            }
        }
        const int j = 32 * jt + r; const float gcj = SM[j];
#pragma unroll
        for (int reg = 0; reg < 16; ++reg) {
            const int i = 32 * it + crow(reg, hh); const float gci = SM[i];
            float v = 0.f;
            if (which == 0) { if (j < i) v = acc[reg] * SM[128 + i] * __expf(gci - gcj); }
            else { if (j <= i) v = acc[reg] * __expf(gci - gcj); }
            dst[i * 68 + j] = v;
        }
    }
    __syncthreads();
    {
        const float gcl = SM[63];
        bf16_t* QDF = (bf16_t*)(ws + WS_QDF) + (size_t)cid * 8192; bf16_t* KTF = (bf16_t*)(ws + WS_KTF) + (size_t)cid * 8192; bf16_t* QKF = (bf16_t*)(ws + WS_QKF) + (size_t)cid * 4096;
#pragma unroll 1
        for (int s = tid; s < 2560; s += NTHR) {
            const int l = s & 63, r = l & 31, hh = l >> 5, f = s >> 6;
            float v[8];
            if (f < 16) { const int mt = f >> 3, kk = f & 7, c = 32 * mt + r, db = 16 * kk + 4 * hh; const float sc = SM[64 + c];
#pragma unroll
                for (int e = 0; e < 8; ++e) v[e] = QT[c * 132 + db + 8 * (e >> 2) + (e & 3)] * sc;
                *(bf16x8*)(QDF + f * 512 + l * 8) = pack8v(v);
            } else if (f < 32) { const int f2 = f - 16, dmt = f2 >> 2, ks = f2 & 3, d = 32 * dmt + r, cb = 16 * ks + 4 * hh;
#pragma unroll
                for (int e = 0; e < 8; ++e) { const int c = cb + 8 * (e >> 2) + (e & 3); v[e] = KT[c * 132 + d] * __expf(gcl - SM[c]); }
                *(bf16x8*)(KTF + f2 * 512 + l * 8) = pack8v(v);
            } else { const int f3 = f - 32, mt = f3 >> 2, ks = f3 & 3, i = 32 * mt + r, cb = 16 * ks + 4 * hh;
#pragma unroll
                for (int e = 0; e < 8; ++e) v[e] = QKM[i * 68 + cb + 8 * (e >> 2) + (e & 3)];
                *(bf16x8*)(QKF + f3 * 512 + l * 8) = pack8v(v);
            }
        }
        if (tid == 0) ((float*)(ws + WS_GL))[cid] = __expf(gcl);
    }
    __syncthreads();
    LAS float* TM = QKM;
    {   const int r = lane & 31, hh = lane >> 5;
        if (wave < 2 && lane < 32) {
            const LAS float* Lb = vlaunder((const LAS float*)(LM + (32 * wave) * 68 + 32 * wave));
            float x[32];
#pragma unroll
            for (int i = 0; i < 32; ++i) x[i] = (i == lane) ? 1.f : 0.f;
#pragma unroll
            for (int ip = 1; ip < 32; ip += 2) {
                f32x4 la[8], lb[8];
#pragma unroll
                for (int j4 = 0; j4 < (ip + 3) / 4; ++j4) la[j4] = *(const LAS f32x4*)(Lb + ip * 68 + 4 * j4);
                if (ip + 1 < 32) {
#pragma unroll
                    for (int j4 = 0; j4 < (ip + 4) / 4; ++j4) lb[j4] = *(const LAS f32x4*)(Lb + (ip + 1) * 68 + 4 * j4); }
                {   const int i = ip; float a0 = 0.f, a1 = 0.f, a2 = 0.f, a3 = 0.f;
#pragma unroll
                    for (int j4 = 0; j4 < (i + 3) / 4; ++j4) { const f32x4 l4 = la[j4];
                        if (4 * j4 + 0 < i) a0 += l4.x * x[4 * j4 + 0]; if (4 * j4 + 1 < i) a1 += l4.y * x[4 * j4 + 1];
                        if (4 * j4 + 2 < i) a2 += l4.z * x[4 * j4 + 2]; if (4 * j4 + 3 < i) a3 += l4.w * x[4 * j4 + 3]; }
                    x[i] -= (a0 + a1) + (a2 + a3); }
                if (ip + 1 < 32) { const int i = ip + 1; float a0 = 0.f, a1 = 0.f, a2 = 0.f, a3 = 0.f;
#pragma unroll
                    for (int j4 = 0; j4 < (i + 3) / 4; ++j4) { const f32x4 l4 = lb[j4];
                        if (4 * j4 + 0 < i) a0 += l4.x * x[4 * j4 + 0]; if (4 * j4 + 1 < i) a1 += l4.y * x[4 * j4 + 1];
                        if (4 * j4 + 2 < i) a2 += l4.z * x[4 * j4 + 2]; if (4 * j4 + 3 < i) a3 += l4.w * x[4 * j4 + 3]; }
                    x[i] -= (a0 + a1) + (a2 + a3); }
                asm volatile("" ::: "memory"); __builtin_amdgcn_sched_barrier(0);
            }
            LAS float* Tb = vlaunder(TM + (32 * wave) * 68 + 32 * wave + lane);
#pragma unroll
            for (int i = 0; i < 32; ++i) Tb[i * 68] = x[i];
        } else if (wave == 2) {
#pragma unroll
            for (int q = 0; q < 16; ++q) { const int idx = q * 64 + lane; TM[(idx >> 5) * 68 + 32 + (idx & 31)] = 0.f; }
        }
        __syncthreads();
        if (wave == 0) {
            f32x16 M = zero16();
#pragma unroll
            for (int ks = 0; ks < 2; ++ks) { const LAS float* ap = LM + (32 + r) * 68 + 16 * ks + 8 * hh; float bv[8];
#pragma unroll
                for (int e = 0; e < 8; ++e) bv[e] = TM[(16 * ks + 8 * hh + e) * 68 + r];
                M = MFMA32(pack8(*(const LAS f32x4*)ap, *(const LAS f32x4*)(ap + 4)), pack8v(bv), M); }
            f32x16 T2 = zero16();
#pragma unroll
            for (int sx = 0; sx < 2; ++sx) { const LAS float* ap = TM + (32 + r) * 68 + 32 + 16 * sx + 4 * hh;
                T2 = MFMA32(pack8(*(const LAS f32x4*)ap, *(const LAS f32x4*)(ap + 8)), pack_step(M, sx), T2); }
#pragma unroll
            for (int reg = 0; reg < 16; ++reg) TM[(32 + crow(reg, hh)) * 68 + r] = -T2[reg];
        }
        __syncthreads();
        {
            bf16_t* WF = (bf16_t*)(ws + WS_WF) + (size_t)cid * 8192; bf16_t* UB = (bf16_t*)(ws + WS_UB) + (size_t)cid * 8192;
            const int dt = wave >> 1, ct = wave & 1, mt = wave >> 2, es = wave & 3;
            f32x16 aw = zero16(), au = zero16();
#pragma unroll
            for (int ks = 0; ks < 4; ++ks) {
                float av[8], bv[8];
#pragma unroll
                for (int e = 0; e < 8; ++e) { const int j = 16 * ks + 8 * hh + e; const float bj = SM[128 + j]; av[e] = KT[j * 132 + 32 * dt + r] * bj * SM[64 + j]; bv[e] = VT[j * 132 + 32 * es + r] * bj; }
                const LAS float* tw = TM + (32 * ct + r) * 68 + 16 * ks + 8 * hh; const LAS float* tu = TM + (32 * mt + r) * 68 + 16 * ks + 8 * hh;
                aw = MFMA32(pack8v(av), pack8(*(const LAS f32x4*)tw, *(const LAS f32x4*)(tw + 4)), aw);
                au = MFMA32(pack8(*(const LAS f32x4*)tu, *(const LAS f32x4*)(tu + 4)), pack8v(bv), au);
            }
            aw = aw * -1.f;
#pragma unroll
            for (int sx = 0; sx < 2; ++sx) *(bf16x8*)(WF + (ct * 8 + 2 * dt + sx) * 512 + lane * 8) = pack_step(aw, sx);
#pragma unroll
            for (int sx = 0; sx < 2; ++sx) *(bf16x8*)(UB + ((es * 2 + mt) * 64 + lane) * 16 + 8 * sx) = pack_step(au, sx);
        }
    }
    __syncthreads();
}

DI void rg_tile_item(const Params& P, LAS unsigned char* lds, int T) {
    const int tid = tid_(), lane = tid & 63, wave = tid >> 6, r = lane & 31, hh = lane >> 5;
    unsigned char* ws = P.ws;
    LAS bf16_t* XC = (LAS bf16_t*)lds + wave * (64 * 72);
    const bf16_t* PROJ = (const bf16_t*)(ws + WS_PROJ);
    const int m0 = 64 * T; const bool prm = T < 256; const int sq0 = prm ? 0 : (m0 - NTOK_P) / 8;
    {
        const int c = 64 * wave + lane;
        const float* cw = P.in[I_RCW]; const float w0 = cw[c], w1 = cw[512 + c], w2 = cw[1024 + c], w3 = cw[1536 + c], cb = P.in[I_RCB][c];
        const bf16_t* src = PROJ + (size_t)m0 * NPROJ + c;
        float x3 = 0.f, x2 = 0.f, x1 = 0.f;
        if (prm && (T & 31) != 0) { x3 = bf2f(src[-3 * NPROJ]); x2 = bf2f(src[-2 * NPROJ]); x1 = bf2f(src[-NPROJ]); }
        const float* rcs = P.in[I_SRC];
        float xr[64];
#pragma unroll
        for (int i = 0; i < 64; ++i) xr[i] = bf2f(src[i * NPROJ]);
#pragma unroll
        for (int i = 0; i < 64; ++i) {
            const int seq = sq0 + (i >> 3);
            if (!prm && (i & 7) == 0) { x3 = rcs[(size_t)(seq * 3 + 0) * 512 + c]; x2 = rcs[(size_t)(seq * 3 + 1) * 512 + c]; x1 = rcs[(size_t)(seq * 3 + 2) * 512 + c]; }
            const float x0 = xr[i];
            XC[i * 72 + lane] = (bf16_t)f2bf(w0 * x3 + w1 * x2 + w2 * x1 + w3 * x0 + cb);
            if (prm) { if ((T & 31) == 31 && i >= 61) P.out[OUT_PRC + (size_t)((T >> 5) * 3 + (i - 61)) * 512 + c] = x0; }
            else { if ((i & 7) >= 5) P.out[OUT_SRC + (size_t)(seq * 3 + (i & 7) - 5) * 512 + c] = x0; }
            x3 = x2; x2 = x1; x1 = x0;
        }
    }
    asm volatile("s_waitcnt lgkmcnt(0)" ::: "memory");
    const bf16x8* RGW = (const bf16x8*)(ws + WS_RGW);
#pragma unroll 1
    for (int nt = 0; nt < 2; ++nt) {
        f32x16 aa[2], ai[2]; aa[0] = zero16(); aa[1] = zero16(); ai[0] = zero16(); ai[1] = zero16();
#pragma unroll
        for (int ks = 0; ks < 4; ++ks) {
            const bf16x8 bfa = RGW[(((0 * 8 + wave) * 2 + nt) * 4 + ks) * 64 + lane], bfi = RGW[(((1 * 8 + wave) * 2 + nt) * 4 + ks) * 64 + lane];
#pragma unroll
            for (int mt = 0; mt < 2; ++mt) { const bf16x8 a = *(const LAS bf16x8*)(XC + (32 * mt + r) * 72 + 16 * ks + 8 * hh);
                aa[mt] = MFMA32(a, bfa, aa[mt]); ai[mt] = MFMA32(a, bfi, ai[mt]); }
        }
        const int j = 64 * wave + 32 * nt + r;
        const float ba = P.in[I_RBA][j], bi = P.in[I_RBI][j], spl = -8.f * softplus(-P.in[I_LAM][j]);
        float Cc = 0.f, Pp = 1.f;
        const bf16_t* projb = PROJ + (size_t)(m0 + 4 * hh) * NPROJ + 512 + j;
        bf16_t yv[32];
#pragma unroll
        for (int q = 0; q < 32; ++q) yv[q] = projb[(size_t)(32 * (q >> 4) + 8 * ((q >> 2) & 3) + (q & 3)) * NPROJ];
        bf16_t* mixb = (bf16_t*)(ws + WS_MIX) + (size_t)(m0 + 4 * hh) * DM + j;
        bf16_t* gab = (bf16_t*)(ws + WS_GA) + (size_t)(m0 + 4 * hh) * 512 + j;
#pragma unroll
        for (int Gi = 0; Gi < 8; ++Gi) {
            const int mt = Gi >> 2, g = Gi & 3;
            bf16_t* mb = vlaunder(mixb); bf16_t* gb = vlaunder(gab);
            float Hl[4], Ac[4];
#pragma unroll
            for (int k = 0; k < 4; ++k) { const int reg = 4 * g + k, t = 32 * mt + 8 * g + 4 * hh + k;
                const float rg_ = sigm(aa[mt][reg] + ba), ig = sigm(ai[mt][reg] + bi), la = spl * rg_, a = __expf(la), mult = __builtin_amdgcn_sqrtf(one_minus_exp(2.f * la, a * a));
                const float u = mult * ig * bf2f(XC[t * 72 + 32 * nt + r]);
                if (k == 0) { Hl[0] = u; Ac[0] = a; } else { Hl[k] = a * Hl[k - 1] + u; Ac[k] = a * Ac[k - 1]; } }
            const float Ag = Ac[3], Hg = Hl[3], pA = __shfl_xor(Ag, 32), pH = __shfl_xor(Hg, 32);
            const int seq = sq0 + Gi;
            if (!prm) { Cc = P.in[I_SRH][(size_t)seq * 512 + j]; Pp = 1.f; }
            float cin, pin, Cn, Pn;
            if (hh == 0) { cin = Cc; pin = Pp; Cn = pA * (Ag * Cc + Hg) + pH; Pn = Pp * Ag * pA; }
            else { cin = pA * Cc + pH; pin = Pp * pA; Cn = Ag * cin + Hg; Pn = Pp * pA * Ag; }
#pragma unroll
            for (int k = 0; k < 4; ++k) { const int tt = 32 * mt + 8 * g + k;
                const float hv = Hl[k] + Ac[k] * cin, gy = gelu_tanh(bf2f(yv[4 * Gi + k]));
                mb[(size_t)tt * DM] = (bf16_t)f2bf(gy * hv);
                if (prm) gb[(size_t)tt * 512] = (bf16_t)f2bf(gy * Ac[k] * pin);
                else if (hh == 1 && k == 3) P.out[OUT_SRH + (size_t)seq * 512 + j] = hv; }
            Cc = Cn; Pp = Pn;
            asm volatile("" ::: "memory"); __builtin_amdgcn_sched_barrier(0);
        }
        if (prm && hh == 0) { ((float*)(ws + WS_SEGA))[T * 512 + j] = Pp; ((float*)(ws + WS_SEGH))[T * 512 + j] = Cc; }
    }
    asm volatile("s_waitcnt lgkmcnt(0)" ::: "memory");
}

constexpr int SEQ_BUF = 49152;
DI void seq_step(f32x16 (&S)[4], const LAS unsigned char* bw, bf16_t* SNB, bf16_t* VNB, int cid, int es, int lane, float gl) {
    bf16x8 Sb[8];
#pragma unroll
    for (int dt = 0; dt < 4; ++dt) { Sb[2 * dt] = pack_step(S[dt], 0); Sb[2 * dt + 1] = pack_step(S[dt], 1); }
#pragma unroll
    for (int kk = 0; kk < 8; ++kk) *(bf16x8*)(SNB + (size_t)cid * 16384 + (es * 8 + kk) * 512 + lane * 8) = Sb[kk];
    f32x16 vacc[2];
#pragma unroll
    for (int mt = 0; mt < 2; ++mt) { const LAS u32x4* up = (const LAS u32x4*)(bw + 32768 + ((es * 2 + mt) * 64 + lane) * 32); const u32x4 u0 = up[0], u1 = up[1];
#pragma unroll
        for (int i = 0; i < 4; ++i) { vacc[mt][2 * i] = __uint_as_float(u0[i] << 16); vacc[mt][2 * i + 1] = __uint_as_float(u0[i] & 0xffff0000u);
            vacc[mt][8 + 2 * i] = __uint_as_float(u1[i] << 16); vacc[mt][8 + 2 * i + 1] = __uint_as_float(u1[i] & 0xffff0000u); } }
#pragma unroll
    for (int mt = 0; mt < 2; ++mt)
#pragma unroll
        for (int kk = 0; kk < 8; ++kk) vacc[mt] = MFMA32(*(const LAS bf16x8*)(bw + ((mt * 8 + kk) * 64 + lane) * 16), Sb[kk], vacc[mt]);
    bf16x8 vb[4];
#pragma unroll
    for (int ct = 0; ct < 2; ++ct) { vb[2 * ct] = pack_step(vacc[ct], 0); vb[2 * ct + 1] = pack_step(vacc[ct], 1); }
#pragma unroll
    for (int ks = 0; ks < 4; ++ks) *(bf16x8*)(VNB + (size_t)cid * 8192 + (es * 4 + ks) * 512 + lane * 8) = vb[ks];
#pragma unroll
    for (int dt = 0; dt < 4; ++dt) { S[dt] = S[dt] * gl;
#pragma unroll
        for (int ks = 0; ks < 4; ++ks) S[dt] = MFMA32(*(const LAS bf16x8*)(bw + 16384 + ((dt * 4 + ks) * 64 + lane) * 16), vb[ks], S[dt]); }
}
DI void gdn_seq_block(const Params& P, LAS unsigned char* lds, int bh) {
    const int tid = tid_(), lane = tid & 63, wave = __builtin_amdgcn_readfirstlane(tid >> 6), r = lane & 31, hh = lane >> 5;
    unsigned char* ws = P.ws;
    const unsigned char* gW = ws + WS_WF + (size_t)bh * 32 * 16384; const unsigned char* gK = ws + WS_KTF + (size_t)bh * 32 * 16384; const unsigned char* gU = ws + WS_UB + (size_t)bh * 32 * 16384;
    bf16_t* SNB = (bf16_t*)P.out; bf16_t* VNB = (bf16_t*)((unsigned char*)P.out + 32 * MiB);
    const float glv = (lane < 32) ? ((const float*)(ws + WS_GL))[bh * 32 + lane] : 0.f;
    f32x16 S[4]; S[0] = zero16(); S[1] = zero16(); S[2] = zero16(); S[3] = zero16();
    const int es = wave & 3, lt = tid - 256;
#define SEQ_STAGE(nn, bb) do { _Pragma("unroll") for (int q = 0; q < 12; ++q) { const unsigned char* g_ = (q < 4 ? gW : q < 8 ? gK : gU) + (size_t)(nn) * 16384 + ((q & 3) * 256 + lt) * 16; \
        __builtin_amdgcn_global_load_lds((const unsigned*)g_, (LAS unsigned*)(lds + (bb) * SEQ_BUF + (q >> 2) * 16384 + (q & 3) * 4096 + (wave - 4) * 1024), 16, 0, 0); } } while (0)
    if (wave >= 4) {
        SEQ_STAGE(0, 0); SEQ_STAGE(1, 1); asm volatile("s_waitcnt vmcnt(12)" ::: "memory");
        __builtin_amdgcn_s_barrier(); asm volatile("" ::: "memory");
        int bn = 2;
#pragma unroll 1
        for (int n = 0; n < 32; ++n) {
            const int ns = (n + 2 < 32) ? n + 2 : 31; SEQ_STAGE(ns, bn); asm volatile("s_waitcnt vmcnt(12)" ::: "memory");
            __builtin_amdgcn_s_barrier(); asm volatile("" ::: "memory");
            bn = (bn == 2) ? 0 : bn + 1;
        }
        asm volatile("s_waitcnt vmcnt(0)" ::: "memory");
    } else {
        __builtin_amdgcn_s_barrier(); asm volatile("" ::: "memory");
        int bc = 0;
#pragma unroll 1
        for (int n = 0; n < 32; ++n) {
            seq_step(S, lds + bc * SEQ_BUF, SNB, VNB, bh * 32 + n, es, lane, __shfl(glv, n));
            asm volatile("s_waitcnt lgkmcnt(0)" ::: "memory"); __builtin_amdgcn_s_barrier(); asm volatile("" ::: "memory");
            bc = (bc == 2) ? 0 : bc + 1;
        }
    }
    __syncthreads();
#undef SEQ_STAGE
    if (wave < 4) {
        const int e0 = 32 * es;
#pragma unroll
        for (int dt = 0; dt < 4; ++dt)
#pragma unroll
            for (int reg = 0; reg < 16; ++reg) P.out[OUT_PGS + ((size_t)bh * 128 + 32 * dt + crow(reg, hh)) * 128 + e0 + r] = S[dt][reg];
    }
}

DI void gdn_out_item(const Params& P, LAS unsigned char* lds, int cid) {
    const int tid = tid_(), lane = tid & 63, wave = tid >> 6, r = lane & 31, hh = lane >> 5;
    unsigned char* ws = P.ws;
    const int bh = cid >> 5, n = cid & 31, b = bh >> 2, h = bh & 3, mt = wave >> 2, es = wave & 3;
    const bf16_t* SNB = (const bf16_t*)P.out; const bf16_t* VNB = (const bf16_t*)((const unsigned char*)P.out + 32 * MiB);
    const bf16_t* PROJ = (const bf16_t*)(ws + WS_PROJ);
    LAS float* OB = (LAS float*)lds;
    bf16x8 a1[8], b1[8], a2[4], b2[4];
#pragma unroll
    for (int kk = 0; kk < 8; ++kk) { a1[kk] = *(const bf16x8*)((const bf16_t*)(ws + WS_QDF) + (size_t)cid * 8192 + (mt * 8 + kk) * 512 + lane * 8); b1[kk] = *(const bf16x8*)(SNB + (size_t)cid * 16384 + (es * 8 + kk) * 512 + lane * 8); }
#pragma unroll
    for (int ks = 0; ks < 4; ++ks) { a2[ks] = *(const bf16x8*)((const bf16_t*)(ws + WS_QKF) + (size_t)cid * 4096 + (mt * 4 + ks) * 512 + lane * 8); b2[ks] = *(const bf16x8*)(VNB + (size_t)cid * 8192 + (es * 4 + ks) * 512 + lane * 8); }
    const size_t mb = (size_t)b * 2048 + 64 * n + 8 * wave;
    bf16_t zr[8][2];
#pragma unroll
    for (int k = 0; k < 8; ++k) { zr[k][0] = PROJ[(mb + k) * NPROJ + 2560 + 128 * h + lane]; zr[k][1] = PROJ[(mb + k) * NPROJ + 2560 + 128 * h + 64 + lane]; }
    f32x16 oacc = zero16();
#pragma unroll
    for (int kk = 0; kk < 8; ++kk) oacc = MFMA32(a1[kk], b1[kk], oacc);
#pragma unroll
    for (int ks = 0; ks < 4; ++ks) oacc = MFMA32(a2[ks], b2[ks], oacc);
#pragma unroll
    for (int reg = 0; reg < 16; ++reg) OB[(32 * mt + crow(reg, hh)) * 132 + 32 * es + r] = oacc[reg];
    __syncthreads();
    const float gw0 = P.in[I_GNW][lane], gw1 = P.in[I_GNW][lane + 64];
#pragma unroll
    for (int k = 0; k < 8; ++k) { const int c = 8 * wave + k;
        const float o0 = OB[c * 132 + lane], o1 = OB[c * 132 + 64 + lane];
        const float rstd = rsqrtf(wave_sum(o0 * o0 + o1 * o1) * (1.f / 128.f) + 1e-6f);
        bf16_t* mp = (bf16_t*)(ws + WS_MIX) + (mb + k) * DM + 512 + 128 * h;
        mp[lane] = (bf16_t)f2bf(o0 * rstd * gw0 * silu(bf2f(zr[k][0]))); mp[lane + 64] = (bf16_t)f2bf(o1 * rstd * gw1 * silu(bf2f(zr[k][1]))); }
    __syncthreads();
}

DI void gdn_sample_item(const Params& P, LAS unsigned char* lds, int s, int h) {
    const int tid = tid_(), lane = tid & 63, wave = tid >> 6;
    unsigned char* ws = P.ws;
    LAS float* Q = (LAS float*)lds; LAS float* K = Q + 1024; LAS float* V = K + 1024; LAS float* Uu = V + 1024; LAS float* Ww = Uu + 1024; LAS float* Oo = Ww + 1024;
    LAS float* RED = Oo + 1024;
    LAS float* SMs = RED + 8192;
    const bf16_t* PROJ = (const bf16_t*)(ws + WS_PROJ);
    const int m0 = NTOK_P + 8 * s;
    float Sr[32];
    {   const float* S0 = P.in[I_SGS] + ((size_t)(s * 4 + h) * 128 + 32 * (tid >> 7)) * 128 + (tid & 127);
#pragma unroll
        for (int k = 0; k < 32; ++k) Sr[k] = S0[(size_t)k * 128]; }
    const bf16_t zq0 = PROJ[(size_t)(m0 + wave) * NPROJ + 2560 + 128 * h + lane], zq1 = PROJ[(size_t)(m0 + wave) * NPROJ + 2560 + 128 * h + 64 + lane];
    const float gq = ((const float*)(ws + WS_G))[(m0 + (lane & 7)) * 4 + h], bq = ((const float*)(ws + WS_BETA))[(m0 + (lane & 7)) * 4 + h];
    const float gnw0 = P.in[I_GNW][lane], gnw1 = P.in[I_GNW][lane + 64];
    if (tid < 384) {
        const int mat = tid >> 7, d = tid & 127, ch = mat * 512 + h * 128 + d;
        const float* cw = P.in[I_GCW]; const float w0 = cw[ch], w1 = cw[1536 + ch], w2 = cw[3072 + ch], w3 = cw[4608 + ch];
        const float* st = P.in[I_SGC] + (size_t)s * 3 * 1536 + ch;
        float x3 = st[0], x2 = st[1536], x1 = st[3072];
        LAS float* T = Q + mat * 1024;
#pragma unroll
        for (int t = 0; t < 8; ++t) { const float x0 = bf2f(PROJ[(size_t)(m0 + t) * NPROJ + 1024 + ch]);
            T[t * 128 + d] = silu(w0 * x3 + w1 * x2 + w2 * x1 + w3 * x0);
            if (t >= 5) P.out[OUT_SGC + (size_t)(s * 3 + t - 5) * 1536 + ch] = x0;
            x3 = x2; x2 = x1; x1 = x0; }
    }
    if (tid >= 448) {
        const int t = lane & 7;
        float g = gq; const float bt = bq;
#pragma unroll
        for (int o = 1; o < 8; o <<= 1) { const float v = __shfl_up(g, o); if (t >= o) g += v; }
        const float tot = __shfl(g, 7);
        if (lane < 8) { SMs[t] = g; SMs[8 + t] = __expf(g); SMs[16 + t] = bt; SMs[24 + t] = __expf(tot - g); } }
    __syncthreads();
    {   const int i = wave;
        const float q0 = Q[i * 128 + lane], q1 = Q[i * 128 + 64 + lane], k0 = K[i * 128 + lane], k1 = K[i * 128 + 64 + lane];
        const float rq = rsqrtf(wave_sum(q0 * q0 + q1 * q1) + 1e-6f) * 0.08838834764831845f, rk = rsqrtf(wave_sum(k0 * k0 + k1 * k1) + 1e-6f);
        Q[i * 128 + lane] = q0 * rq; Q[i * 128 + 64 + lane] = q1 * rq; K[i * 128 + lane] = k0 * rk; K[i * 128 + 64 + lane] = k1 * rk; }
    __syncthreads();
    if (tid < 128) { const int which = tid >> 6, i = (tid >> 3) & 7, j = tid & 7;
        const LAS float* a = (which ? Q : K) + i * 128; const LAS float* bq = K + j * 128; float dot = 0.f;
        for (int d = 0; d < 128; ++d) dot += a[d] * bq[d];
        const float dec = __expf(SMs[i] - SMs[j]);
        if (which == 0) SMs[32 + i * 8 + j] = (j < i) ? dot * SMs[16 + i] * dec : 0.f;
        else SMs[96 + i * 8 + j] = (j <= i) ? dot * dec : 0.f; }
    __syncthreads();
    if (tid < 256) { const bool isw = tid >= 128; const int ci = tid & 127; float x[8];
#pragma unroll
        for (int i = 0; i < 8; ++i) { float acc = (isw ? K : V)[i * 128 + ci] * SMs[16 + i]; if (isw) acc *= SMs[8 + i];
#pragma unroll
            for (int j = 0; j < 8; ++j) if (j < i) acc -= SMs[32 + i * 8 + j] * x[j];
            x[i] = acc; (isw ? Ww : Uu)[i * 128 + ci] = acc; } }
    __syncthreads();
    {   const int e = tid & 127, dq = tid >> 7;
        float pv[8], po[8];
#pragma unroll
        for (int c = 0; c < 8; ++c) { pv[c] = 0.f; po[c] = 0.f; }
#pragma unroll
        for (int k4 = 0; k4 < 8; ++k4) { const int d = 32 * dq + 4 * k4;
#pragma unroll
            for (int c = 0; c < 8; ++c) { const f32x4 w4 = *(const LAS f32x4*)(Ww + c * 128 + d), q4 = *(const LAS f32x4*)(Q + c * 128 + d);
                pv[c] += (w4.x * Sr[4 * k4] + w4.y * Sr[4 * k4 + 1]) + (w4.z * Sr[4 * k4 + 2] + w4.w * Sr[4 * k4 + 3]);
                po[c] += (q4.x * Sr[4 * k4] + q4.y * Sr[4 * k4 + 1]) + (q4.z * Sr[4 * k4 + 2] + q4.w * Sr[4 * k4 + 3]); } }
#pragma unroll
        for (int c = 0; c < 8; ++c) { RED[(dq * 16 + c) * 128 + e] = pv[c]; RED[(dq * 16 + 8 + c) * 128 + e] = po[c] * SMs[8 + c]; }
        __syncthreads();
        float vn[8];
#pragma unroll
        for (int c = 0; c < 8; ++c) vn[c] = Uu[c * 128 + e] - ((RED[(0 * 16 + c) * 128 + e] + RED[(1 * 16 + c) * 128 + e]) + (RED[(2 * 16 + c) * 128 + e] + RED[(3 * 16 + c) * 128 + e]));
        const float gl = SMs[15];
        float* So = P.out + OUT_SGS + ((size_t)(s * 4 + h) * 128 + 32 * dq) * 128 + e;
        float kv[8];
#pragma unroll
        for (int c = 0; c < 8; ++c) kv[c] = SMs[24 + c] * vn[c];
#pragma unroll
        for (int k4 = 0; k4 < 8; ++k4) { const int d = 32 * dq + 4 * k4; f32x4 acc = (f32x4){Sr[4 * k4] * gl, Sr[4 * k4 + 1] * gl, Sr[4 * k4 + 2] * gl, Sr[4 * k4 + 3] * gl};
#pragma unroll
            for (int c = 0; c < 8; ++c) acc += *(const LAS f32x4*)(K + c * 128 + d) * kv[c];
            So[(size_t)(4 * k4) * 128] = acc.x; So[(size_t)(4 * k4 + 1) * 128] = acc.y; So[(size_t)(4 * k4 + 2) * 128] = acc.z; So[(size_t)(4 * k4 + 3) * 128] = acc.w; }
        if (dq == 0) {
#pragma unroll
            for (int c = 0; c < 8; ++c) { float o = (RED[(0 * 16 + 8 + c) * 128 + e] + RED[(1 * 16 + 8 + c) * 128 + e]) + (RED[(2 * 16 + 8 + c) * 128 + e] + RED[(3 * 16 + 8 + c) * 128 + e]);
#pragma unroll
                for (int j = 0; j < 8; ++j) if (j <= c) o += SMs[96 + c * 8 + j] * vn[j];
                Oo[c * 128 + e] = o; } }
    }
    __syncthreads();
    {   const int c = wave; const size_t m = m0 + c;
        const float o0 = Oo[c * 128 + lane], o1 = Oo[c * 128 + 64 + lane];
        const float rstd = rsqrtf(wave_sum(o0 * o0 + o1 * o1) * (1.f / 128.f) + 1e-6f);
        const float z0 = bf2f(zq0), z1 = bf2f(zq1);
        bf16_t* mp = (bf16_t*)(ws + WS_MIX) + m * DM + 512 + 128 * h;
        mp[lane] = (bf16_t)f2bf(o0 * rstd * gnw0 * silu(z0)); mp[lane + 64] = (bf16_t)f2bf(o1 * rstd * gnw1 * silu(z1)); }
    __syncthreads();
}

DI void rg_fix_item(const Params& P, int b, int n) {
    const int c = tid_(); unsigned char* ws = P.ws;
    const float* SA = (const float*)(ws + WS_SEGA); const float* SH = (const float*)(ws + WS_SEGH);
    float Cc = 0.f;
    {   float sa[31], sh[31];
#pragma unroll
        for (int j = 0; j < 31; ++j) { const int Tj = b * 32 + j; sa[j] = (j < n) ? SA[Tj * 512 + c] : 1.f; sh[j] = (j < n) ? SH[Tj * 512 + c] : 0.f; }
#pragma unroll
        for (int j = 0; j < 31; ++j) Cc = sa[j] * Cc + sh[j]; }
    bf16_t* MIX = (bf16_t*)(ws + WS_MIX); const bf16_t* GA = (const bf16_t*)(ws + WS_GA);
    const size_t mb = (size_t)b * 2048 + 64 * n;
#pragma unroll 1
    for (int i0 = 0; i0 < 64; i0 += 32) {
        bf16_t mx[32], ga[32];
#pragma unroll
        for (int i = 0; i < 32; ++i) { const size_t m = mb + i0 + i; mx[i] = MIX[m * DM + c]; ga[i] = GA[m * 512 + c]; }
#pragma unroll
        for (int i = 0; i < 32; ++i) { const size_t m = mb + i0 + i; MIX[m * DM + c] = (bf16_t)f2bf(bf2f(mx[i]) + bf2f(ga[i]) * Cc); }
    }
    if (n == 31) { const int Tj = b * 32 + 31; P.out[OUT_PRH + (size_t)b * 512 + c] = SA[Tj * 512 + c] * Cc + SH[Tj * 512 + c]; }
}

__global__ void __launch_bounds__(NTHR, 2) hybrid_fwd(Params Pk) {
    extern __shared__ __attribute__((aligned(16))) unsigned char lds_raw[];
    LAS unsigned char* lds = (LAS unsigned char*)lds_raw;
    cg::grid_group grid = cg::this_grid();
    const int G = gridDim.x;
    volatile LAS unsigned* bst = (volatile LAS unsigned*)(lds + (LDS_BYTES - 64));
    if (threadIdx.x < 2) bst[threadIdx.x] = 0u;
    __syncthreads();
    XcdBarrier xb; { const Params P = load_params(); xb = xcd_barrier_post((unsigned*)(P.ws + WS_CTL), bst); }
    int n_stamp = 0;
#define STAMP() do { if (PROBE_T && blockIdx.x == 0 && threadIdx.x == 0) bst[4 + n_stamp] = (unsigned)__builtin_amdgcn_s_memrealtime(); ++n_stamp; } while (0)
    STAMP();

    { const Params P = load_params(); phase0(P, lds); }
    if (PROBE == 10) { __syncthreads(); const Params P = load_params(); phase0(P, lds); }
    if (Pk.ws == nullptr) grid.sync();
    xcd_barrier(xb); if (PROBE == 20) xcd_barrier(xb); STAMP();
    {   const Params P = load_params(); unsigned char* ws = P.ws;
        pg8::Gemm g{(const bf16_t*)(ws + WS_HN), (const bf16_t*)(ws + WS_WIN), NTOK_P, NPROJ, DM, DM}; pg8::StaticOrder S; S.init(NTOK_P, NPROJ, G, (int)blockIdx.x);
        EpiProj E{(bf16_t*)(ws + WS_PROJ), NPROJ};
        pg8::gemm_phase<EpiProj, pg8::StaticOrder, true, true>(lds, g, S, E);
        if (PROBE == 11) pg8::gemm_phase<EpiProj, pg8::StaticOrder, true, true>(lds, g, S, E); }
    xcd_barrier(xb); if (PROBE == 20) xcd_barrier(xb); STAMP();
    {
        const int bx = (int)blockIdx.x;
        if (bx < 48) {
            const Params P = load_params(); unsigned char* ws = P.ws;
            pg8::Gemm g{(const bf16_t*)(ws + WS_HN), (const bf16_t*)(ws + WS_WIN), NTOK, NPROJ, DM, DM}; SampleOrder3 S{bx};
            EpiProj E{(bf16_t*)(ws + WS_PROJ), NPROJ};
            pg8::gemm_phase<EpiProj, SampleOrder3, true, true>(lds, g, S, E);
            __syncthreads(); }
        const int nmine = (G == 256 && bx < 48) ? 3 : 4;
        for (int k = 0; k < nmine; ++k) { const int it = bx + k * G; if (it < 1024) { const Params P = load_params(); gdn_chunk_item(P, lds, G == 256 ? xmap(it) : it); } }
        if (G == 256 && bx >= 48 && bx < 96) { const Params P = load_params(); gdn_chunk_item(P, lds, xmap(768 + bx - 48)); }
        for (int it = bx; it < 256; it += G) { const Params P = load_params(); rg_tile_item(P, lds, G == 256 ? (it & 7) * 32 + (it >> 3) : it); __syncthreads(); }
        if (G != 256) { const Params P = load_params(); late_weights(P, lds, bx, G); }
        else if (bx >= 96) { const Params P = load_params(); late_weights(P, lds, bx - 96, 160); }
    }
    xcd_barrier(xb); if (PROBE == 20) xcd_barrier(xb); STAMP();
    if (blockIdx.x < 32) { for (int rep = 0; rep < (PROBE == 4 ? 2 : 1); ++rep) { const Params P = load_params(); gdn_seq_block(P, lds, (int)(blockIdx.x & 7) * 4 + (int)(blockIdx.x >> 3)); } }
    else {
        for (int it = blockIdx.x - 32; it < 512; it += G - 32) { const Params P = load_params(); gdn_sample_item(P, lds, it >> 2, it & 3); }
        {   const int nb = (int)blockIdx.x - 32 - 64;
            if (nb >= 0 && nb < 16) { const Params P = load_params(); rg_tile_item(P, lds, 256 + nb); __syncthreads(); } }
        for (int q = blockIdx.x - 32; q < 248; q += G - 32) { const Params P = load_params(); rg_fix_item(P, q / 31, 1 + q % 31); }
    }
    if (PROBE_T >= 10) { asm volatile("s_waitcnt vmcnt(0)" ::: "memory"); __syncthreads(); if (threadIdx.x == 0) { const Params P = load_params(); ((unsigned*)(P.ws + WS_CTL))[16000 + blockIdx.x] = (unsigned)__builtin_amdgcn_s_memrealtime(); } }
    xcd_barrier(xb); if (PROBE == 20) xcd_barrier(xb); STAMP();
    {
        const int bx = (int)blockIdx.x; const int nmine = (G == 256 && bx >= 192) ? 3 : 4;
        for (int k = 0; k < nmine; ++k) { const int it = bx + k * G; if (it < 1024) { const Params P = load_params(); gdn_out_item(P, lds, G == 256 ? xmap(it) : it); } }
        if (G == 256 && bx < 64) { const Params P = load_params(); gdn_out_item(P, lds, xmap(960 + bx)); }
        if (G != 256) for (int it = bx + 4 * G; it < 1024; it += G) { const Params P = load_params(); gdn_out_item(P, lds, it); } }
    {
        const Params P = load_params(); unsigned char* ws = P.ws;
        pg8::Gemm g{(const bf16_t*)(ws + WS_MIX), (const bf16_t*)(ws + WS_WOUT), NTOK, DM, 256, DM}; SplitOrder2 S{G, G - 1 - (int)blockIdx.x};
        EpiX2Split E{(float*)(ws + WS_SLAB2)};
        pg8::gemm_phase<EpiX2Split, SplitOrder2, true, true>(lds, g, S, E); }
    xcd_barrier(xb); if (PROBE == 20) xcd_barrier(xb); STAMP();
    {   const Params P = load_params(); unsigned char* ws = P.ws;
        pg8::Gemm g{(const bf16_t*)(ws + WS_MIX), (const bf16_t*)(ws + WS_WOUT), NTOK_P, DM, DM, DM}; pg8::StaticOrder S; S.init(NTOK_P, DM, G, (int)blockIdx.x);
        {
            const int tid = tid_(), lane = tid & 63, wave = tid >> 6;
            for (int m = blockIdx.x * NWAVES + wave; m < NTOK - NTOK_P; m += G * NWAVES) {
                const float* xr = P.in[I_XS] + (size_t)m * DM + 4 * lane; const float* sl = (const float*)(ws + WS_SLAB2) + (size_t)m * DM + 4 * lane;
                f32x4 v[4]; float ssum = 0.f;
#pragma unroll
                for (int j = 0; j < 4; ++j) { v[j] = *(const f32x4*)(xr + 256 * j);
#pragma unroll
                    for (int q = 0; q < 4; ++q) v[j] += *(const f32x4*)(sl + (size_t)q * (1024 * 1024) + 256 * j);
                    ssum += (v[j].x * v[j].x + v[j].y * v[j].y) + (v[j].z * v[j].z + v[j].w * v[j].w);
                    u32x2 w; w.x = pk2(v[j].x, v[j].y); w.y = pk2(v[j].z, v[j].w); *(u32x2*)((bf16_t*)(ws + WS_X1B) + (size_t)(NTOK_P + m) * DM + 4 * lane + 256 * j) = w; }
                ssum = wave_sum(ssum); if (lane == 0) ((float*)(ws + WS_SS1))[NTOK_P + m] = ssum; }
            __syncthreads(); }
        if (PROBE == 12) { EpiX1T<false> E0{P.in[I_XP], P.in[I_XS], (bf16_t*)(ws + WS_X1B), (float*)(ws + WS_SS1)}; pg8::gemm_phase<EpiX1T<false>, pg8::StaticOrder, true, true>(lds, g, S, E0); }
        EpiX1T<true> E{P.in[I_XP], P.in[I_XS], (bf16_t*)(ws + WS_X1B), (float*)(ws + WS_SS1)};
        pg8::gemm_phase<EpiX1T<true>, pg8::StaticOrder, true, true>(lds, g, S, E); }
    xcd_barrier(xb); if (PROBE == 20) xcd_barrier(xb); STAMP();
    {   const Params P = load_params(); unsigned char* ws = P.ws;
        pg8::Gemm g{(const bf16_t*)(ws + WS_X1B), (const bf16_t*)(ws + WS_WGU), NTOK, NGU, DM, DM}; pg8::StaticOrder S; S.init(NTOK, NGU, G, (int)blockIdx.x);
        EpiAct E{(bf16_t*)(ws + WS_ACT), (const float*)(ws + WS_SS1)};
        pg8::gemm_phase<EpiAct, pg8::StaticOrder, true, true>(lds, g, S, E);
        if (PROBE == 15) pg8::gemm_phase<EpiAct, pg8::StaticOrder, true, true>(lds, g, S, E); }
    xcd_barrier(xb); if (PROBE == 20) xcd_barrier(xb); STAMP();
    {   const Params P = load_params(); unsigned char* ws = P.ws;
        {   pg8::Gemm g{(const bf16_t*)(ws + WS_ACT), (const bf16_t*)(ws + WS_WDN), NTOK_P, DM, DFF, DFF}; pg8::StaticOrder S; S.init(NTOK_P, DM, G, (int)blockIdx.x);
            EpiX2 E{P.out + OUT_Y, (const bf16_t*)(ws + WS_X1B)};
            pg8::gemm_phase<EpiX2, pg8::StaticOrder, true, true>(lds, g, S, E); }
        {   pg8::Gemm g{(const bf16_t*)(ws + WS_ACT), (const bf16_t*)(ws + WS_WDN), NTOK, DM, 256, DFF}; SplitOrder S{G, (int)blockIdx.x};
            EpiX2Split E{(float*)(ws + WS_SLAB)};
            pg8::gemm_phase<EpiX2Split, SplitOrder, true, true>(lds, g, S, E); } }
    xcd_barrier(xb); if (PROBE == 20) xcd_barrier(xb); STAMP();
    {
        const Params P = load_params();
        const int tid = tid_(), lane = tid & 63, wave = tid >> 6; const float* fw = P.in[I_FN];
        f32x4 nw[4];
#pragma unroll
        for (int j = 0; j < 4; ++j) nw[j] = *(const f32x4*)(fw + 4 * lane + 256 * j);
        for (int rep = (PROBE == 17 ? 0 : 1); rep < 2; ++rep)
        for (int m = blockIdx.x * NWAVES + wave; m < NTOK; m += G * NWAVES) {
            float* row = P.out + OUT_Y + (size_t)m * DM; f32x4 v[4]; float s = 0.f;
            float* orow = (rep == 0) ? (float*)(P.ws + WS_HN) + (size_t)m * DM : row;
#pragma unroll
            for (int j = 0; j < 4; ++j) v[j] = *(const f32x4*)(row + 4 * lane + 256 * j);
            if (m >= NTOK_P) { const bf16_t* xb = (const bf16_t*)(P.ws + WS_X1B) + (size_t)m * DM + 4 * lane;
#pragma unroll
                for (int j = 0; j < 4; ++j) { const u32x2 x = *(const u32x2*)(xb + 256 * j); v[j] = (f32x4){__uint_as_float(x.x << 16), __uint_as_float(x.x & 0xffff0000u), __uint_as_float(x.y << 16), __uint_as_float(x.y & 0xffff0000u)}; }
                const float* sl = (const float*)(P.ws + WS_SLAB) + (size_t)(m - NTOK_P) * DM + 4 * lane;
#pragma unroll
                for (int q = 0; q < 11; ++q)
#pragma unroll
                    for (int j = 0; j < 4; ++j) v[j] += *(const f32x4*)(sl + (size_t)q * (1024 * 1024) + 256 * j); }
#pragma unroll
            for (int j = 0; j < 4; ++j) s += (v[j].x * v[j].x + v[j].y * v[j].y) + (v[j].z * v[j].z + v[j].w * v[j].w);
            const float rstd = rsqrtf(wave_sum(s) * (1.f / DM) + 1e-6f);
#pragma unroll
            for (int j = 0; j < 4; ++j) *(f32x4*)(orow + 4 * lane + 256 * j) = v[j] * rstd * nw[j];
        }
    }
    if (PROBE_T) {
        asm volatile("s_waitcnt vmcnt(0)" ::: "memory"); __syncthreads(); STAMP(); __syncthreads();
        if (blockIdx.x == 0) { const Params P = load_params(); const unsigned* ctlw = (const unsigned*)(P.ws + WS_CTL);
            const unsigned dtk = (PROBE_T < 10) ? bst[4 + PROBE_T] - bst[4 + PROBE_T - 1] : __hip_atomic_load(ctlw + 16000 + (PROBE_T == 10 ? 0 : PROBE_T == 11 ? 40 : 255), __ATOMIC_RELAXED, __HIP_MEMORY_SCOPE_AGENT) - bst[4 + 3];
            const float sc = 1.f + PROBE_SC * (float)dtk;
            for (int i = threadIdx.x; i < 4096; i += NTHR) P.out[OUT_PRH + i] *= sc; }
    }
#undef STAMP
}

extern "C" void kernel_launch(void* const* d_in, const int* in_sizes, int n_in, void* d_out, int out_size, void* d_ws, size_t ws_size, hipStream_t stream) {
    static int grid = 0;
    if (grid == 0) {
        int dev = 0, cus = 0, per_cu = 0;
        if (n_in != 25 || ws_size < WS_END) { fprintf(stderr, "kernel_launch: unexpected n_in %d / ws_size %zu\n", n_in, ws_size); grid = -1; return; }
        hipGetDevice(&dev); hipDeviceGetAttribute(&cus, hipDeviceAttributeMultiprocessorCount, dev);
        hipFuncSetAttribute((const void*)hybrid_fwd, hipFuncAttributeMaxDynamicSharedMemorySize, LDS_BYTES);
        hipOccupancyMaxActiveBlocksPerMultiprocessor(&per_cu, (const void*)hybrid_fwd, NTHR, LDS_BYTES);
        (void)hipGetLastError();
        if (per_cu < 1) { fprintf(stderr, "kernel_launch: occupancy query says %d blocks per CU\n", per_cu); per_cu = 1; }
        grid = cus;
        if (grid > 256) grid = 256;
    }
    if (grid < 0) return;
    hipMemsetAsync((char*)d_ws + WS_CTL, 0, CTL_BYTES, stream);
    Params p{};
    for (int i = 0; i < 25; ++i) p.in[i] = (const float*)d_in[i];
    p.out = (float*)d_out; p.ws = (unsigned char*)d_ws;
    void* args[] = {&p};
    hipError_t e = hipLaunchCooperativeKernel((const void*)hybrid_fwd, dim3(grid), dim3(NTHR), args, LDS_BYTES, stream);
    if (e != hipSuccess) fprintf(stderr, "cooperative launch failed: %s (grid %d)\n", hipGetErrorString(e), grid);
}
```

```cpp
#include <hip/hip_runtime.h>
#include <hip/hip_cooperative_groups.h>
#include <cstdio>
#include <cstdint>
namespace cg = cooperative_groups;
namespace pg8 {
#define PG8_LAS __attribute__((address_space(3)))
typedef unsigned short bf16_t;
typedef short bf16x8 __attribute__((ext_vector_type(8)));
typedef float f32x4 __attribute__((ext_vector_type(4)));
typedef unsigned u32x4 __attribute__((ext_vector_type(4)));
constexpr int BM = 256, BK = 64, HALF = 128, HTB = HALF * BK * 2  , STAGE_BYTES = 8 * HTB, NXCD = 8, WGM = 8;

__host__ __device__ __forceinline__ int lds_byte(int r, int c) { const int st = (r >> 4) * 2 + (c >> 5), rr = r & 15, cc = c & 31, ob = rr * 64 + cc * 2; return st * 1024 + (ob ^ (((ob >> 9) & 1) << 5)); }
__host__ __device__ __forceinline__ void stage_rc(int b, int& R, int& C) { const int st = b / 1024, sb = b % 1024, swz = sb ^ (((sb >> 9) & 1) << 5); R = (st >> 1) * 16 + swz / 64; C = (st & 1) * 32 + (swz % 64) / 2; }
__host__ __device__ __forceinline__ int perm32(int rho) { const int n = rho >> 4, i = rho & 15; return 8 * (i >> 2) + 4 * n + (i & 3); }

struct Unit { int pm, pn, kb, ks; };
struct Gemm { const bf16_t* A; const bf16_t* Bt; int M, N, K, ld; };

struct StaticOrder {
    int nM, nN, nwg, G, c;
    __host__ __device__ void init(int M, int N, int G_, int c_) { nM = M / BM; nN = N / BM; nwg = nM * nN; G = G_; c = c_; }
    __host__ __device__ bool next(int i, Unit& u) const {
        const long L = (long)i * G + c; if (L >= nwg) return false;
        int wgid = (int)L; { const int q = nwg / NXCD, r = nwg % NXCD, xcd = wgid % NXCD, off = wgid / NXCD; wgid = (xcd < r ? xcd * (q + 1) : r * (q + 1) + (xcd - r) * q) + off; }
        const int nig = WGM * nN, gid = wgid / nig, fm = gid * WGM, gsz = (nM - fm) < WGM ? (nM - fm) : WGM;
        u.pm = fm + ((wgid % nig) % gsz); u.pn = (wgid % nig) / gsz; u.kb = 0; u.ks = 0; return true;
    }
    __device__ __forceinline__ void a_ready(const Unit&) const {}
    __device__ __forceinline__ void done(const Unit&) const {}
};
__device__ __forceinline__ unsigned cvt_pk_bf16(float lo, float hi) { unsigned r; asm volatile("v_cvt_pk_bf16_f32 %0, %1, %2" : "=v"(r) : "v"(lo), "v"(hi)); return r; }
template <class Epi, class Sched, bool ALIGN_EPI = false, bool SP2 = false>
__device__ __forceinline__ void gemm_phase(PG8_LAS unsigned char* lds, const Gemm g, const Sched& S, const Epi& E) {
    int tid = threadIdx.x; asm volatile("" : "+v"(tid)); const int wid = __builtin_amdgcn_readfirstlane(tid >> 6), lane = tid & 63, wr = wid >> 2, wc = wid & 3, fr = lane & 15, fq = lane >> 4;
    const int K = g.ld, nt = g.K / BK;
    unsigned voffA[2], voffB[2];
#pragma unroll
    for (int i = 0; i < 2; ++i) { int R, C; stage_rc(tid * 16 + i * 8192, R, C); const int Rb = Epi::PERM ? ((R & ~31) + perm32(R & 31)) : R;
        voffA[i] = (unsigned)(R * K + C) * 2u; voffB[i] = (unsigned)(Rb * K + C) * 2u; }
    const size_t kstep = (size_t)(BK * 2);
    const size_t hstep = (size_t)HALF * K * 2;
    const size_t tstep = 2 * hstep;
    const unsigned ldsw = (unsigned)wid * 1024u;
    const int aoff = lds_byte(wr * 64 + fr, fq * 8), boff = lds_byte(wc * 32 + fr, fq * 8);
#define PG8_SA(b, h) (((b) * 2 + (h)) * HTB)
#define PG8_SB(b, h) ((4 + (b) * 2 + (h)) * HTB)
#define PG8_STAGE(bufoff, gbase, voff) do { _Pragma("unroll") for (int _i = 0; _i < 2; ++_i) \
        __builtin_amdgcn_global_load_lds((const unsigned*)((const char*)(gbase) + (voff)[_i]), (PG8_LAS unsigned*)(lds + (bufoff) + ldsw + _i * 8192), 16, 0, 0); } while (0)
#define PG8_LDA(dst, b, h) do { _Pragma("unroll") for (int m = 0; m < 4; ++m) _Pragma("unroll") for (int k = 0; k < 2; ++k) dst[m][k] = *(const PG8_LAS bf16x8*)(lds + PG8_SA(b, h) + aoff + m * 2048 + k * 1024); } while (0)
#define PG8_LDB(dst, b, h) do { _Pragma("unroll") for (int n = 0; n < 2; ++n) _Pragma("unroll") for (int k = 0; k < 2; ++k) dst[n][k] = *(const PG8_LAS bf16x8*)(lds + PG8_SB(b, h) + boff + n * 2048 + k * 1024); } while (0)
#define PG8_MMA(ai, bj, At, Bt) do { __builtin_amdgcn_s_setprio(1); _Pragma("unroll") for (int m = 0; m < 4; ++m) _Pragma("unroll") for (int n = 0; n < 2; ++n) _Pragma("unroll") for (int k = 0; k < 2; ++k) \
        acc[ai][bj][m][n] = __builtin_amdgcn_mfma_f32_16x16x32_bf16(Bt[n][k], At[m][k], acc[ai][bj][m][n], 0, 0, 0); __builtin_amdgcn_s_setprio(0); } while (0)
#define PG8_WAIT_V(n) asm volatile("s_waitcnt vmcnt(" #n ")" ::: "memory")
#define PG8_WAIT_L(n) asm volatile("s_waitcnt lgkmcnt(" #n ")" ::: "memory")
#define PG8_BAR __builtin_amdgcn_s_barrier()
#define PG8_SCHED __builtin_amdgcn_sched_barrier(0)
    Unit cur, nxt; int ui = 0;
    if (!S.next(0, cur)) return;
    f32x4 acc[2][2][4][2];
#pragma unroll
    for (int a = 0; a < 2; ++a)
#pragma unroll
        for (int b = 0; b < 2; ++b)
#pragma unroll
            for (int m = 0; m < 4; ++m)
#pragma unroll
                for (int n = 0; n < 2; ++n) acc[a][b][m][n] = (f32x4){0.f, 0.f, 0.f, 0.f};
    bf16x8 At[4][2], B0[2][2], B1[2][2];
    const char* cA = (const char*)g.A + (size_t)cur.pm * tstep + cur.kb; const char* cB = (const char*)g.Bt + (size_t)cur.pn * tstep + cur.kb;
    S.a_ready(cur);
    if constexpr (SP2) {
        PG8_STAGE(PG8_SB(0, 0), cB, voffB); PG8_STAGE(PG8_SB(0, 1), cB + hstep, voffB); PG8_STAGE(PG8_SA(0, 0), cA, voffA); PG8_STAGE(PG8_SA(0, 1), cA + hstep, voffA);
        if (wr == 1) PG8_BAR;
        PG8_WAIT_V(2); PG8_BAR;
        PG8_STAGE(PG8_SB(1, 0), cB + kstep, voffB); PG8_STAGE(PG8_SA(1, 0), cA + kstep, voffA); PG8_STAGE(PG8_SB(1, 1), cB + hstep + kstep, voffB);
        PG8_WAIT_V(6); PG8_BAR;
    } else {
        PG8_STAGE(PG8_SB(0, 0), cB, voffB); PG8_STAGE(PG8_SA(0, 0), cA, voffA); PG8_STAGE(PG8_SB(0, 1), cB + hstep, voffB); PG8_STAGE(PG8_SA(0, 1), cA + hstep, voffA);
        if (wr == 1) PG8_BAR;
        PG8_WAIT_V(4); PG8_BAR;
        PG8_STAGE(PG8_SB(1, 0), cB + kstep, voffB); PG8_STAGE(PG8_SA(1, 0), cA + kstep, voffA); PG8_STAGE(PG8_SB(1, 1), cB + hstep + kstep, voffB);
        PG8_WAIT_V(6); PG8_BAR;
    }
    for (;;) {
        const bool has_next = S.next(ui + 1, nxt);
        const char* nA = has_next ? (const char*)g.A + (size_t)nxt.pm * tstep + nxt.kb : cA; const char* nB = has_next ? (const char*)g.Bt + (size_t)nxt.pn * tstep + nxt.kb : cB;
        for (int t = 0; t < nt; t += 2) {
            const bool last = (t == nt - 2);
            const char* a1 = cA + (size_t)(t + 1) * kstep;
            const char* a2 = last ? nA : cA + (size_t)(t + 2) * kstep; const char* b2 = last ? nB : cB + (size_t)(t + 2) * kstep;
            const char* a3 = a2 + kstep; const char* b3 = b2 + kstep;
            if (last && has_next) S.a_ready(nxt);
            if constexpr (SP2) {
            PG8_LDB(B0, 0, 0); PG8_LDB(B1, 0, 1); PG8_SCHED; PG8_LDA(At, 0, 0); PG8_STAGE(PG8_SA(1, 1), a1 + hstep, voffA);
            PG8_WAIT_V(8); PG8_WAIT_L(0); PG8_BAR; PG8_MMA(0, 0, At, B0); PG8_MMA(0, 1, At, B1); PG8_BAR; PG8_SCHED;
            PG8_LDA(At, 0, 1); PG8_STAGE(PG8_SB(0, 0), b2, voffB); PG8_STAGE(PG8_SB(0, 1), b2 + hstep, voffB); PG8_STAGE(PG8_SA(0, 0), a2, voffA);
            PG8_WAIT_V(8); PG8_WAIT_L(0); PG8_BAR; PG8_MMA(1, 0, At, B0); PG8_MMA(1, 1, At, B1); PG8_BAR; PG8_SCHED;
            PG8_LDB(B0, 1, 0); PG8_LDB(B1, 1, 1); PG8_SCHED; PG8_LDA(At, 1, 0); PG8_STAGE(PG8_SA(0, 1), a2 + hstep, voffA);
            PG8_WAIT_V(8); PG8_WAIT_L(0); PG8_BAR; PG8_MMA(0, 0, At, B0); PG8_MMA(0, 1, At, B1); PG8_BAR; PG8_SCHED;
            PG8_LDA(At, 1, 1); PG8_STAGE(PG8_SB(1, 0), b3, voffB); PG8_STAGE(PG8_SB(1, 1), b3 + hstep, voffB); PG8_STAGE(PG8_SA(1, 0), a3, voffA);
            PG8_WAIT_V(8); PG8_WAIT_L(0); PG8_BAR; PG8_MMA(1, 0, At, B0); PG8_MMA(1, 1, At, B1); PG8_BAR; PG8_SCHED;
            } else {
            PG8_LDB(B0, 0, 0); PG8_SCHED; PG8_LDA(At, 0, 0); PG8_STAGE(PG8_SA(1, 1), a1 + hstep, voffA);
            PG8_WAIT_L(8); PG8_BAR; PG8_WAIT_L(0); PG8_MMA(0, 0, At, B0); PG8_BAR; PG8_SCHED;
            PG8_LDB(B1, 0, 1); PG8_STAGE(PG8_SB(0, 0), b2, voffB);
            PG8_BAR; PG8_WAIT_L(0); PG8_MMA(0, 1, At, B1); PG8_BAR;
            PG8_LDA(At, 0, 1); PG8_STAGE(PG8_SA(0, 0), a2, voffA);
            PG8_BAR; PG8_WAIT_L(0); PG8_MMA(1, 0, At, B0); PG8_BAR; PG8_SCHED;
            PG8_STAGE(PG8_SB(0, 1), b2 + hstep, voffB);
            PG8_WAIT_V(6); PG8_BAR; PG8_MMA(1, 1, At, B1); PG8_BAR;
            PG8_LDB(B0, 1, 0); PG8_SCHED; PG8_LDA(At, 1, 0); PG8_STAGE(PG8_SA(0, 1), a2 + hstep, voffA);
            PG8_WAIT_L(8); PG8_BAR; PG8_WAIT_L(0); PG8_MMA(0, 0, At, B0); PG8_BAR; PG8_SCHED;
            PG8_LDB(B1, 1, 1); PG8_STAGE(PG8_SB(1, 0), b3, voffB);
            PG8_BAR; PG8_WAIT_L(0); PG8_MMA(0, 1, At, B1); PG8_BAR;
            PG8_LDA(At, 1, 1); PG8_STAGE(PG8_SA(1, 0), a3, voffA);
            PG8_BAR; PG8_WAIT_L(0); PG8_MMA(1, 0, At, B0); PG8_BAR; PG8_SCHED;
            PG8_STAGE(PG8_SB(1, 1), b3 + hstep, voffB);
            PG8_WAIT_V(6); PG8_BAR; PG8_MMA(1, 1, At, B1); PG8_BAR;
            }
        }
        if constexpr (ALIGN_EPI) { if (wr == 0) PG8_BAR; }
        if constexpr (!Epi::AFTER_DRAIN) { E(acc, cur, wr, wc, fr, fq); S.done(cur); }
        if (!has_next) break;
#pragma unroll
        for (int a = 0; a < 2; ++a)
#pragma unroll
            for (int b = 0; b < 2; ++b)
#pragma unroll
                for (int m = 0; m < 4; ++m)
#pragma unroll
                    for (int n = 0; n < 2; ++n) acc[a][b][m][n] = (f32x4){0.f, 0.f, 0.f, 0.f};
        cur = nxt; cA = nA; cB = nB; ++ui;
        if constexpr (ALIGN_EPI) { if (wr == 1) PG8_BAR; }
    }
    PG8_WAIT_V(0);
    if constexpr (!ALIGN_EPI) { if (wr == 0) PG8_BAR; }
    PG8_BAR;
    if constexpr (Epi::AFTER_DRAIN) { E.fused(acc, cur, wr, wc, fr, fq, lds, wid, lane); S.done(cur); }
#undef PG8_SA
#undef PG8_SB
#undef PG8_STAGE
#undef PG8_LDA
#undef PG8_LDB
#undef PG8_MMA
#undef PG8_WAIT_V
#undef PG8_WAIT_L
#undef PG8_BAR
#undef PG8_SCHED
}
}

#define LAS __attribute__((address_space(3)))
typedef unsigned short bf16_t;
typedef short bf16x8 __attribute__((ext_vector_type(8)));
typedef float f32x4 __attribute__((ext_vector_type(4)));
typedef float f32x16 __attribute__((ext_vector_type(16)));
typedef unsigned u32x4 __attribute__((ext_vector_type(4)));
typedef unsigned u32x2 __attribute__((ext_vector_type(2)));

#define XB_TMO      128
#define XB_XCNT(j)  (256  + 64 * (j))
#define XB_XSUB(j)  (1280 + 64 * (j))
#define XB_XGEN(j)  (2304 + 64 * (j))
#define XB_TOP      3328
#define XB_TOPGEN   3392
#define XCD_BAR_WORDS 3456
#define XB_SPIN_CAP (1u << 18)

__device__ __forceinline__ unsigned xb_ld(unsigned* p)              { return __hip_atomic_load(p, __ATOMIC_RELAXED, __HIP_MEMORY_SCOPE_AGENT); }
__device__ __forceinline__ unsigned xb_add(unsigned* p, unsigned v) { return __hip_atomic_fetch_add(p, v, __ATOMIC_RELAXED, __HIP_MEMORY_SCOPE_AGENT); }
__device__ __forceinline__ unsigned xb_xcc_id() { return (unsigned)__builtin_amdgcn_s_getreg((3 << 11) | 20) & 0xFu; }
#define XB_SPIN(cond, bar) do { unsigned _sp = 0; while (cond) { __builtin_amdgcn_s_sleep(1); \
    if ((++_sp & 255u) == 0u) { if (xb_ld(&(bar)[XB_TMO])) break; if (_sp > XB_SPIN_CAP) { atomicAdd(&(bar)[XB_TMO], 1u); break; } } } } while (0)

struct XcdBarrier {
    unsigned* bar; unsigned x;
    volatile LAS unsigned* st;
};

__device__ __forceinline__ XcdBarrier xcd_barrier_post(unsigned* bar, volatile LAS unsigned* st) {
    XcdBarrier b; b.bar = bar; b.x = xb_xcc_id(); b.st = st;
    if (threadIdx.x == 0) (void)xb_add(&bar[XB_XCNT(b.x)], 1u);
    return b;
}
__device__ __forceinline__ void xcd_barrier_complete(unsigned* bar, unsigned x, unsigned& nloc, unsigned& nx) {
    const unsigned G = gridDim.x * gridDim.y * gridDim.z;
    unsigned sum, cnt, mine, sp = 0u;
    for (;;) {
        sum = 0u; cnt = 0u; mine = 0u;
#pragma unroll
        for (unsigned j = 0; j < 16; ++j) { const unsigned c = xb_ld(&bar[XB_XCNT(j)]); sum += c; cnt += (c > 0u) ? 1u : 0u; mine = (j == x) ? c : mine; }
        if (sum == G) break;
        __builtin_amdgcn_s_sleep(1);
        if ((++sp & 255u) == 0u) { if (xb_ld(&bar[XB_TMO])) break; if (sp > XB_SPIN_CAP) { atomicAdd(&bar[XB_TMO], 1u); break; } }
    }
    nloc = mine > 0u ? mine : 1u; nx = cnt > 0u ? cnt : 1u;
}

__device__ __forceinline__ void xcd_barrier(const XcdBarrier& b) {
    asm volatile("s_waitcnt vmcnt(0)" ::: "memory");
    __syncthreads();
    if (threadIdx.x == 0) {
        unsigned* bar = b.bar;
        __builtin_amdgcn_s_waitcnt(0);
        unsigned nloc = b.st[0], nx = b.st[1];
        if (nloc == 0u) { xcd_barrier_complete(bar, b.x, nloc, nx); b.st[0] = nloc; b.st[1] = nx; }
        const unsigned old = xb_add(&bar[XB_XSUB(b.x)], 1u);
        const unsigned gen = old / nloc;
        if (old + 1u == (gen + 1u) * nloc) {
            __builtin_amdgcn_fence(__ATOMIC_RELEASE, "agent");
            asm volatile("s_waitcnt vmcnt(0)" ::: "memory");
            const unsigned og = xb_add(&bar[XB_TOP], 1u);
            const unsigned tg = og / nx;
            if (og + 1u == (tg + 1u) * nx) xb_add(&bar[XB_TOPGEN], 1u);
            else XB_SPIN(xb_ld(&bar[XB_TOPGEN]) == tg, bar);
            __builtin_amdgcn_fence(__ATOMIC_ACQUIRE, "agent");
            xb_add(&bar[XB_XGEN(b.x)], 1u);
            asm volatile("s_waitcnt vmcnt(0)" ::: "memory");
        } else {
            XB_SPIN(xb_ld(&bar[XB_XGEN(b.x)]) == gen, bar);
            __builtin_amdgcn_fence(__ATOMIC_ACQUIRE, "agent");
            asm volatile("s_waitcnt vmcnt(0)" ::: "memory");
        }
    }
    __syncthreads();
}


constexpr int DM = 1024, NTOK_P = 16384, NTOK = 17408, DIN = 3080, NPROJ = 3072, DFF = 2816, NGU = 5632;
constexpr int NWAVES = 8, NTHR = 512;
constexpr int PROBE = 0;
constexpr int PROBE_T = 0; constexpr float PROBE_SC = 1e-6f;
constexpr int LDS_BYTES = 148480;
constexpr size_t MiB = 1u << 20;
constexpr size_t WS_CTL = 0, CTL_BYTES = 160 * 1024, WS_SS1 = 65536;
constexpr size_t WS_WIN = 1 * MiB, WS_WOUT = 7 * MiB, WS_WGU = 9 * MiB, WS_WDN = 20 * MiB;
constexpr size_t WS_RGW = 25 * MiB + 512 * 1024;
constexpr size_t WS_BETA = 26 * MiB, WS_G = 26 * MiB + 512 * 1024, WS_GL = 26 * MiB + 896 * 1024;
constexpr size_t WS_SEGA = 27 * MiB, WS_SEGH = 27 * MiB + 512 * 1024;
constexpr size_t WS_HN = 28 * MiB, WS_WF = 28 * MiB, WS_QDF = 44 * MiB, WS_X1B = 28 * MiB;
constexpr size_t WS_PROJ = 62 * MiB, WS_ACT = 62 * MiB;
constexpr size_t WS_SLAB2 = 198 * MiB;
constexpr size_t WS_SLAB = 198 * MiB;
constexpr size_t WS_MIX = 164 * MiB, WS_GA = 198 * MiB, WS_KTF = 214 * MiB, WS_QKF = 230 * MiB, WS_UB = 238 * MiB, WS_END = 254 * MiB;
constexpr size_t OUT_Y = 0, OUT_PRC = 17825792, OUT_PRH = 17838080, OUT_PGC = 17842176, OUT_PGS = 17879040,
                 OUT_SRC = 18403328, OUT_SRH = 18599936, OUT_SGC = 18665472, OUT_SGS = 19255296;

struct Params { const float* in[25]; float* out; unsigned char* ws; };
enum { I_XP = 0, I_XS, I_SRC, I_SRH, I_SGC, I_SGS, I_NORM1, I_WIN, I_RCW, I_RCB, I_RWA, I_RBA, I_RWI, I_RBI, I_LAM, I_GCW, I_ALOG, I_DTB, I_GNW, I_WOUT, I_NORM2, I_WG, I_WU, I_WD, I_FN };

#define DI __device__ __forceinline__
#define KAS __attribute__((address_space(4)))
DI Params load_params() {
#if defined(__HIP_DEVICE_COMPILE__)
    const KAS unsigned char* ka = (const KAS unsigned char*)__builtin_amdgcn_kernarg_segment_ptr(); asm volatile("" : "+s"(ka)); return *(const KAS Params*)ka;
#else
    return Params{};
#endif
}
template <class T> DI T vlaunder(T p) { asm volatile("" : "+v"(p)); return p; }
DI int tid_() { int t = threadIdx.x; asm volatile("" : "+v"(t)); return t; }
typedef __bf16 hbf2 __attribute__((ext_vector_type(2)));
typedef float f32x2 __attribute__((ext_vector_type(2)));
DI unsigned pk2(float lo, float hi) { const f32x2 v = {lo, hi}; return __builtin_bit_cast(unsigned, __builtin_convertvector(v, hbf2)); }
DI unsigned f2bf(float f) { return pk2(f, 0.f) & 0xffffu; }
DI float bf2f(bf16_t b) { return __uint_as_float(((unsigned)b) << 16); }
DI float dpp_add(float v, const int ctrl_sel) {
    const int x = __float_as_int(v); int y;
    if (ctrl_sel == 0) y = __builtin_amdgcn_update_dpp(x, x, 0xB1, 0xf, 0xf, false);
    else if (ctrl_sel == 1) y = __builtin_amdgcn_update_dpp(x, x, 0x4E, 0xf, 0xf, false);
    else if (ctrl_sel == 2) y = __builtin_amdgcn_update_dpp(x, x, 0x141, 0xf, 0xf, false);
    else y = __builtin_amdgcn_update_dpp(x, x, 0x140, 0xf, 0xf, false);
    return v + __int_as_float(y);
}
DI float wave_sum(float v) {
    v = dpp_add(v, 0); v = dpp_add(v, 1); v = dpp_add(v, 2); v = dpp_add(v, 3);
    v += __shfl_xor(v, 16); v += __shfl_xor(v, 32);
    return v;
}
DI float sigm(float x) { return __builtin_amdgcn_rcpf(1.f + __expf(-x)); }
DI float silu(float x) { return x * __builtin_amdgcn_rcpf(1.f + __expf(-x)); }
DI float one_minus_exp(float y, float e) { const float p = -y * (1.f + y * (0.5f + y * (0.16666667f + y * (0.041666668f + y * 0.0083333338f)))); return y > -0.3f ? p : 1.f - e; }
DI float softplus(float x) { return x > 20.f ? x : log1pf(__expf(x)); }
DI float gelu_tanh(float x) { const float u = 0.7978845608028654f * (x + 0.044715f * x * x * x); return x * __builtin_amdgcn_rcpf(1.f + __expf(-2.f * u)); }
DI int crow(int reg, int hh) { return (reg & 3) + 8 * (reg >> 2) + 4 * hh; }
DI bf16x8 pack8(f32x4 a, f32x4 b) { u32x4 p; p.x = pk2(a.x, a.y); p.y = pk2(a.z, a.w); p.z = pk2(b.x, b.y); p.w = pk2(b.z, b.w); return __builtin_bit_cast(bf16x8, p); }
DI bf16x8 pack8v(const float* v) { u32x4 p; p.x = pk2(v[0], v[1]); p.y = pk2(v[2], v[3]); p.z = pk2(v[4], v[5]); p.w = pk2(v[6], v[7]); return __builtin_bit_cast(bf16x8, p); }
#define MFMA32(a, b, c) __builtin_amdgcn_mfma_f32_32x32x16_bf16((a), (b), (c), 0, 0, 0)
DI bf16x8 pack_step(const f32x16& x, int s) {
    u32x4 p;
    p.x = pk2(x[8 * s + 0], x[8 * s + 1]); p.y = pk2(x[8 * s + 2], x[8 * s + 3]); p.z = pk2(x[8 * s + 4], x[8 * s + 5]); p.w = pk2(x[8 * s + 6], x[8 * s + 7]);
    return __builtin_bit_cast(bf16x8, p);
}
DI f32x16 zero16() { f32x16 z;
#pragma unroll
    for (int i = 0; i < 16; ++i) z[i] = 0.f;
    return z; }

struct EpiProj {
    static constexpr bool PERM = true, AFTER_DRAIN = false;
    bf16_t* O; int ldc;
    DI void operator()(const f32x4 (&acc)[2][2][4][2], const pg8::Unit& u, int wr, int wc, int fr, int fq) const {
        const int row0 = u.pm * 256 + wr * 64 + fr, col0 = u.pn * 256 + wc * 32 + 8 * fq;
#pragma unroll
        for (int ai = 0; ai < 2; ++ai)
#pragma unroll
            for (int m = 0; m < 4; ++m) { bf16_t* rowp = O + (size_t)(row0 + ai * 128 + m * 16) * ldc + col0;
#pragma unroll
                for (int bj = 0; bj < 2; ++bj) { const f32x4 v0 = acc[ai][bj][m][0], v1 = acc[ai][bj][m][1];
                    u32x4 w; w.x = pg8::cvt_pk_bf16(v0[0], v0[1]); w.y = pg8::cvt_pk_bf16(v0[2], v0[3]); w.z = pg8::cvt_pk_bf16(v1[0], v1[1]); w.w = pg8::cvt_pk_bf16(v1[2], v1[3]);
                    *(u32x4*)(rowp + bj * 128) = w; } }
    }
};
template <bool ATOM> struct EpiX1T {
    static constexpr bool PERM = false, AFTER_DRAIN = false;
    const float* xp; const float* xs; bf16_t* X1B; float* SS1;
    DI void operator()(const f32x4 (&acc)[2][2][4][2], const pg8::Unit& u, int wr, int wc, int fr, int fq) const {
        const int row0 = u.pm * 256 + wr * 64 + fr, col0 = u.pn * 256 + wc * 32 + 4 * fq;
        const float* xbase = (u.pm < 64 ? xp + (size_t)row0 * DM : xs + (size_t)(row0 - NTOK_P) * DM) + col0;
        f32x4 xv[3][4];
#pragma unroll
        for (int g0 = 0; g0 < 2; ++g0) { const float* xn = xbase + (size_t)((g0 >> 2) * 128 + (g0 & 3) * 16) * DM;
#pragma unroll
            for (int k = 0; k < 4; ++k) xv[g0][k] = *(const f32x4*)(xn + (k >> 1) * 128 + (k & 1) * 16); }
#pragma unroll
        for (int gi = 0; gi < 8; ++gi) { const int ai = gi >> 2, m = gi & 3, row = row0 + ai * 128 + m * 16;
            if (gi + 2 < 8) { const int g2 = gi + 2; const float* xn = xbase + (size_t)((g2 >> 2) * 128 + (g2 & 3) * 16) * DM;
#pragma unroll
                for (int k = 0; k < 4; ++k) xv[g2 % 3][k] = *(const f32x4*)(xn + (k >> 1) * 128 + (k & 1) * 16); }
            bf16_t* bp = X1B + (size_t)row * DM + col0; float ss = 0.f;
#pragma unroll
            for (int k = 0; k < 4; ++k) { const int bj = k >> 1, n = k & 1; const f32x4 v = acc[ai][bj][m][n] + xv[gi % 3][k];
                u32x2 w; w.x = pk2(v[0], v[1]); w.y = pk2(v[2], v[3]);
                *(u32x2*)(bp + bj * 128 + n * 16) = w; ss += (v[0] * v[0] + v[1] * v[1]) + (v[2] * v[2] + v[3] * v[3]); }
            ss += __shfl_xor(ss, 16); ss += __shfl_xor(ss, 32);
            if (ATOM && fq == 0) atomicAdd(SS1 + row, ss); }
    }
};
struct EpiAct {
    static constexpr bool PERM = true, AFTER_DRAIN = false;
    bf16_t* ACT; const float* SS1;
    DI void operator()(const f32x4 (&acc)[2][2][4][2], const pg8::Unit& u, int wr, int wc, int fr, int fq) const {
        const int row0 = u.pm * 256 + wr * 64 + fr, col0 = u.pn * 256 + wc * 32 + 8 * fq;
        float ssv[8];
#pragma unroll
        for (int gi = 0; gi < 8; ++gi) ssv[gi] = SS1[row0 + (gi >> 2) * 128 + (gi & 3) * 16];
#pragma unroll
        for (int ai = 0; ai < 2; ++ai)
#pragma unroll
            for (int m = 0; m < 4; ++m) { const int row = row0 + ai * 128 + m * 16; const float rstd = rsqrtf(ssv[ai * 4 + m] * (1.f / DM) + 1e-6f);
                bf16_t* rowp = ACT + (size_t)row * DFF + (col0 >> 1);
#pragma unroll
                for (int bj = 0; bj < 2; ++bj) { const f32x4 v0 = acc[ai][bj][m][0] * rstd, v1 = acc[ai][bj][m][1] * rstd;
                    u32x2 w; w.x = pg8::cvt_pk_bf16(silu(v0[0]) * v0[1], silu(v0[2]) * v0[3]); w.y = pg8::cvt_pk_bf16(silu(v1[0]) * v1[1], silu(v1[2]) * v1[3]);
                    *(u32x2*)(rowp + bj * 64) = w; } }
    }
};
struct EpiX2 {
    static constexpr bool PERM = false, AFTER_DRAIN = false;
    float* Y; const bf16_t* X1B;
    DI void operator()(const f32x4 (&acc)[2][2][4][2], const pg8::Unit& u, int wr, int wc, int fr, int fq) const {
        const int row0 = u.pm * 256 + wr * 64 + fr, col0 = u.pn * 256 + wc * 32 + 4 * fq;
        const bf16_t* xbase = X1B + (size_t)row0 * DM + col0; float* ybase = Y + (size_t)row0 * DM + col0;
        u32x2 xv[3][4];
#pragma unroll
        for (int g0 = 0; g0 < 2; ++g0) { const bf16_t* xn = xbase + (size_t)((g0 >> 2) * 128 + (g0 & 3) * 16) * DM;
#pragma unroll
            for (int k = 0; k < 4; ++k) xv[g0][k] = *(const u32x2*)(xn + (k >> 1) * 128 + (k & 1) * 16); }
#pragma unroll
        for (int gi = 0; gi < 8; ++gi) { const int ai = gi >> 2, m = gi & 3;
            if (gi + 2 < 8) { const int g2 = gi + 2; const bf16_t* xn = xbase + (size_t)((g2 >> 2) * 128 + (g2 & 3) * 16) * DM;
#pragma unroll
                for (int k = 0; k < 4; ++k) xv[g2 % 3][k] = *(const u32x2*)(xn + (k >> 1) * 128 + (k & 1) * 16); }
            float* yp = ybase + (size_t)(ai * 128 + m * 16) * DM;
#pragma unroll
            for (int k = 0; k < 4; ++k) { const u32x2 x = xv[gi % 3][k];
                const f32x4 xf = (f32x4){__uint_as_float(x.x << 16), __uint_as_float(x.x & 0xffff0000u), __uint_as_float(x.y << 16), __uint_as_float(x.y & 0xffff0000u)};
                *(f32x4*)(yp + (k >> 1) * 128 + (k & 1) * 16) = xf + acc[ai][k >> 1][m][k & 1]; } }
    }
};
struct SplitOrder {
    int G, c;
    DI bool next(int i, pg8::Unit& u) const { const int L = i * G + c; if (L >= 176) return false; const int ks = L % 11, t = L / 11; u.pm = 64 + (t >> 2); u.pn = t & 3; u.kb = ks * 512; u.ks = ks; return true; }
    DI void a_ready(const pg8::Unit&) const {}
    DI void done(const pg8::Unit&) const {}
};
struct SampleOrder3 {
    int c;
    DI bool next(int i, pg8::Unit& u) const { if (i != 0 || c >= 48) return false; u.pm = 64 + c / 12; u.pn = c % 12; u.kb = 0; u.ks = 0; return true; }
    DI void a_ready(const pg8::Unit&) const {}
    DI void done(const pg8::Unit&) const {}
};
struct SplitOrder2 {
    int G, c;
    DI bool next(int i, pg8::Unit& u) const { const int L = i * G + c; if (L >= 64) return false; const int ks = L & 3, t = L >> 2; u.pm = 64 + (t >> 2); u.pn = t & 3; u.kb = ks * 512; u.ks = ks; return true; }
    DI void a_ready(const pg8::Unit&) const {}
    DI void done(const pg8::Unit&) const {}
};
struct EpiX2Split {
    static constexpr bool PERM = false, AFTER_DRAIN = false;
    float* SLAB;
    DI void operator()(const f32x4 (&acc)[2][2][4][2], const pg8::Unit& u, int wr, int wc, int fr, int fq) const {
        const int row0 = u.pm * 256 + wr * 64 + fr, col0 = u.pn * 256 + wc * 32 + 4 * fq;
        float* base = SLAB + (size_t)u.ks * (1024 * 1024) - (size_t)NTOK_P * DM;
#pragma unroll
        for (int ai = 0; ai < 2; ++ai)
#pragma unroll
            for (int m = 0; m < 4; ++m) { float* yp = base + (size_t)(row0 + ai * 128 + m * 16) * DM + col0;
#pragma unroll
                for (int bj = 0; bj < 2; ++bj)
#pragma unroll
                    for (int n = 0; n < 2; ++n) { f32x4* p = (f32x4*)(yp + bj * 128 + n * 16); *p = acc[ai][bj][m][n]; } }
    }
};

DI void p0_transpose_item(const float* W, int ldw, int nblk, int K, bf16_t* WT, int rmul, int radd, const float* ksc, LAS float* scr, int item, int lane) {
    const int kb = item / nblk, nb = item % nblk, k0 = 64 * kb, n0 = 32 * nb;
#pragma unroll
    for (int i = 0; i < 32; ++i) { const int kk = 2 * i + (lane >> 5); scr[kk * 33 + (lane & 31)] = W[(size_t)(k0 + kk) * ldw + n0 + (lane & 31)]; }
    const int c = lane & 7;
    f32x4 sa = (f32x4){1.f, 1.f, 1.f, 1.f}, sb = sa;
    if (ksc) { sa = *(const f32x4*)(ksc + k0 + 8 * c); sb = *(const f32x4*)(ksc + k0 + 8 * c + 4); }
    asm volatile("s_waitcnt lgkmcnt(0)" ::: "memory");
#pragma unroll
    for (int j = 0; j < 4; ++j) { const int n = (lane >> 3) + 8 * j; const LAS float* s = scr + (8 * c) * 33 + n;
        u32x4 o; o.x = pk2(s[0 * 33] * sa.x, s[1 * 33] * sa.y); o.y = pk2(s[2 * 33] * sa.z, s[3 * 33] * sa.w); o.z = pk2(s[4 * 33] * sb.x, s[5 * 33] * sb.y); o.w = pk2(s[6 * 33] * sb.z, s[7 * 33] * sb.w);
        *(u32x4*)(WT + (size_t)((n0 + n) * rmul + radd) * K + k0 + 8 * c) = o; }
    asm volatile("s_waitcnt lgkmcnt(0)" ::: "memory");
}
DI void phase0(const Params& P, LAS unsigned char* lds) {
    const int tid = tid_(), lane = tid & 63, wave = tid >> 6, G = gridDim.x;
    unsigned char* ws = P.ws;
    LAS float* scr = (LAS float*)(lds + wave * 16384);
    const int gw = blockIdx.x * NWAVES + wave, NGW = G * NWAVES;
    constexpr int I_IN = 16 * 96;
    for (int it = gw; it < I_IN + 512; it += NGW) {
        if (it < I_IN) p0_transpose_item(P.in[I_WIN], DIN, 96, DM, (bf16_t*)(ws + WS_WIN), 1, 0, nullptr, scr, it, lane);
        else p0_transpose_item(P.in[I_WOUT], DM, 32, DM, (bf16_t*)(ws + WS_WOUT), 1, 0, nullptr, scr, it - I_IN, lane); }
    for (int s = blockIdx.x * NTHR + tid; s < 8192; s += G * NTHR) {
        const int l = s & 63, f = s >> 6, ks = f & 3, nt = (f >> 2) & 1, hb = (f >> 3) & 7, mat = f >> 6;
        const float* w = (mat ? P.in[I_RWI] : P.in[I_RWA]) + hb * 4096 + (16 * ks + 8 * (l >> 5)) * 64 + 32 * nt + (l & 31);
        u32x4 o; o.x = pk2(w[0], w[64]); o.y = pk2(w[128], w[192]); o.z = pk2(w[256], w[320]); o.w = pk2(w[384], w[448]);
        *(u32x4*)(ws + WS_RGW + (size_t)s * 16) = o;
    }
    __syncthreads();
    LAS float* EXT = (LAS float*)lds;
    for (int i = tid; i < 8192; i += NTHR) { const int k = i >> 3, c = i & 7, l = (k & 255) >> 2, q = k & 3, j = k >> 8;
        EXT[(((j * 4 + q) * 64 + l) << 3) + c] = P.in[I_WIN][(size_t)k * DIN + NPROJ + c]; }
    __syncthreads();
    const float* n1 = P.in[I_NORM1];
    f32x4 nw[4];
#pragma unroll
    for (int j = 0; j < 4; ++j) nw[j] = *(const f32x4*)(n1 + 4 * lane + 256 * j);
    for (int m = gw; m < NTOK; m += NGW) {
        const float* xrow = (m < NTOK_P) ? P.in[I_XP] + (size_t)m * DM : P.in[I_XS] + (size_t)(m - NTOK_P) * DM;
        f32x4 v[4]; float s = 0.f;
#pragma unroll
        for (int j = 0; j < 4; ++j) { v[j] = *(const f32x4*)(xrow + 4 * lane + 256 * j); s += (v[j].x * v[j].x + v[j].y * v[j].y) + (v[j].z * v[j].z + v[j].w * v[j].w); }
        const float rstd = rsqrtf(wave_sum(s) * (1.f / DM) + 1e-6f);
        float e[8];
#pragma unroll
        for (int c = 0; c < 8; ++c) e[c] = 0.f;
        bf16_t* orow = (bf16_t*)(ws + WS_HN) + (size_t)m * DM;
#pragma unroll
        for (int j = 0; j < 4; ++j) { v[j] = v[j] * rstd * nw[j];
            u32x2 w; w.x = pk2(v[j].x, v[j].y); w.y = pk2(v[j].z, v[j].w); *(u32x2*)(orow + 4 * lane + 256 * j) = w;
#pragma unroll
            for (int q = 0; q < 4; ++q) { const LAS f32x4* ep = (const LAS f32x4*)(EXT + (((j * 4 + q) * 64 + lane) << 3)); const f32x4 e0 = ep[0], e1 = ep[1]; const float hv = v[j][q];
                e[0] += hv * e0.x; e[1] += hv * e0.y; e[2] += hv * e0.z; e[3] += hv * e0.w; e[4] += hv * e1.x; e[5] += hv * e1.y; e[6] += hv * e1.z; e[7] += hv * e1.w; } }
        {
            const bool b0 = lane & 1, b1 = lane & 2, b2 = lane & 4;
            float k4[4], k2[2];
#pragma unroll
            for (int q = 0; q < 4; ++q) { const float snd = b0 ? e[q] : e[q + 4]; k4[q] = (b0 ? e[q + 4] : e[q]) + __shfl_xor(snd, 1); }
#pragma unroll
            for (int q = 0; q < 2; ++q) { const float snd = b1 ? k4[q] : k4[q + 2]; k2[q] = (b1 ? k4[q + 2] : k4[q]) + __shfl_xor(snd, 2); }
            const float snd = b2 ? k2[0] : k2[1]; float sv = (b2 ? k2[1] : k2[0]) + __shfl_xor(snd, 4);
            sv += __shfl_xor(sv, 8); sv += __shfl_xor(sv, 16); sv += __shfl_xor(sv, 32);
            const int col = (b0 ? 4 : 0) + (b1 ? 2 : 0) + (b2 ? 1 : 0);
            if (lane < 8) {
                if (col < 4) ((float*)(ws + WS_BETA))[m * 4 + col] = sigm(sv);
                else ((float*)(ws + WS_G))[m * 4 + col - 4] = -__expf(P.in[I_ALOG][col - 4]) * softplus(sv + P.in[I_DTB][col - 4]); } }
    }
}

DI void late_weights(const Params& P, LAS unsigned char* lds, int vb, int nb) {
    const int tid = tid_(), lane = tid & 63, wave = tid >> 6;
    unsigned char* ws = P.ws;
    LAS float* scr = (LAS float*)(lds + wave * 16384);
    constexpr int I_G = 16 * 88, I_D = 44 * 32, NIT = 2 * I_G + I_D;
    for (int it = vb * NWAVES + wave; it < NIT; it += nb * NWAVES) {
        int r = it;
        if (r < I_G) { p0_transpose_item(P.in[I_WG], DFF, 88, DM, (bf16_t*)(ws + WS_WGU), 2, 0, P.in[I_NORM2], scr, r, lane); continue; } r -= I_G;
        if (r < I_G) { p0_transpose_item(P.in[I_WU], DFF, 88, DM, (bf16_t*)(ws + WS_WGU), 2, 1, P.in[I_NORM2], scr, r, lane); continue; } r -= I_G;
        p0_transpose_item(P.in[I_WD], DM, 32, DFF, (bf16_t*)(ws + WS_WDN), 1, 0, nullptr, scr, r, lane);
    }
}

DI void gdn_chunk_item(const Params& P, LAS unsigned char* lds, int item) {
    const int tid = tid_(), lane = tid & 63, wave = tid >> 6;
    const int h = item & 3, bn = item >> 2, b = bn >> 5, n = bn & 31;
    const int m0 = b * 2048 + n * 64, cid = (b * 4 + h) * 32 + n;
    unsigned char* ws = P.ws;
    LAS float* QT = (LAS float*)lds; LAS float* KT = QT + 64 * 132; LAS float* VT = KT + 64 * 132;
    LAS float* LM = VT + 64 * 132; LAS float* QKM = LM + 64 * 68; LAS float* SM = QKM + 64 * 68;
    const bf16_t* PROJ = (const bf16_t*)(ws + WS_PROJ);
    if (tid < 384) {
        const int cg8 = tid % 48, tg = tid / 48, mat = cg8 >> 4, d0 = (cg8 & 15) * 8, ch = mat * 512 + h * 128 + d0;
        const bf16_t* src = PROJ + (size_t)(m0 + 8 * tg) * NPROJ + 1024 + ch;
        u32x4 raw[11];
        const bool hist = (n > 0 || tg > 0);
#pragma unroll
        for (int q = 0; q < 11; ++q) { if (q >= 3 || hist) raw[q] = *(const u32x4*)(src + (q - 3) * NPROJ); else raw[q] = (u32x4){0u, 0u, 0u, 0u}; }
        const float* cw = P.in[I_GCW] + ch;
        f32x4 wv[4][2];
#pragma unroll
        for (int j = 0; j < 4; ++j) { wv[j][0] = *(const f32x4*)(cw + j * 1536); wv[j][1] = *(const f32x4*)(cw + j * 1536 + 4); }
        LAS float* T = QT + mat * (64 * 132);
#pragma unroll
        for (int i = 0; i < 8; ++i) {
            f32x4 y0 = (f32x4){0.f, 0.f, 0.f, 0.f}, y1 = y0;
#pragma unroll
            for (int j = 0; j < 4; ++j) { const u32x4 x = raw[i + j];
                const f32x4 xa = (f32x4){__uint_as_float(x.x << 16), __uint_as_float(x.x & 0xffff0000u), __uint_as_float(x.y << 16), __uint_as_float(x.y & 0xffff0000u)};
                const f32x4 xb = (f32x4){__uint_as_float(x.z << 16), __uint_as_float(x.z & 0xffff0000u), __uint_as_float(x.w << 16), __uint_as_float(x.w & 0xffff0000u)};
                y0 += wv[j][0] * xa; y1 += wv[j][1] * xb; }
            f32x4 s0, s1;
#pragma unroll
            for (int e = 0; e < 4; ++e) { s0[e] = silu(y0[e]); s1[e] = silu(y1[e]); }
            *(LAS f32x4*)(T + (8 * tg + i) * 132 + d0) = s0; *(LAS f32x4*)(T + (8 * tg + i) * 132 + d0 + 4) = s1;
            if (n == 31 && tg == 7 && i >= 5) { const u32x4 x = raw[i + 3]; float* op = P.out + OUT_PGC + (size_t)(b * 3 + (i - 5)) * 1536 + ch;
                *(f32x4*)op = (f32x4){__uint_as_float(x.x << 16), __uint_as_float(x.x & 0xffff0000u), __uint_as_float(x.y << 16), __uint_as_float(x.y & 0xffff0000u)};
                *(f32x4*)(op + 4) = (f32x4){__uint_as_float(x.z << 16), __uint_as_float(x.z & 0xffff0000u), __uint_as_float(x.w << 16), __uint_as_float(x.w & 0xffff0000u)}; }
        }
    }
    if (tid < 64) {
        SM[128 + tid] = ((const float*)(ws + WS_BETA))[(m0 + tid) * 4 + h];
        float g = ((const float*)(ws + WS_G))[(m0 + tid) * 4 + h];
#pragma unroll
        for (int o = 1; o < 64; o <<= 1) { const float t = __shfl_up(g, o); if (lane >= o) g += t; }
        SM[tid] = g; SM[64 + tid] = __expf(g);
    }
    __syncthreads();
#pragma unroll 1
    for (int k = 0; k < 8; ++k) {
        const int i = 8 * wave + k;
        const float q0 = QT[i * 132 + lane], q1 = QT[i * 132 + 64 + lane], k0 = KT[i * 132 + lane], k1 = KT[i * 132 + 64 + lane];
        const float rq = rsqrtf(wave_sum(q0 * q0 + q1 * q1) + 1e-6f) * 0.08838834764831845f, rk = rsqrtf(wave_sum(k0 * k0 + k1 * k1) + 1e-6f);
        QT[i * 132 + lane] = q0 * rq; QT[i * 132 + 64 + lane] = q1 * rq; KT[i * 132 + lane] = k0 * rk; KT[i * 132 + 64 + lane] = k1 * rk;
    }
    __syncthreads();
    {
        const int which = wave >> 2, it = (wave >> 1) & 1, jt = wave & 1, r = lane & 31, hh = lane >> 5;
        LAS float* dst = which ? QKM : LM;
        f32x16 acc = zero16();
        if (!(it == 0 && jt == 1)) {
            const LAS float* Ar = (which ? QT : KT) + (32 * it + r) * 132 + 8 * hh;
            const LAS float* Br = KT + (32 * jt + r) * 132 + 8 * hh;
#pragma unroll
            for (int ks = 0; ks < 8; ++ks) {
                const bf16x8 a = pack8(*(const LAS f32x4*)(Ar + 16 * ks), *(const LAS f32x4*)(Ar + 16 * ks + 4));
                const bf16x8 bb = pack8(*(const LAS f32x4*)(Br + 16 * ks), *(const LAS f32x4*)(Br + 16 * ks + 4));
                acc = MFMA32(a, bb, acc);
            }
        }
        const int j = 32 * jt + r; const float gcj = SM[j];
#pragma unroll
        for (int reg = 0; reg < 16; ++reg) {
            const int i = 32 * it + crow(reg, hh); const float gci = SM[i];
            float v = 0.f;
            if (which == 0) { if (j < i) v = acc[reg] * SM[128 + i] * __expf(gci - gcj); }
            else { if (j <= i) v = acc[reg] * __expf(gci - gcj); }
            dst[i * 68 + j] = v;
        }
    }
    __syncthreads();
    {
        const float gcl = SM[63];
        bf16_t* QDF = (bf16_t*)(ws + WS_QDF) + (size_t)cid * 8192; bf16_t* KTF = (bf16_t*)(ws + WS_KTF) + (size_t)cid * 8192; bf16_t* QKF = (bf16_t*)(ws + WS_QKF) + (size_t)cid * 4096;
#pragma unroll 1
        for (int s = tid; s < 2560; s += NTHR) {
            const int l = s & 63, r = l & 31, hh = l >> 5, f = s >> 6;
            float v[8];
            if (f < 16) { const int mt = f >> 3, kk = f & 7, c = 32 * mt + r, db = 16 * kk + 4 * hh; const float sc = SM[64 + c];
                {   const f32x4 lo = *(const LAS f32x4*)(QT + c * 132 + db), hi = *(const LAS f32x4*)(QT + c * 132 + db + 8);
                    v[0] = lo.x * sc; v[1] = lo.y * sc; v[2] = lo.z * sc; v[3] = lo.w * sc; v[4] = hi.x * sc; v[5] = hi.y * sc; v[6] = hi.z * sc; v[7] = hi.w * sc; }
                *(bf16x8*)(QDF + f * 512 + l * 8) = pack8v(v);
            } else if (f < 32) { const int f2 = f - 16, dmt = f2 >> 2, ks = f2 & 3, d = 32 * dmt + r, cb = 16 * ks + 4 * hh;
#pragma unroll
                for (int e = 0; e < 8; ++e) { const int c = cb + 8 * (e >> 2) + (e & 3); v[e] = KT[c * 132 + d] * __expf(gcl - SM[c]); }
                *(bf16x8*)(KTF + f2 * 512 + l * 8) = pack8v(v);
            } else { const int f3 = f - 32, mt = f3 >> 2, ks = f3 & 3, i = 32 * mt + r, cb = 16 * ks + 4 * hh;
                {   const f32x4 lo = *(const LAS f32x4*)(QKM + i * 68 + cb), hi = *(const LAS f32x4*)(QKM + i * 68 + cb + 8);
                    v[0] = lo.x; v[1] = lo.y; v[2] = lo.z; v[3] = lo.w; v[4] = hi.x; v[5] = hi.y; v[6] = hi.z; v[7] = hi.w; }
                *(bf16x8*)(QKF + f3 * 512 + l * 8) = pack8v(v);
            }
        }
        if (tid == 0) ((float*)(ws + WS_GL))[cid] = __expf(gcl);
    }
    __syncthreads();
    LAS float* TM = QKM;
    {   const int r = lane & 31, hh = lane >> 5;
        if (wave < 2 && lane < 32) {
            const LAS float* Lb = vlaunder((const LAS float*)(LM + (32 * wave) * 68 + 32 * wave));
            float x[32];
#pragma unroll
            for (int i = 0; i < 32; ++i) x[i] = (i == lane) ? 1.f : 0.f;
#pragma unroll
            for (int ip = 1; ip < 32; ip += 2) {
                f32x4 la[8], lb[8];
#pragma unroll
                for (int j4 = 0; j4 < (ip + 3) / 4; ++j4) la[j4] = *(const LAS f32x4*)(Lb + ip * 68 + 4 * j4);
                if (ip + 1 < 32) {
#pragma unroll
                    for (int j4 = 0; j4 < (ip + 4) / 4; ++j4) lb[j4] = *(const LAS f32x4*)(Lb + (ip + 1) * 68 + 4 * j4); }
                {   const int i = ip; float a0 = 0.f, a1 = 0.f, a2 = 0.f, a3 = 0.f;
#pragma unroll
                    for (int j4 = 0; j4 < (i + 3) / 4; ++j4) { const f32x4 l4 = la[j4];
                        if (4 * j4 + 0 < i) a0 += l4.x * x[4 * j4 + 0]; if (4 * j4 + 1 < i) a1 += l4.y * x[4 * j4 + 1];
                        if (4 * j4 + 2 < i) a2 += l4.z * x[4 * j4 + 2]; if (4 * j4 + 3 < i) a3 += l4.w * x[4 * j4 + 3]; }
                    x[i] -= (a0 + a1) + (a2 + a3); }
                if (ip + 1 < 32) { const int i = ip + 1; float a0 = 0.f, a1 = 0.f, a2 = 0.f, a3 = 0.f;
#pragma unroll
                    for (int j4 = 0; j4 < (i + 3) / 4; ++j4) { const f32x4 l4 = lb[j4];
                        if (4 * j4 + 0 < i) a0 += l4.x * x[4 * j4 + 0]; if (4 * j4 + 1 < i) a1 += l4.y * x[4 * j4 + 1];
                        if (4 * j4 + 2 < i) a2 += l4.z * x[4 * j4 + 2]; if (4 * j4 + 3 < i) a3 += l4.w * x[4 * j4 + 3]; }
                    x[i] -= (a0 + a1) + (a2 + a3); }
                asm volatile("" ::: "memory"); __builtin_amdgcn_sched_barrier(0);
            }
            LAS float* Tb = vlaunder(TM + (32 * wave) * 68 + 32 * wave + lane);
#pragma unroll
            for (int i = 0; i < 32; ++i) Tb[i * 68] = x[i];
        } else if (wave == 2) {
#pragma unroll
            for (int q = 0; q < 16; ++q) { const int idx = q * 64 + lane; TM[(idx >> 5) * 68 + 32 + (idx & 31)] = 0.f; }
        }
        __syncthreads();
        if (wave == 0) {
            f32x16 M = zero16();
#pragma unroll
            for (int ks = 0; ks < 2; ++ks) { const LAS float* ap = LM + (32 + r) * 68 + 16 * ks + 8 * hh; float bv[8];
#pragma unroll
                for (int e = 0; e < 8; ++e) bv[e] = TM[(16 * ks + 8 * hh + e) * 68 + r];
                M = MFMA32(pack8(*(const LAS f32x4*)ap, *(const LAS f32x4*)(ap + 4)), pack8v(bv), M); }
            f32x16 T2 = zero16();
#pragma unroll
            for (int sx = 0; sx < 2; ++sx) { const LAS float* ap = TM + (32 + r) * 68 + 32 + 16 * sx + 4 * hh;
                T2 = MFMA32(pack8(*(const LAS f32x4*)ap, *(const LAS f32x4*)(ap + 8)), pack_step(M, sx), T2); }
#pragma unroll
            for (int reg = 0; reg < 16; ++reg) TM[(32 + crow(reg, hh)) * 68 + r] = -T2[reg];
        }
        __syncthreads();
        {
            bf16_t* WF = (bf16_t*)(ws + WS_WF) + (size_t)cid * 8192; bf16_t* UB = (bf16_t*)(ws + WS_UB) + (size_t)cid * 8192;
            const int dt = wave >> 1, ct = wave & 1, mt = wave >> 2, es = wave & 3;
            f32x16 aw = zero16(), au = zero16();
#pragma unroll
            for (int ks = 0; ks < 4; ++ks) {
                float av[8], bv[8];
#pragma unroll
                for (int e = 0; e < 8; ++e) { const int j = 16 * ks + 8 * hh + e; const float bj = SM[128 + j]; av[e] = KT[j * 132 + 32 * dt + r] * bj * SM[64 + j]; bv[e] = VT[j * 132 + 32 * es + r] * bj; }
                const LAS float* tw = TM + (32 * ct + r) * 68 + 16 * ks + 8 * hh; const LAS float* tu = TM + (32 * mt + r) * 68 + 16 * ks + 8 * hh;
                aw = MFMA32(pack8v(av), pack8(*(const LAS f32x4*)tw, *(const LAS f32x4*)(tw + 4)), aw);
                au = MFMA32(pack8(*(const LAS f32x4*)tu, *(const LAS f32x4*)(tu + 4)), pack8v(bv), au);
            }
            aw = aw * -1.f;
#pragma unroll
            for (int sx = 0; sx < 2; ++sx) *(bf16x8*)(WF + (ct * 8 + 2 * dt + sx) * 512 + lane * 8) = pack_step(aw, sx);
#pragma unroll
            for (int sx = 0; sx < 2; ++sx) *(bf16x8*)(UB + ((es * 2 + mt) * 64 + lane) * 16 + 8 * sx) = pack_step(au, sx);
        }
    }
    __syncthreads();
}

DI void rg_tile_item(const Params& P, LAS unsigned char* lds, int T) {
    const int tid = tid_(), lane = tid & 63, wave = tid >> 6, r = lane & 31, hh = lane >> 5;
    unsigned char* ws = P.ws;
    LAS bf16_t* XC = (LAS bf16_t*)lds + wave * (64 * 72);
    const bf16_t* PROJ = (const bf16_t*)(ws + WS_PROJ);
    const int m0 = 64 * T; const bool prm = T < 256; const int sq0 = prm ? 0 : (m0 - NTOK_P) / 8;
    {
        const int c = 64 * wave + lane;
        const float* cw = P.in[I_RCW]; const float w0 = cw[c], w1 = cw[512 + c], w2 = cw[1024 + c], w3 = cw[1536 + c], cb = P.in[I_RCB][c];
        const bf16_t* src = PROJ + (size_t)m0 * NPROJ + c;
        float x3 = 0.f, x2 = 0.f, x1 = 0.f;
        if (prm && (T & 31) != 0) { x3 = bf2f(src[-3 * NPROJ]); x2 = bf2f(src[-2 * NPROJ]); x1 = bf2f(src[-NPROJ]); }
        const float* rcs = P.in[I_SRC];
        float xr[64];
#pragma unroll
        for (int i = 0; i < 64; ++i) xr[i] = bf2f(src[i * NPROJ]);
#pragma unroll
        for (int i = 0; i < 64; ++i) {
            const int seq = sq0 + (i >> 3);
            if (!prm && (i & 7) == 0) { x3 = rcs[(size_t)(seq * 3 + 0) * 512 + c]; x2 = rcs[(size_t)(seq * 3 + 1) * 512 + c]; x1 = rcs[(size_t)(seq * 3 + 2) * 512 + c]; }
            const float x0 = xr[i];
            XC[i * 72 + lane] = (bf16_t)f2bf(w0 * x3 + w1 * x2 + w2 * x1 + w3 * x0 + cb);
            if (prm) { if ((T & 31) == 31 && i >= 61) P.out[OUT_PRC + (size_t)((T >> 5) * 3 + (i - 61)) * 512 + c] = x0; }
            else { if ((i & 7) >= 5) P.out[OUT_SRC + (size_t)(seq * 3 + (i & 7) - 5) * 512 + c] = x0; }
            x3 = x2; x2 = x1; x1 = x0;
        }
    }
    asm volatile("s_waitcnt lgkmcnt(0)" ::: "memory");
    const bf16x8* RGW = (const bf16x8*)(ws + WS_RGW);
#pragma unroll 1
    for (int nt = 0; nt < 2; ++nt) {
        f32x16 aa[2], ai[2]; aa[0] = zero16(); aa[1] = zero16(); ai[0] = zero16(); ai[1] = zero16();
#pragma unroll
        for (int ks = 0; ks < 4; ++ks) {
            const bf16x8 bfa = RGW[(((0 * 8 + wave) * 2 + nt) * 4 + ks) * 64 + lane], bfi = RGW[(((1 * 8 + wave) * 2 + nt) * 4 + ks) * 64 + lane];
#pragma unroll
            for (int mt = 0; mt < 2; ++mt) { const bf16x8 a = *(const LAS bf16x8*)(XC + (32 * mt + r) * 72 + 16 * ks + 8 * hh);
                aa[mt] = MFMA32(a, bfa, aa[mt]); ai[mt] = MFMA32(a, bfi, ai[mt]); }
        }
        const int j = 64 * wave + 32 * nt + r;
        const float ba = P.in[I_RBA][j], bi = P.in[I_RBI][j], spl = -8.f * softplus(-P.in[I_LAM][j]);
        float Cc = 0.f, Pp = 1.f;
        const bf16_t* projb = PROJ + (size_t)(m0 + 4 * hh) * NPROJ + 512 + j;
        bf16_t yv[32];
#pragma unroll
        for (int q = 0; q < 32; ++q) yv[q] = projb[(size_t)(32 * (q >> 4) + 8 * ((q >> 2) & 3) + (q & 3)) * NPROJ];
        bf16_t* mixb = (bf16_t*)(ws + WS_MIX) + (size_t)(m0 + 4 * hh) * DM + j;
        bf16_t* gab = (bf16_t*)(ws + WS_GA) + (size_t)(m0 + 4 * hh) * 512 + j;
#pragma unroll
        for (int Gi = 0; Gi < 8; ++Gi) {
            const int mt = Gi >> 2, g = Gi & 3;
            bf16_t* mb = vlaunder(mixb); bf16_t* gb = vlaunder(gab);
            float Hl[4], Ac[4];
#pragma unroll
            for (int k = 0; k < 4; ++k) { const int reg = 4 * g + k, t = 32 * mt + 8 * g + 4 * hh + k;
                const float rg_ = sigm(aa[mt][reg] + ba), ig = sigm(ai[mt][reg] + bi), la = spl * rg_, a = __expf(la), mult = __builtin_amdgcn_sqrtf(one_minus_exp(2.f * la, a * a));
                const float u = mult * ig * bf2f(XC[t * 72 + 32 * nt + r]);
                if (k == 0) { Hl[0] = u; Ac[0] = a; } else { Hl[k] = a * Hl[k - 1] + u; Ac[k] = a * Ac[k - 1]; } }
            const float Ag = Ac[3], Hg = Hl[3], pA = __shfl_xor(Ag, 32), pH = __shfl_xor(Hg, 32);
            const int seq = sq0 + Gi;
            if (!prm) { Cc = P.in[I_SRH][(size_t)seq * 512 + j]; Pp = 1.f; }
            float cin, pin, Cn, Pn;
            if (hh == 0) { cin = Cc; pin = Pp; Cn = pA * (Ag * Cc + Hg) + pH; Pn = Pp * Ag * pA; }
            else { cin = pA * Cc + pH; pin = Pp * pA; Cn = Ag * cin + Hg; Pn = Pp * pA * Ag; }
#pragma unroll
            for (int k = 0; k < 4; ++k) { const int tt = 32 * mt + 8 * g + k;
                const float hv = Hl[k] + Ac[k] * cin, gy = gelu_tanh(bf2f(yv[4 * Gi + k]));
                mb[(size_t)tt * DM] = (bf16_t)f2bf(gy * hv);
                if (prm) gb[(size_t)tt * 512] = (bf16_t)f2bf(gy * Ac[k] * pin);
                else if (hh == 1 && k == 3) P.out[OUT_SRH + (size_t)seq * 512 + j] = hv; }
            Cc = Cn; Pp = Pn;
            asm volatile("" ::: "memory"); __builtin_amdgcn_sched_barrier(0);
        }
        if (prm && hh == 0) { ((float*)(ws + WS_SEGA))[T * 512 + j] = Pp; ((float*)(ws + WS_SEGH))[T * 512 + j] = Cc; }
    }
    asm volatile("s_waitcnt lgkmcnt(0)" ::: "memory");
}

constexpr int SEQ_BUF = 49152;
DI void seq_step(f32x16 (&S)[4], const LAS unsigned char* bw, bf16_t* SNB, bf16_t* VNB, int cid, int es, int lane, float gl) {
    bf16x8 Sb[8];
#pragma unroll
    for (int dt = 0; dt < 4; ++dt) { Sb[2 * dt] = pack_step(S[dt], 0); Sb[2 * dt + 1] = pack_step(S[dt], 1); }
#pragma unroll
    for (int kk = 0; kk < 8; ++kk) *(bf16x8*)(SNB + (size_t)cid * 16384 + (es * 8 + kk) * 512 + lane * 8) = Sb[kk];
    f32x16 vacc[2];
#pragma unroll
    for (int mt = 0; mt < 2; ++mt) { const LAS u32x4* up = (const LAS u32x4*)(bw + 32768 + ((es * 2 + mt) * 64 + lane) * 32); const u32x4 u0 = up[0], u1 = up[1];
#pragma unroll
        for (int i = 0; i < 4; ++i) { vacc[mt][2 * i] = __uint_as_float(u0[i] << 16); vacc[mt][2 * i + 1] = __uint_as_float(u0[i] & 0xffff0000u);
            vacc[mt][8 + 2 * i] = __uint_as_float(u1[i] << 16); vacc[mt][8 + 2 * i + 1] = __uint_as_float(u1[i] & 0xffff0000u); } }
#pragma unroll
    for (int mt = 0; mt < 2; ++mt)
#pragma unroll
        for (int kk = 0; kk < 8; ++kk) vacc[mt] = MFMA32(*(const LAS bf16x8*)(bw + ((mt * 8 + kk) * 64 + lane) * 16), Sb[kk], vacc[mt]);
    bf16x8 vb[4];
#pragma unroll
    for (int ct = 0; ct < 2; ++ct) { vb[2 * ct] = pack_step(vacc[ct], 0); vb[2 * ct + 1] = pack_step(vacc[ct], 1); }
#pragma unroll
    for (int ks = 0; ks < 4; ++ks) *(bf16x8*)(VNB + (size_t)cid * 8192 + (es * 4 + ks) * 512 + lane * 8) = vb[ks];
#pragma unroll
    for (int dt = 0; dt < 4; ++dt) { S[dt] = S[dt] * gl;
#pragma unroll
        for (int ks = 0; ks < 4; ++ks) S[dt] = MFMA32(*(const LAS bf16x8*)(bw + 16384 + ((dt * 4 + ks) * 64 + lane) * 16), vb[ks], S[dt]); }
}
DI void gdn_seq_block(const Params& P, LAS unsigned char* lds, int bh) {
    const int tid = tid_(), lane = tid & 63, wave = __builtin_amdgcn_readfirstlane(tid >> 6), r = lane & 31, hh = lane >> 5;
    unsigned char* ws = P.ws;
    const unsigned char* gW = ws + WS_WF + (size_t)bh * 32 * 16384; const unsigned char* gK = ws + WS_KTF + (size_t)bh * 32 * 16384; const unsigned char* gU = ws + WS_UB + (size_t)bh * 32 * 16384;
    bf16_t* SNB = (bf16_t*)P.out; bf16_t* VNB = (bf16_t*)((unsigned char*)P.out + 32 * MiB);
    const float glv = (lane < 32) ? ((const float*)(ws + WS_GL))[bh * 32 + lane] : 0.f;
    f32x16 S[4]; S[0] = zero16(); S[1] = zero16(); S[2] = zero16(); S[3] = zero16();
    const int es = wave & 3, lt = tid - 256;
#define SEQ_STAGE(nn, bb) do { _Pragma("unroll") for (int q = 0; q < 12; ++q) { const unsigned char* g_ = (q < 4 ? gW : q < 8 ? gK : gU) + (size_t)(nn) * 16384 + ((q & 3) * 256 + lt) * 16; \
        __builtin_amdgcn_global_load_lds((const unsigned*)g_, (LAS unsigned*)(lds + (bb) * SEQ_BUF + (q >> 2) * 16384 + (q & 3) * 4096 + (wave - 4) * 1024), 16, 0, 0); } } while (0)
    if (wave >= 4) {
        SEQ_STAGE(0, 0); SEQ_STAGE(1, 1); asm volatile("s_waitcnt vmcnt(12)" ::: "memory");
        __builtin_amdgcn_s_barrier(); asm volatile("" ::: "memory");
        int bn = 2;
#pragma unroll 1
        for (int n = 0; n < 32; ++n) {
            const int ns = (n + 2 < 32) ? n + 2 : 31; SEQ_STAGE(ns, bn); asm volatile("s_waitcnt vmcnt(12)" ::: "memory");
            __builtin_amdgcn_s_barrier(); asm volatile("" ::: "memory");
            bn = (bn == 2) ? 0 : bn + 1;
        }
        asm volatile("s_waitcnt vmcnt(0)" ::: "memory");
    } else {
        __builtin_amdgcn_s_barrier(); asm volatile("" ::: "memory");
        int bc = 0;
#pragma unroll 1
        for (int n = 0; n < 32; ++n) {
            seq_step(S, lds + bc * SEQ_BUF, SNB, VNB, bh * 32 + n, es, lane, __shfl(glv, n));
            asm volatile("s_waitcnt lgkmcnt(0)" ::: "memory"); __builtin_amdgcn_s_barrier(); asm volatile("" ::: "memory");
            bc = (bc == 2) ? 0 : bc + 1;
        }
    }
    __syncthreads();
#undef SEQ_STAGE
    if (wave < 4) {
        const int e0 = 32 * es;
#pragma unroll
        for (int dt = 0; dt < 4; ++dt)
#pragma unroll
            for (int reg = 0; reg < 16; ++reg) P.out[OUT_PGS + ((size_t)bh * 128 + 32 * dt + crow(reg, hh)) * 128 + e0 + r] = S[dt][reg];
    }
}

DI void gdn_out_item(const Params& P, LAS unsigned char* lds, int cid) {
    const int tid = tid_(), lane = tid & 63, wave = tid >> 6, r = lane & 31, hh = lane >> 5;
    unsigned char* ws = P.ws;
    const int bh = cid >> 5, n = cid & 31, b = bh >> 2, h = bh & 3, mt = wave >> 2, es = wave & 3;
    const bf16_t* SNB = (const bf16_t*)P.out; const bf16_t* VNB = (const bf16_t*)((const unsigned char*)P.out + 32 * MiB);
    const bf16_t* PROJ = (const bf16_t*)(ws + WS_PROJ);
    LAS float* OB = (LAS float*)lds;
    bf16x8 a1[8], b1[8], a2[4], b2[4];
#pragma unroll
    for (int kk = 0; kk < 8; ++kk) { a1[kk] = *(const bf16x8*)((const bf16_t*)(ws + WS_QDF) + (size_t)cid * 8192 + (mt * 8 + kk) * 512 + lane * 8); b1[kk] = *(const bf16x8*)(SNB + (size_t)cid * 16384 + (es * 8 + kk) * 512 + lane * 8); }
#pragma unroll
    for (int ks = 0; ks < 4; ++ks) { a2[ks] = *(const bf16x8*)((const bf16_t*)(ws + WS_QKF) + (size_t)cid * 4096 + (mt * 4 + ks) * 512 + lane * 8); b2[ks] = *(const bf16x8*)(VNB + (size_t)cid * 8192 + (es * 4 + ks) * 512 + lane * 8); }
    const size_t mb = (size_t)b * 2048 + 64 * n + 8 * wave;
    bf16_t zr[8][2];
#pragma unroll
    for (int k = 0; k < 8; ++k) { zr[k][0] = PROJ[(mb + k) * NPROJ + 2560 + 128 * h + lane]; zr[k][1] = PROJ[(mb + k) * NPROJ + 2560 + 128 * h + 64 + lane]; }
    f32x16 oacc = zero16();
#pragma unroll
    for (int kk = 0; kk < 8; ++kk) oacc = MFMA32(a1[kk], b1[kk], oacc);
#pragma unroll
    for (int ks = 0; ks < 4; ++ks) oacc = MFMA32(a2[ks], b2[ks], oacc);
#pragma unroll
    for (int reg = 0; reg < 16; ++reg) OB[(32 * mt + crow(reg, hh)) * 132 + 32 * es + r] = oacc[reg];
    __syncthreads();
    const float gw0 = P.in[I_GNW][lane], gw1 = P.in[I_GNW][lane + 64];
#pragma unroll
    for (int k = 0; k < 8; ++k) { const int c = 8 * wave + k;
        const float o0 = OB[c * 132 + lane], o1 = OB[c * 132 + 64 + lane];
        const float rstd = rsqrtf(wave_sum(o0 * o0 + o1 * o1) * (1.f / 128.f) + 1e-6f);
        bf16_t* mp = (bf16_t*)(ws + WS_MIX) + (mb + k) * DM + 512 + 128 * h;
        mp[lane] = (bf16_t)f2bf(o0 * rstd * gw0 * silu(bf2f(zr[k][0]))); mp[lane + 64] = (bf16_t)f2bf(o1 * rstd * gw1 * silu(bf2f(zr[k][1]))); }
    __syncthreads();
}

DI void gdn_sample_item(const Params& P, LAS unsigned char* lds, int s, int h) {
    const int tid = tid_(), lane = tid & 63, wave = tid >> 6;
    unsigned char* ws = P.ws;
    LAS float* Q = (LAS float*)lds; LAS float* K = Q + 1024; LAS float* V = K + 1024; LAS float* Uu = V + 1024; LAS float* Ww = Uu + 1024; LAS float* Oo = Ww + 1024;
    LAS float* RED = Oo + 1024;
    LAS float* SMs = RED + 8192;
    const bf16_t* PROJ = (const bf16_t*)(ws + WS_PROJ);
    const int m0 = NTOK_P + 8 * s;
    float Sr[32];
    {   const float* S0 = P.in[I_SGS] + ((size_t)(s * 4 + h) * 128 + 32 * (tid >> 7)) * 128 + (tid & 127);
#pragma unroll
        for (int k = 0; k < 32; ++k) Sr[k] = S0[(size_t)k * 128]; }
    const bf16_t zq0 = PROJ[(size_t)(m0 + wave) * NPROJ + 2560 + 128 * h + lane], zq1 = PROJ[(size_t)(m0 + wave) * NPROJ + 2560 + 128 * h + 64 + lane];
    const float gq = ((const float*)(ws + WS_G))[(m0 + (lane & 7)) * 4 + h], bq = ((const float*)(ws + WS_BETA))[(m0 + (lane & 7)) * 4 + h];
    const float gnw0 = P.in[I_GNW][lane], gnw1 = P.in[I_GNW][lane + 64];
    if (tid < 384) {
        const int mat = tid >> 7, d = tid & 127, ch = mat * 512 + h * 128 + d;
        const float* cw = P.in[I_GCW]; const float w0 = cw[ch], w1 = cw[1536 + ch], w2 = cw[3072 + ch], w3 = cw[4608 + ch];
        const float* st = P.in[I_SGC] + (size_t)s * 3 * 1536 + ch;
        float x3 = st[0], x2 = st[1536], x1 = st[3072];
        LAS float* T = Q + mat * 1024;
#pragma unroll
        for (int t = 0; t < 8; ++t) { const float x0 = bf2f(PROJ[(size_t)(m0 + t) * NPROJ + 1024 + ch]);
            T[t * 128 + d] = silu(w0 * x3 + w1 * x2 + w2 * x1 + w3 * x0);
            if (t >= 5) P.out[OUT_SGC + (size_t)(s * 3 + t - 5) * 1536 + ch] = x0;
            x3 = x2; x2 = x1; x1 = x0; }
    }
    if (tid >= 448) {
        const int t = lane & 7;
        float g = gq; const float bt = bq;
#pragma unroll
        for (int o = 1; o < 8; o <<= 1) { const float v = __shfl_up(g, o); if (t >= o) g += v; }
        const float tot = __shfl(g, 7);
        if (lane < 8) { SMs[t] = g; SMs[8 + t] = __expf(g); SMs[16 + t] = bt; SMs[24 + t] = __expf(tot - g); } }
    __syncthreads();
    {   const int i = wave;
        const float q0 = Q[i * 128 + lane], q1 = Q[i * 128 + 64 + lane], k0 = K[i * 128 + lane], k1 = K[i * 128 + 64 + lane];
        const float rq = rsqrtf(wave_sum(q0 * q0 + q1 * q1) + 1e-6f) * 0.08838834764831845f, rk = rsqrtf(wave_sum(k0 * k0 + k1 * k1) + 1e-6f);
        Q[i * 128 + lane] = q0 * rq; Q[i * 128 + 64 + lane] = q1 * rq; K[i * 128 + lane] = k0 * rk; K[i * 128 + 64 + lane] = k1 * rk; }
    __syncthreads();
    if (tid < 128) { const int which = tid >> 6, i = (tid >> 3) & 7, j = tid & 7;
        const LAS float* a = (which ? Q : K) + i * 128; const LAS float* bq = K + j * 128; float dot = 0.f;
        for (int d = 0; d < 128; ++d) dot += a[d] * bq[d];
        const float dec = __expf(SMs[i] - SMs[j]);
        if (which == 0) SMs[32 + i * 8 + j] = (j < i) ? dot * SMs[16 + i] * dec : 0.f;
        else SMs[96 + i * 8 + j] = (j <= i) ? dot * dec : 0.f; }
    __syncthreads();
    if (tid < 256) { const bool isw = tid >= 128; const int ci = tid & 127; float x[8];
#pragma unroll
        for (int i = 0; i < 8; ++i) { float acc = (isw ? K : V)[i * 128 + ci] * SMs[16 + i]; if (isw) acc *= SMs[8 + i];
#pragma unroll
            for (int j = 0; j < 8; ++j) if (j < i) acc -= SMs[32 + i * 8 + j] * x[j];
            x[i] = acc; (isw ? Ww : Uu)[i * 128 + ci] = acc; } }
    __syncthreads();
    {   const int e = tid & 127, dq = tid >> 7;
        float pv[8], po[8];
#pragma unroll
        for (int c = 0; c < 8; ++c) { pv[c] = 0.f; po[c] = 0.f; }
#pragma unroll
        for (int k4 = 0; k4 < 8; ++k4) { const int d = 32 * dq + 4 * k4;
#pragma unroll
            for (int c = 0; c < 8; ++c) { const f32x4 w4 = *(const LAS f32x4*)(Ww + c * 128 + d), q4 = *(const LAS f32x4*)(Q + c * 128 + d);
                pv[c] += (w4.x * Sr[4 * k4] + w4.y * Sr[4 * k4 + 1]) + (w4.z * Sr[4 * k4 + 2] + w4.w * Sr[4 * k4 + 3]);
                po[c] += (q4.x * Sr[4 * k4] + q4.y * Sr[4 * k4 + 1]) + (q4.z * Sr[4 * k4 + 2] + q4.w * Sr[4 * k4 + 3]); } }
#pragma unroll
        for (int c = 0; c < 8; ++c) { RED[(dq * 16 + c) * 128 + e] = pv[c]; RED[(dq * 16 + 8 + c) * 128 + e] = po[c] * SMs[8 + c]; }
        __syncthreads();
        float vn[8];
#pragma unroll
        for (int c = 0; c < 8; ++c) vn[c] = Uu[c * 128 + e] - ((RED[(0 * 16 + c) * 128 + e] + RED[(1 * 16 + c) * 128 + e]) + (RED[(2 * 16 + c) * 128 + e] + RED[(3 * 16 + c) * 128 + e]));
        const float gl = SMs[15];
        float* So = P.out + OUT_SGS + ((size_t)(s * 4 + h) * 128 + 32 * dq) * 128 + e;
        float kv[8];
#pragma unroll
        for (int c = 0; c < 8; ++c) kv[c] = SMs[24 + c] * vn[c];
#pragma unroll
        for (int k4 = 0; k4 < 8; ++k4) { const int d = 32 * dq + 4 * k4; f32x4 acc = (f32x4){Sr[4 * k4] * gl, Sr[4 * k4 + 1] * gl, Sr[4 * k4 + 2] * gl, Sr[4 * k4 + 3] * gl};
#pragma unroll
            for (int c = 0; c < 8; ++c) acc += *(const LAS f32x4*)(K + c * 128 + d) * kv[c];
            So[(size_t)(4 * k4) * 128] = acc.x; So[(size_t)(4 * k4 + 1) * 128] = acc.y; So[(size_t)(4 * k4 + 2) * 128] = acc.z; So[(size_t)(4 * k4 + 3) * 128] = acc.w; }
        if (dq == 0) {
#pragma unroll
            for (int c = 0; c < 8; ++c) { float o = (RED[(0 * 16 + 8 + c) * 128 + e] + RED[(1 * 16 + 8 + c) * 128 + e]) + (RED[(2 * 16 + 8 + c) * 128 + e] + RED[(3 * 16 + 8 + c) * 128 + e]);
#pragma unroll
                for (int j = 0; j < 8; ++j) if (j <= c) o += SMs[96 + c * 8 + j] * vn[j];
                Oo[c * 128 + e] = o; } }
    }
    __syncthreads();
    {   const int c = wave; const size_t m = m0 + c;
        const float o0 = Oo[c * 128 + lane], o1 = Oo[c * 128 + 64 + lane];
        const float rstd = rsqrtf(wave_sum(o0 * o0 + o1 * o1) * (1.f / 128.f) + 1e-6f);
        const float z0 = bf2f(zq0), z1 = bf2f(zq1);
        bf16_t* mp = (bf16_t*)(ws + WS_MIX) + m * DM + 512 + 128 * h;
        mp[lane] = (bf16_t)f2bf(o0 * rstd * gnw0 * silu(z0)); mp[lane + 64] = (bf16_t)f2bf(o1 * rstd * gnw1 * silu(z1)); }
    __syncthreads();
}

DI void rg_fix_item(const Params& P, int b, int n) {
    const int c = tid_(); unsigned char* ws = P.ws;
    const float* SA = (const float*)(ws + WS_SEGA); const float* SH = (const float*)(ws + WS_SEGH);
    float Cc = 0.f;
    {   float sa[31], sh[31];
#pragma unroll
        for (int j = 0; j < 31; ++j) { const int Tj = b * 32 + j; sa[j] = (j < n) ? SA[Tj * 512 + c] : 1.f; sh[j] = (j < n) ? SH[Tj * 512 + c] : 0.f; }
#pragma unroll
        for (int j = 0; j < 31; ++j) Cc = sa[j] * Cc + sh[j]; }
    bf16_t* MIX = (bf16_t*)(ws + WS_MIX); const bf16_t* GA = (const bf16_t*)(ws + WS_GA);
    const size_t mb = (size_t)b * 2048 + 64 * n;
#pragma unroll 1
    for (int i0 = 0; i0 < 64; i0 += 32) {
        bf16_t mx[32], ga[32];
#pragma unroll
        for (int i = 0; i < 32; ++i) { const size_t m = mb + i0 + i; mx[i] = MIX[m * DM + c]; ga[i] = GA[m * 512 + c]; }
#pragma unroll
        for (int i = 0; i < 32; ++i) { const size_t m = mb + i0 + i; MIX[m * DM + c] = (bf16_t)f2bf(bf2f(mx[i]) + bf2f(ga[i]) * Cc); }
    }
    if (n == 31) { const int Tj = b * 32 + 31; P.out[OUT_PRH + (size_t)b * 512 + c] = SA[Tj * 512 + c] * Cc + SH[Tj * 512 + c]; }
}

__global__ void __launch_bounds__(NTHR, 2) hybrid_fwd(Params Pk) {
    extern __shared__ __attribute__((aligned(16))) unsigned char lds_raw[];
    LAS unsigned char* lds = (LAS unsigned char*)lds_raw;
    cg::grid_group grid = cg::this_grid();
    const int G = gridDim.x;
    volatile LAS unsigned* bst = (volatile LAS unsigned*)(lds + (LDS_BYTES - 64));
    if (threadIdx.x < 2) bst[threadIdx.x] = 0u;
    __syncthreads();
    XcdBarrier xb; { const Params P = load_params(); xb = xcd_barrier_post((unsigned*)(P.ws + WS_CTL), bst); }
    int n_stamp = 0;
#define STAMP() do { if (PROBE_T && blockIdx.x == 0 && threadIdx.x == 0) bst[4 + n_stamp] = (unsigned)__builtin_amdgcn_s_memrealtime(); ++n_stamp; } while (0)
    STAMP();

    { const Params P = load_params(); phase0(P, lds); }
    if (PROBE == 10) { __syncthreads(); const Params P = load_params(); phase0(P, lds); }
    if (Pk.ws == nullptr) grid.sync();
    xcd_barrier(xb); if (PROBE == 20) xcd_barrier(xb); STAMP();
    {   const Params P = load_params(); unsigned char* ws = P.ws;
        pg8::Gemm g{(const bf16_t*)(ws + WS_HN), (const bf16_t*)(ws + WS_WIN), NTOK_P, NPROJ, DM, DM}; pg8::StaticOrder S; S.init(NTOK_P, NPROJ, G, (int)blockIdx.x);
        EpiProj E{(bf16_t*)(ws + WS_PROJ), NPROJ};
        pg8::gemm_phase<EpiProj, pg8::StaticOrder, true, true>(lds, g, S, E);
        if (PROBE == 11) pg8::gemm_phase<EpiProj, pg8::StaticOrder, true, true>(lds, g, S, E); }
    xcd_barrier(xb); if (PROBE == 20) xcd_barrier(xb); STAMP();
    {
        const int bx = (int)blockIdx.x;
        if (bx < 48) {
            const Params P = load_params(); unsigned char* ws = P.ws;
            pg8::Gemm g{(const bf16_t*)(ws + WS_HN), (const bf16_t*)(ws + WS_WIN), NTOK, NPROJ, DM, DM}; SampleOrder3 S{bx};
            EpiProj E{(bf16_t*)(ws + WS_PROJ), NPROJ};
            pg8::gemm_phase<EpiProj, SampleOrder3, true, true>(lds, g, S, E);
            __syncthreads(); }
        const int nmine = (G == 256 && bx < 48) ? 3 : 4;
        for (int k = 0; k < nmine; ++k) { const int it = bx + k * G; if (it < 1024) { const Params P = load_params(); gdn_chunk_item(P, lds, it); } }
        if (G == 256 && bx >= 48 && bx < 96) { const Params P = load_params(); gdn_chunk_item(P, lds, 768 + bx - 48); }
        for (int it = bx; it < 256; it += G) { const Params P = load_params(); rg_tile_item(P, lds, it); __syncthreads(); }
        if (G != 256) { const Params P = load_params(); late_weights(P, lds, bx, G); }
        else if (bx >= 96) { const Params P = load_params(); late_weights(P, lds, bx - 96, 160); }
    }
    xcd_barrier(xb); if (PROBE == 20) xcd_barrier(xb); STAMP();
    if (blockIdx.x < 32) { for (int rep = 0; rep < (PROBE == 4 ? 2 : 1); ++rep) { const Params P = load_params(); gdn_seq_block(P, lds, blockIdx.x); } }
    else {
        for (int it = blockIdx.x - 32; it < 512; it += G - 32) { const Params P = load_params(); gdn_sample_item(P, lds, it >> 2, it & 3); }
        {   const int nb = (int)blockIdx.x - 32 - 64;
            if (nb >= 0 && nb < 16) { const Params P = load_params(); rg_tile_item(P, lds, 256 + nb); __syncthreads(); } }
        for (int q = blockIdx.x - 32; q < 248; q += G - 32) { const Params P = load_params(); rg_fix_item(P, q / 31, 1 + q % 31); }
    }
    if (PROBE_T >= 10) { asm volatile("s_waitcnt vmcnt(0)" ::: "memory"); __syncthreads(); if (threadIdx.x == 0) { const Params P = load_params(); ((unsigned*)(P.ws + WS_CTL))[16000 + blockIdx.x] = (unsigned)__builtin_amdgcn_s_memrealtime(); } }
    xcd_barrier(xb); if (PROBE == 20) xcd_barrier(xb); STAMP();
    {
        const int bx = (int)blockIdx.x; const int nmine = (G == 256 && bx >= 192) ? 3 : 4;
        for (int k = 0; k < nmine; ++k) { const int it = bx + k * G; if (it < 1024) { const Params P = load_params(); gdn_out_item(P, lds, it); } }
        if (G == 256 && bx < 64) { const Params P = load_params(); gdn_out_item(P, lds, 960 + bx); }
        if (G != 256) for (int it = bx + 4 * G; it < 1024; it += G) { const Params P = load_params(); gdn_out_item(P, lds, it); } }
    {
        const Params P = load_params(); unsigned char* ws = P.ws;
        pg8::Gemm g{(const bf16_t*)(ws + WS_MIX), (const bf16_t*)(ws + WS_WOUT), NTOK, DM, 256, DM}; SplitOrder2 S{G, G - 1 - (int)blockIdx.x};
        EpiX2Split E{(float*)(ws + WS_SLAB2)};
        pg8::gemm_phase<EpiX2Split, SplitOrder2, true, true>(lds, g, S, E); }
    xcd_barrier(xb); if (PROBE == 20) xcd_barrier(xb); STAMP();
    {   const Params P = load_params(); unsigned char* ws = P.ws;
        pg8::Gemm g{(const bf16_t*)(ws + WS_MIX), (const bf16_t*)(ws + WS_WOUT), NTOK_P, DM, DM, DM}; pg8::StaticOrder S; S.init(NTOK_P, DM, G, (int)blockIdx.x);
        {
            const int tid = tid_(), lane = tid & 63, wave = tid >> 6;
            for (int m = blockIdx.x * NWAVES + wave; m < NTOK - NTOK_P; m += G * NWAVES) {
                const float* xr = P.in[I_XS] + (size_t)m * DM + 4 * lane; const float* sl = (const float*)(ws + WS_SLAB2) + (size_t)m * DM + 4 * lane;
                f32x4 v[4]; float ssum = 0.f;
#pragma unroll
                for (int j = 0; j < 4; ++j) { v[j] = *(const f32x4*)(xr + 256 * j);
#pragma unroll
                    for (int q = 0; q < 4; ++q) v[j] += *(const f32x4*)(sl + (size_t)q * (1024 * 1024) + 256 * j);
                    ssum += (v[j].x * v[j].x + v[j].y * v[j].y) + (v[j].z * v[j].z + v[j].w * v[j].w);
                    u32x2 w; w.x = pk2(v[j].x, v[j].y); w.y = pk2(v[j].z, v[j].w); *(u32x2*)((bf16_t*)(ws + WS_X1B) + (size_t)(NTOK_P + m) * DM + 4 * lane + 256 * j) = w; }
                ssum = wave_sum(ssum); if (lane == 0) ((float*)(ws + WS_SS1))[NTOK_P + m] = ssum; }
            __syncthreads(); }
        if (PROBE == 12) { EpiX1T<false> E0{P.in[I_XP], P.in[I_XS], (bf16_t*)(ws + WS_X1B), (float*)(ws + WS_SS1)}; pg8::gemm_phase<EpiX1T<false>, pg8::StaticOrder, true, true>(lds, g, S, E0); }
        EpiX1T<true> E{P.in[I_XP], P.in[I_XS], (bf16_t*)(ws + WS_X1B), (float*)(ws + WS_SS1)};
        pg8::gemm_phase<EpiX1T<true>, pg8::StaticOrder, true, true>(lds, g, S, E); }
    xcd_barrier(xb); if (PROBE == 20) xcd_barrier(xb); STAMP();
    {   const Params P = load_params(); unsigned char* ws = P.ws;
        pg8::Gemm g{(const bf16_t*)(ws + WS_X1B), (const bf16_t*)(ws + WS_WGU), NTOK, NGU, DM, DM}; pg8::StaticOrder S; S.init(NTOK, NGU, G, (int)blockIdx.x);
        EpiAct E{(bf16_t*)(ws + WS_ACT), (const float*)(ws + WS_SS1)};
        pg8::gemm_phase<EpiAct, pg8::StaticOrder, true, true>(lds, g, S, E);
        if (PROBE == 15) pg8::gemm_phase<EpiAct, pg8::StaticOrder, true, true>(lds, g, S, E); }
    xcd_barrier(xb); if (PROBE == 20) xcd_barrier(xb); STAMP();
    {   const Params P = load_params(); unsigned char* ws = P.ws;
        {   pg8::Gemm g{(const bf16_t*)(ws + WS_ACT), (const bf16_t*)(ws + WS_WDN), NTOK_P, DM, DFF, DFF}; pg8::StaticOrder S; S.init(NTOK_P, DM, G, (int)blockIdx.x);
            EpiX2 E{P.out + OUT_Y, (const bf16_t*)(ws + WS_X1B)};
            pg8::gemm_phase<EpiX2, pg8::StaticOrder, true, true>(lds, g, S, E); }
        {   pg8::Gemm g{(const bf16_t*)(ws + WS_ACT), (const bf16_t*)(ws + WS_WDN), NTOK, DM, 256, DFF}; SplitOrder S{G, (int)blockIdx.x};
            EpiX2Split E{(float*)(ws + WS_SLAB)};
            pg8::gemm_phase<EpiX2Split, SplitOrder, true, true>(lds, g, S, E); } }
    xcd_barrier(xb); if (PROBE == 20) xcd_barrier(xb); STAMP();
    {
        const Params P = load_params();
        const int tid = tid_(), lane = tid & 63, wave = tid >> 6; const float* fw = P.in[I_FN];
        f32x4 nw[4];
#pragma unroll
        for (int j = 0; j < 4; ++j) nw[j] = *(const f32x4*)(fw + 4 * lane + 256 * j);
        for (int rep = (PROBE == 17 ? 0 : 1); rep < 2; ++rep)
        for (int m = blockIdx.x * NWAVES + wave; m < NTOK; m += G * NWAVES) {
            float* row = P.out + OUT_Y + (size_t)m * DM; f32x4 v[4]; float s = 0.f;
            float* orow = (rep == 0) ? (float*)(P.ws + WS_HN) + (size_t)m * DM : row;
#pragma unroll
            for (int j = 0; j < 4; ++j) v[j] = *(const f32x4*)(row + 4 * lane + 256 * j);
            if (m >= NTOK_P) { const bf16_t* xb = (const bf16_t*)(P.ws + WS_X1B) + (size_t)m * DM + 4 * lane;
#pragma unroll
                for (int j = 0; j < 4; ++j) { const u32x2 x = *(const u32x2*)(xb + 256 * j); v[j] = (f32x4){__uint_as_float(x.x << 16), __uint_as_float(x.x & 0xffff0000u), __uint_as_float(x.y << 16), __uint_as_float(x.y & 0xffff0000u)}; }
                const float* sl = (const float*)(P.ws + WS_SLAB) + (size_t)(m - NTOK_P) * DM + 4 * lane;
#pragma unroll
                for (int q = 0; q < 11; ++q)
#pragma unroll
                    for (int j = 0; j < 4; ++j) v[j] += *(const f32x4*)(sl + (size_t)q * (1024 * 1024) + 256 * j); }
#pragma unroll
            for (int j = 0; j < 4; ++j) s += (v[j].x * v[j].x + v[j].y * v[j].y) + (v[j].z * v[j].z + v[j].w * v[j].w);
            const float rstd = rsqrtf(wave_sum(s) * (1.f / DM) + 1e-6f);
#pragma unroll
            for (int j = 0; j < 4; ++j) *(f32x4*)(orow + 4 * lane + 256 * j) = v[j] * rstd * nw[j];
        }
    }
    if (PROBE_T) {
        asm volatile("s_waitcnt vmcnt(0)" ::: "memory"); __syncthreads(); STAMP(); __syncthreads();
        if (blockIdx.x == 0) { const Params P = load_params(); const unsigned* ctlw = (const unsigned*)(P.ws + WS_CTL);
            const unsigned dtk = (PROBE_T < 10) ? bst[4 + PROBE_T] - bst[4 + PROBE_T - 1] : __hip_atomic_load(ctlw + 16000 + (PROBE_T == 10 ? 0 : PROBE_T == 11 ? 40 : 255), __ATOMIC_RELAXED, __HIP_MEMORY_SCOPE_AGENT) - bst[4 + 3];
            const float sc = 1.f + PROBE_SC * (float)dtk;
            for (int i = threadIdx.x; i < 4096; i += NTHR) P.out[OUT_PRH + i] *= sc; }
    }
#undef STAMP
}

extern "C" void kernel_launch(void* const* d_in, const int* in_sizes, int n_in, void* d_out, int out_size, void* d_ws, size_t ws_size, hipStream_t stream) {
    static int grid = 0;
    if (grid == 0) {
        int dev = 0, cus = 0, per_cu = 0;
        if (n_in != 25 || ws_size < WS_END) { fprintf(stderr, "kernel_launch: unexpected n_in %d / ws_size %zu\n", n_in, ws_size); grid = -1; return; }
        hipGetDevice(&dev); hipDeviceGetAttribute(&cus, hipDeviceAttributeMultiprocessorCount, dev);
        hipFuncSetAttribute((const void*)hybrid_fwd, hipFuncAttributeMaxDynamicSharedMemorySize, LDS_BYTES);
        hipOccupancyMaxActiveBlocksPerMultiprocessor(&per_cu, (const void*)hybrid_fwd, NTHR, LDS_BYTES);
        (void)hipGetLastError();
        if (per_cu < 1) { fprintf(stderr, "kernel_launch: occupancy query says %d blocks per CU\n", per_cu); per_cu = 1; }
        grid = cus;
        if (grid > 256) grid = 256;
    }
    if (grid < 0) return;
    hipMemsetAsync((char*)d_ws + WS_CTL, 0, CTL_BYTES, stream);
    Params p{};
    for (int i = 0; i < 25; ++i) p.in[i] = (const float*)d_in[i];
    p.out = (float*)d_out; p.ws = (unsigned char*)d_ws;
    void* args[] = {&p};
    hipError_t e = hipLaunchCooperativeKernel((const void*)hybrid_fwd, dim3(grid), dim3(NTHR), args, LDS_BYTES, stream);
    if (e != hipSuccess) fprintf(stderr, "cooperative launch failed: %s (grid %d)\n", hipGetErrorString(e), grid);
}
```

```cpp
#include <hip/hip_runtime.h>
#include <hip/hip_cooperative_groups.h>
#include <cstdio>
#include <cstdint>
namespace cg = cooperative_groups;
namespace pg8 {
#define PG8_LAS __attribute__((address_space(3)))
typedef unsigned short bf16_t;
typedef short bf16x8 __attribute__((ext_vector_type(8)));
typedef float f32x4 __attribute__((ext_vector_type(4)));
typedef unsigned u32x4 __attribute__((ext_vector_type(4)));
constexpr int BM = 256, BK = 64, HALF = 128, HTB = HALF * BK * 2  , STAGE_BYTES = 8 * HTB, NXCD = 8, WGM = 8;

__host__ __device__ __forceinline__ int lds_byte(int r, int c) { const int st = (r >> 4) * 2 + (c >> 5), rr = r & 15, cc = c & 31, ob = rr * 64 + cc * 2; return st * 1024 + (ob ^ (((ob >> 9) & 1) << 5)); }
__host__ __device__ __forceinline__ void stage_rc(int b, int& R, int& C) { const int st = b / 1024, sb = b % 1024, swz = sb ^ (((sb >> 9) & 1) << 5); R = (st >> 1) * 16 + swz / 64; C = (st & 1) * 32 + (swz % 64) / 2; }
__host__ __device__ __forceinline__ int perm32(int rho) { const int n = rho >> 4, i = rho & 15; return 8 * (i >> 2) + 4 * n + (i & 3); }

struct Unit { int pm, pn, kb, ks; };
struct Gemm { const bf16_t* A; const bf16_t* Bt; int M, N, K, ld; };

struct StaticOrder {
    int nM, nN, nwg, G, c;
    __host__ __device__ void init(int M, int N, int G_, int c_) { nM = M / BM; nN = N / BM; nwg = nM * nN; G = G_; c = c_; }
    __host__ __device__ bool next(int i, Unit& u) const {
        const long L = (long)i * G + c; if (L >= nwg) return false;
        int wgid = (int)L; { const int q = nwg / NXCD, r = nwg % NXCD, xcd = wgid % NXCD, off = wgid / NXCD; wgid = (xcd < r ? xcd * (q + 1) : r * (q + 1) + (xcd - r) * q) + off; }
        const int nig = WGM * nN, gid = wgid / nig, fm = gid * WGM, gsz = (nM - fm) < WGM ? (nM - fm) : WGM;
        u.pm = fm + ((wgid % nig) % gsz); u.pn = (wgid % nig) / gsz; u.kb = 0; u.ks = 0; return true;
    }
    __device__ __forceinline__ void a_ready(const Unit&) const {}
    __device__ __forceinline__ void done(const Unit&) const {}
};
__device__ __forceinline__ unsigned cvt_pk_bf16(float lo, float hi) { unsigned r; asm volatile("v_cvt_pk_bf16_f32 %0, %1, %2" : "=v"(r) : "v"(lo), "v"(hi)); return r; }
template <class Epi, class Sched, bool ALIGN_EPI = false, bool SP2 = false>
__device__ __forceinline__ void gemm_phase(PG8_LAS unsigned char* lds, const Gemm g, const Sched& S, const Epi& E) {
    int tid = threadIdx.x; asm volatile("" : "+v"(tid)); const int wid = __builtin_amdgcn_readfirstlane(tid >> 6), lane = tid & 63, wr = wid >> 2, wc = wid & 3, fr = lane & 15, fq = lane >> 4;
    const int K = g.ld, nt = g.K / BK;
    unsigned voffA[2], voffB[2];
#pragma unroll
    for (int i = 0; i < 2; ++i) { int R, C; stage_rc(tid * 16 + i * 8192, R, C); const int Rb = Epi::PERM ? ((R & ~31) + perm32(R & 31)) : R;
        voffA[i] = (unsigned)(R * K + C) * 2u; voffB[i] = (unsigned)(Rb * K + C) * 2u; }
    const size_t kstep = (size_t)(BK * 2);
    const size_t hstep = (size_t)HALF * K * 2;
    const size_t tstep = 2 * hstep;
    const unsigned ldsw = (unsigned)wid * 1024u;
    const int aoff = lds_byte(wr * 64 + fr, fq * 8), boff = lds_byte(wc * 32 + fr, fq * 8);
#define PG8_SA(b, h) (((b) * 2 + (h)) * HTB)
#define PG8_SB(b, h) ((4 + (b) * 2 + (h)) * HTB)
#define PG8_STAGE(bufoff, gbase, voff) do { _Pragma("unroll") for (int _i = 0; _i < 2; ++_i) \
        __builtin_amdgcn_global_load_lds((const unsigned*)((const char*)(gbase) + (voff)[_i]), (PG8_LAS unsigned*)(lds + (bufoff) + ldsw + _i * 8192), 16, 0, 0); } while (0)
#define PG8_LDA(dst, b, h) do { _Pragma("unroll") for (int m = 0; m < 4; ++m) _Pragma("unroll") for (int k = 0; k < 2; ++k) dst[m][k] = *(const PG8_LAS bf16x8*)(lds + PG8_SA(b, h) + aoff + m * 2048 + k * 1024); } while (0)
#define PG8_LDB(dst, b, h) do { _Pragma("unroll") for (int n = 0; n < 2; ++n) _Pragma("unroll") for (int k = 0; k < 2; ++k) dst[n][k] = *(const PG8_LAS bf16x8*)(lds + PG8_SB(b, h) + boff + n * 2048 + k * 1024); } while (0)
#define PG8_MMA(ai, bj, At, Bt) do { __builtin_amdgcn_s_setprio(1); _Pragma("unroll") for (int m = 0; m < 4; ++m) _Pragma("unroll") for (int n = 0; n < 2; ++n) _Pragma("unroll") for (int k = 0; k < 2; ++k) \
        acc[ai][bj][m][n] = __builtin_amdgcn_mfma_f32_16x16x32_bf16(Bt[n][k], At[m][k], acc[ai][bj][m][n], 0, 0, 0); __builtin_amdgcn_s_setprio(0); } while (0)
#define PG8_WAIT_V(n) asm volatile("s_waitcnt vmcnt(" #n ")" ::: "memory")
#define PG8_WAIT_L(n) asm volatile("s_waitcnt lgkmcnt(" #n ")" ::: "memory")
#define PG8_BAR __builtin_amdgcn_s_barrier()
#define PG8_SCHED __builtin_amdgcn_sched_barrier(0)
    Unit cur, nxt; int ui = 0;
    if (!S.next(0, cur)) return;
    f32x4 acc[2][2][4][2];
#pragma unroll
    for (int a = 0; a < 2; ++a)
#pragma unroll
        for (int b = 0; b < 2; ++b)
#pragma unroll
            for (int m = 0; m < 4; ++m)
#pragma unroll
                for (int n = 0; n < 2; ++n) acc[a][b][m][n] = (f32x4){0.f, 0.f, 0.f, 0.f};
    bf16x8 At[4][2], B0[2][2], B1[2][2];
    const char* cA = (const char*)g.A + (size_t)cur.pm * tstep + cur.kb; const char* cB = (const char*)g.Bt + (size_t)cur.pn * tstep + cur.kb;
    S.a_ready(cur);
    if constexpr (SP2) {
        PG8_STAGE(PG8_SB(0, 0), cB, voffB); PG8_STAGE(PG8_SB(0, 1), cB + hstep, voffB); PG8_STAGE(PG8_SA(0, 0), cA, voffA); PG8_STAGE(PG8_SA(0, 1), cA + hstep, voffA);
        if (wr == 1) PG8_BAR;
        PG8_WAIT_V(2); PG8_BAR;
        PG8_STAGE(PG8_SB(1, 0), cB + kstep, voffB); PG8_STAGE(PG8_SA(1, 0), cA + kstep, voffA); PG8_STAGE(PG8_SB(1, 1), cB + hstep + kstep, voffB);
        PG8_WAIT_V(6); PG8_BAR;
    } else {
        PG8_STAGE(PG8_SB(0, 0), cB, voffB); PG8_STAGE(PG8_SA(0, 0), cA, voffA); PG8_STAGE(PG8_SB(0, 1), cB + hstep, voffB); PG8_STAGE(PG8_SA(0, 1), cA + hstep, voffA);
        if (wr == 1) PG8_BAR;
        PG8_WAIT_V(4); PG8_BAR;
        PG8_STAGE(PG8_SB(1, 0), cB + kstep, voffB); PG8_STAGE(PG8_SA(1, 0), cA + kstep, voffA); PG8_STAGE(PG8_SB(1, 1), cB + hstep + kstep, voffB);
        PG8_WAIT_V(6); PG8_BAR;
    }
    for (;;) {
        const bool has_next = S.next(ui + 1, nxt);
        const char* nA = has_next ? (const char*)g.A + (size_t)nxt.pm * tstep + nxt.kb : cA; const char* nB = has_next ? (const char*)g.Bt + (size_t)nxt.pn * tstep + nxt.kb : cB;
        for (int t = 0; t < nt; t += 2) {
            const bool last = (t == nt - 2);
            const char* a1 = cA + (size_t)(t + 1) * kstep;
            const char* a2 = last ? nA : cA + (size_t)(t + 2) * kstep; const char* b2 = last ? nB : cB + (size_t)(t + 2) * kstep;
            const char* a3 = a2 + kstep; const char* b3 = b2 + kstep;
            if (last && has_next) S.a_ready(nxt);
            if constexpr (SP2) {
            PG8_LDB(B0, 0, 0); PG8_LDB(B1, 0, 1); PG8_SCHED; PG8_LDA(At, 0, 0); PG8_STAGE(PG8_SA(1, 1), a1 + hstep, voffA);
            PG8_WAIT_V(8); PG8_WAIT_L(0); PG8_BAR; PG8_MMA(0, 0, At, B0); PG8_MMA(0, 1, At, B1); PG8_BAR; PG8_SCHED;
            PG8_LDA(At, 0, 1); PG8_STAGE(PG8_SB(0, 0), b2, voffB); PG8_STAGE(PG8_SB(0, 1), b2 + hstep, voffB); PG8_STAGE(PG8_SA(0, 0), a2, voffA);
            PG8_WAIT_V(8); PG8_WAIT_L(0); PG8_BAR; PG8_MMA(1, 0, At, B0); PG8_MMA(1, 1, At, B1); PG8_BAR; PG8_SCHED;
            PG8_LDB(B0, 1, 0); PG8_LDB(B1, 1, 1); PG8_SCHED; PG8_LDA(At, 1, 0); PG8_STAGE(PG8_SA(0, 1), a2 + hstep, voffA);
            PG8_WAIT_V(8); PG8_WAIT_L(0); PG8_BAR; PG8_MMA(0, 0, At, B0); PG8_MMA(0, 1, At, B1); PG8_BAR; PG8_SCHED;
            PG8_LDA(At, 1, 1); PG8_STAGE(PG8_SB(1, 0), b3, voffB); PG8_STAGE(PG8_SB(1, 1), b3 + hstep, voffB); PG8_STAGE(PG8_SA(1, 0), a3, voffA);
            PG8_WAIT_V(8); PG8_WAIT_L(0); PG8_BAR; PG8_MMA(1, 0, At, B0); PG8_MMA(1, 1, At, B1); PG8_BAR; PG8_SCHED;
            } else {
            PG8_LDB(B0, 0, 0); PG8_SCHED; PG8_LDA(At, 0, 0); PG8_STAGE(PG8_SA(1, 1), a1 + hstep, voffA);
            PG8_WAIT_L(8); PG8_BAR; PG8_WAIT_L(0); PG8_MMA(0, 0, At, B0); PG8_BAR; PG8_SCHED;
            PG8_LDB(B1, 0, 1); PG8_STAGE(PG8_SB(0, 0), b2, voffB);
            PG8_BAR; PG8_WAIT_L(0); PG8_MMA(0, 1, At, B1); PG8_BAR;
            PG8_LDA(At, 0, 1); PG8_STAGE(PG8_SA(0, 0), a2, voffA);
            PG8_BAR; PG8_WAIT_L(0); PG8_MMA(1, 0, At, B0); PG8_BAR; PG8_SCHED;
            PG8_STAGE(PG8_SB(0, 1), b2 + hstep, voffB);
            PG8_WAIT_V(6); PG8_BAR; PG8_MMA(1, 1, At, B1); PG8_BAR;
            PG8_LDB(B0, 1, 0); PG8_SCHED; PG8_LDA(At, 1, 0); PG8_STAGE(PG8_SA(0, 1), a2 + hstep, voffA);
            PG8_WAIT_L(8); PG8_BAR; PG8_WAIT_L(0); PG8_MMA(0, 0, At, B0); PG8_BAR; PG8_SCHED;
            PG8_LDB(B1, 1, 1); PG8_STAGE(PG8_SB(1, 0), b3, voffB);
            PG8_BAR; PG8_WAIT_L(0); PG8_MMA(0, 1, At, B1); PG8_BAR;
            PG8_LDA(At, 1, 1); PG8_STAGE(PG8_SA(1, 0), a3, voffA);
            PG8_BAR; PG8_WAIT_L(0); PG8_MMA(1, 0, At, B0); PG8_BAR; PG8_SCHED;
            PG8_STAGE(PG8_SB(1, 1), b3 + hstep, voffB);
            PG8_WAIT_V(6); PG8_BAR; PG8_MMA(1, 1, At, B1); PG8_BAR;
            }
        }
        if constexpr (ALIGN_EPI) { if (wr == 0) PG8_BAR; }
        if constexpr (!Epi::AFTER_DRAIN) { E(acc, cur, wr, wc, fr, fq); S.done(cur); }
        if (!has_next) break;
#pragma unroll
        for (int a = 0; a < 2; ++a)
#pragma unroll
            for (int b = 0; b < 2; ++b)
#pragma unroll
                for (int m = 0; m < 4; ++m)
#pragma unroll
                    for (int n = 0; n < 2; ++n) acc[a][b][m][n] = (f32x4){0.f, 0.f, 0.f, 0.f};
        cur = nxt; cA = nA; cB = nB; ++ui;
        if constexpr (ALIGN_EPI) { if (wr == 1) PG8_BAR; }
    }
    PG8_WAIT_V(0);
    if constexpr (!ALIGN_EPI) { if (wr == 0) PG8_BAR; }
    PG8_BAR;
    if constexpr (Epi::AFTER_DRAIN) { E.fused(acc, cur, wr, wc, fr, fq, lds, wid, lane); S.done(cur); }
#undef PG8_SA
#undef PG8_SB
#undef PG8_STAGE
#undef PG8_LDA
#undef PG8_LDB
#undef PG8_MMA
#undef PG8_WAIT_V
#undef PG8_WAIT_L
#undef PG8_BAR
#undef PG8_SCHED
}
}

#define LAS __attribute__((address_space(3)))
typedef unsigned short bf16_t;
typedef short bf16x8 __attribute__((ext_vector_type(8)));
typedef float f32x4 __attribute__((ext_vector_type(4)));
typedef float f32x16 __attribute__((ext_vector_type(16)));
typedef unsigned u32x4 __attribute__((ext_vector_type(4)));
typedef unsigned u32x2 __attribute__((ext_vector_type(2)));

#define XB_TMO      128
#define XB_XCNT(j)  (256  + 64 * (j))
#define XB_XSUB(j)  (1280 + 64 * (j))
#define XB_XGEN(j)  (2304 + 64 * (j))
#define XB_TOP      3328
#define XB_TOPGEN   3392
#define XCD_BAR_WORDS 3456
#define XB_SPIN_CAP (1u << 18)

__device__ __forceinline__ unsigned xb_ld(unsigned* p)              { return __hip_atomic_load(p, __ATOMIC_RELAXED, __HIP_MEMORY_SCOPE_AGENT); }
__device__ __forceinline__ unsigned xb_add(unsigned* p, unsigned v) { return __hip_atomic_fetch_add(p, v, __ATOMIC_RELAXED, __HIP_MEMORY_SCOPE_AGENT); }
__device__ __forceinline__ unsigned xb_xcc_id() { return (unsigned)__builtin_amdgcn_s_getreg((3 << 11) | 20) & 0xFu; }
#define XB_SPIN(cond, bar) do { unsigned _sp = 0; while (cond) { __builtin_amdgcn_s_sleep(1); \
    if ((++_sp & 255u) == 0u) { if (xb_ld(&(bar)[XB_TMO])) break; if (_sp > XB_SPIN_CAP) { atomicAdd(&(bar)[XB_TMO], 1u); break; } } } } while (0)

struct XcdBarrier {
    unsigned* bar; unsigned x;
    volatile LAS unsigned* st;
};

__device__ __forceinline__ XcdBarrier xcd_barrier_post(unsigned* bar, volatile LAS unsigned* st) {
    XcdBarrier b; b.bar = bar; b.x = xb_xcc_id(); b.st = st;
    if (threadIdx.x == 0) (void)xb_add(&bar[XB_XCNT(b.x)], 1u);
    return b;
}
__device__ __forceinline__ void xcd_barrier_complete(unsigned* bar, unsigned x, unsigned& nloc, unsigned& nx) {
    const unsigned G = gridDim.x * gridDim.y * gridDim.z;
    unsigned sum, cnt, mine, sp = 0u;
    for (;;) {
        sum = 0u; cnt = 0u; mine = 0u;
#pragma unroll
        for (unsigned j = 0; j < 16; ++j) { const unsigned c = xb_ld(&bar[XB_XCNT(j)]); sum += c; cnt += (c > 0u) ? 1u : 0u; mine = (j == x) ? c : mine; }
        if (sum == G) break;
        __builtin_amdgcn_s_sleep(1);
        if ((++sp & 255u) == 0u) { if (xb_ld(&bar[XB_TMO])) break; if (sp > XB_SPIN_CAP) { atomicAdd(&bar[XB_TMO], 1u); break; } }
    }
    nloc = mine > 0u ? mine : 1u; nx = cnt > 0u ? cnt : 1u;
}

__device__ __forceinline__ void xcd_barrier(const XcdBarrier& b) {
    asm volatile("s_waitcnt vmcnt(0)" ::: "memory");
    __syncthreads();
    if (threadIdx.x == 0) {
        unsigned* bar = b.bar;
        __builtin_amdgcn_s_waitcnt(0);
        unsigned nloc = b.st[0], nx = b.st[1];
        if (nloc == 0u) { xcd_barrier_complete(bar, b.x, nloc, nx); b.st[0] = nloc; b.st[1] = nx; }
        const unsigned old = xb_add(&bar[XB_XSUB(b.x)], 1u);
        const unsigned gen = old / nloc;
        if (old + 1u == (gen + 1u) * nloc) {
            __builtin_amdgcn_fence(__ATOMIC_RELEASE, "agent");
            asm volatile("s_waitcnt vmcnt(0)" ::: "memory");
            const unsigned og = xb_add(&bar[XB_TOP], 1u);
            const unsigned tg = og / nx;
            if (og + 1u == (tg + 1u) * nx) xb_add(&bar[XB_TOPGEN], 1u);
            else XB_SPIN(xb_ld(&bar[XB_TOPGEN]) == tg, bar);
            __builtin_amdgcn_fence(__ATOMIC_ACQUIRE, "agent");
            xb_add(&bar[XB_XGEN(b.x)], 1u);
            asm volatile("s_waitcnt vmcnt(0)" ::: "memory");
        } else {
            XB_SPIN(xb_ld(&bar[XB_XGEN(b.x)]) == gen, bar);
            __builtin_amdgcn_fence(__ATOMIC_ACQUIRE, "agent");
            asm volatile("s_waitcnt vmcnt(0)" ::: "memory");
        }
    }
    __syncthreads();
}


constexpr int DM = 1024, NTOK_P = 16384, NTOK = 17408, DIN = 3080, NPROJ = 3072, DFF = 2816, NGU = 5632;
constexpr int NWAVES = 8, NTHR = 512;
constexpr int PROBE = 0;
constexpr int PROBE_T = 0; constexpr float PROBE_SC = 1e-6f;
constexpr int LDS_BYTES = 148480;
constexpr size_t MiB = 1u << 20;
constexpr size_t WS_CTL = 0, CTL_BYTES = 160 * 1024, WS_SS1 = 65536;
constexpr size_t WS_WIN = 1 * MiB, WS_WOUT = 7 * MiB, WS_WGU = 9 * MiB, WS_WDN = 20 * MiB;
constexpr size_t WS_RGW = 25 * MiB + 512 * 1024;
constexpr size_t WS_BETA = 26 * MiB, WS_G = 26 * MiB + 512 * 1024, WS_GL = 26 * MiB + 896 * 1024;
constexpr size_t WS_SEGA = 27 * MiB, WS_SEGH = 27 * MiB + 512 * 1024;
constexpr size_t WS_HN = 28 * MiB, WS_WF = 28 * MiB, WS_QDF = 44 * MiB, WS_X1B = 28 * MiB;
constexpr size_t WS_PROJ = 62 * MiB, WS_ACT = 62 * MiB;
constexpr size_t WS_SLAB2 = 198 * MiB;
constexpr size_t WS_SLAB = 198 * MiB;
constexpr size_t WS_MIX = 164 * MiB, WS_GA = 198 * MiB, WS_KTF = 214 * MiB, WS_QKF = 230 * MiB, WS_UB = 238 * MiB, WS_END = 254 * MiB;
constexpr size_t OUT_Y = 0, OUT_PRC = 17825792, OUT_PRH = 17838080, OUT_PGC = 17842176, OUT_PGS = 17879040,
                 OUT_SRC = 18403328, OUT_SRH = 18599936, OUT_SGC = 18665472, OUT_SGS = 19255296;

struct Params { const float* in[25]; float* out; unsigned char* ws; };
enum { I_XP = 0, I_XS, I_SRC, I_SRH, I_SGC, I_SGS, I_NORM1, I_WIN, I_RCW, I_RCB, I_RWA, I_RBA, I_RWI, I_RBI, I_LAM, I_GCW, I_ALOG, I_DTB, I_GNW, I_WOUT, I_NORM2, I_WG, I_WU, I_WD, I_FN };

#define DI __device__ __forceinline__
#define KAS __attribute__((address_space(4)))
DI Params load_params() {
#if defined(__HIP_DEVICE_COMPILE__)
    const KAS unsigned char* ka = (const KAS unsigned char*)__builtin_amdgcn_kernarg_segment_ptr(); asm volatile("" : "+s"(ka)); return *(const KAS Params*)ka;
#else
    return Params{};
#endif
}
template <class T> DI T vlaunder(T p) { asm volatile("" : "+v"(p)); return p; }
DI int tid_() { int t = threadIdx.x; asm volatile("" : "+v"(t)); return t; }
typedef __bf16 hbf2 __attribute__((ext_vector_type(2)));
typedef float f32x2 __attribute__((ext_vector_type(2)));
DI unsigned pk2(float lo, float hi) { const f32x2 v = {lo, hi}; return __builtin_bit_cast(unsigned, __builtin_convertvector(v, hbf2)); }
DI unsigned f2bf(float f) { return pk2(f, 0.f) & 0xffffu; }
DI float bf2f(bf16_t b) { return __uint_as_float(((unsigned)b) << 16); }
DI float dpp_add(float v, const int ctrl_sel) {
    const int x = __float_as_int(v); int y;
    if (ctrl_sel == 0) y = __builtin_amdgcn_update_dpp(x, x, 0xB1, 0xf, 0xf, false);
    else if (ctrl_sel == 1) y = __builtin_amdgcn_update_dpp(x, x, 0x4E, 0xf, 0xf, false);
    else if (ctrl_sel == 2) y = __builtin_amdgcn_update_dpp(x, x, 0x141, 0xf, 0xf, false);
    else y = __builtin_amdgcn_update_dpp(x, x, 0x140, 0xf, 0xf, false);
    return v + __int_as_float(y);
}
DI float wave_sum(float v) {
    v = dpp_add(v, 0); v = dpp_add(v, 1); v = dpp_add(v, 2); v = dpp_add(v, 3);
    v += __shfl_xor(v, 16); v += __shfl_xor(v, 32);
    return v;
}
DI float sigm(float x) { return __builtin_amdgcn_rcpf(1.f + __expf(-x)); }
DI float silu(float x) { return x * __builtin_amdgcn_rcpf(1.f + __expf(-x)); }
DI float one_minus_exp(float y, float e) { const float p = -y * (1.f + y * (0.5f + y * (0.16666667f + y * (0.041666668f + y * 0.0083333338f)))); return y > -0.3f ? p : 1.f - e; }
DI float softplus(float x) { return x > 20.f ? x : log1pf(__expf(x)); }
DI float gelu_tanh(float x) { const float u = 0.7978845608028654f * (x + 0.044715f * x * x * x); return x * __builtin_amdgcn_rcpf(1.f + __expf(-2.f * u)); }
DI int crow(int reg, int hh) { return (reg & 3) + 8 * (reg >> 2) + 4 * hh; }
DI bf16x8 pack8(f32x4 a, f32x4 b) { u32x4 p; p.x = pk2(a.x, a.y); p.y = pk2(a.z, a.w); p.z = pk2(b.x, b.y); p.w = pk2(b.z, b.w); return __builtin_bit_cast(bf16x8, p); }
DI bf16x8 pack8v(const float* v) { u32x4 p; p.x = pk2(v[0], v[1]); p.y = pk2(v[2], v[3]); p.z = pk2(v[4], v[5]); p.w = pk2(v[6], v[7]); return __builtin_bit_cast(bf16x8, p); }
#define MFMA32(a, b, c) __builtin_amdgcn_mfma_f32_32x32x16_bf16((a), (b), (c), 0, 0, 0)
DI bf16x8 pack_step(const f32x16& x, int s) {
    u32x4 p;
    p.x = pk2(x[8 * s + 0], x[8 * s + 1]); p.y = pk2(x[8 * s + 2], x[8 * s + 3]); p.z = pk2(x[8 * s + 4], x[8 * s + 5]); p.w = pk2(x[8 * s + 6], x[8 * s + 7]);
    return __builtin_bit_cast(bf16x8, p);
}
DI f32x16 zero16() { f32x16 z;
#pragma unroll
    for (int i = 0; i < 16; ++i) z[i] = 0.f;
    return z; }

struct EpiProj {
    static constexpr bool PERM = true, AFTER_DRAIN = false;
    bf16_t* O; int ldc;
    DI void operator()(const f32x4 (&acc)[2][2][4][2], const pg8::Unit& u, int wr, int wc, int fr, int fq) const {
        const int row0 = u.pm * 256 + wr * 64 + fr, col0 = u.pn * 256 + wc * 32 + 8 * fq;
#pragma unroll
        for (int ai = 0; ai < 2; ++ai)
#pragma unroll
            for (int m = 0; m < 4; ++m) { bf16_t* rowp = O + (size_t)(row0 + ai * 128 + m * 16) * ldc + col0;
#pragma unroll
                for (int bj = 0; bj < 2; ++bj) { const f32x4 v0 = acc[ai][bj][m][0], v1 = acc[ai][bj][m][1];
                    u32x4 w; w.x = pg8::cvt_pk_bf16(v0[0], v0[1]); w.y = pg8::cvt_pk_bf16(v0[2], v0[3]); w.z = pg8::cvt_pk_bf16(v1[0], v1[1]); w.w = pg8::cvt_pk_bf16(v1[2], v1[3]);
                    *(u32x4*)(rowp + bj * 128) = w; } }
    }
};
template <bool ATOM> struct EpiX1T {
    static constexpr bool PERM = false, AFTER_DRAIN = false;
    const float* xp; const float* xs; bf16_t* X1B; float* SS1;
    DI void operator()(const f32x4 (&acc)[2][2][4][2], const pg8::Unit& u, int wr, int wc, int fr, int fq) const {
        const int row0 = u.pm * 256 + wr * 64 + fr, col0 = u.pn * 256 + wc * 32 + 4 * fq;
        const float* xbase = (u.pm < 64 ? xp + (size_t)row0 * DM : xs + (size_t)(row0 - NTOK_P) * DM) + col0;
        f32x4 xv[3][4];
#pragma unroll
        for (int g0 = 0; g0 < 2; ++g0) { const float* xn = xbase + (size_t)((g0 >> 2) * 128 + (g0 & 3) * 16) * DM;
#pragma unroll
            for (int k = 0; k < 4; ++k) xv[g0][k] = *(const f32x4*)(xn + (k >> 1) * 128 + (k & 1) * 16); }
#pragma unroll
        for (int gi = 0; gi < 8; ++gi) { const int ai = gi >> 2, m = gi & 3, row = row0 + ai * 128 + m * 16;
            if (gi + 2 < 8) { const int g2 = gi + 2; const float* xn = xbase + (size_t)((g2 >> 2) * 128 + (g2 & 3) * 16) * DM;
#pragma unroll
                for (int k = 0; k < 4; ++k) xv[g2 % 3][k] = *(const f32x4*)(xn + (k >> 1) * 128 + (k & 1) * 16); }
            bf16_t* bp = X1B + (size_t)row * DM + col0; float ss = 0.f;
#pragma unroll
            for (int k = 0; k < 4; ++k) { const int bj = k >> 1, n = k & 1; const f32x4 v = acc[ai][bj][m][n] + xv[gi % 3][k];
                u32x2 w; w.x = pk2(v[0], v[1]); w.y = pk2(v[2], v[3]);
                *(u32x2*)(bp + bj * 128 + n * 16) = w; ss += (v[0] * v[0] + v[1] * v[1]) + (v[2] * v[2] + v[3] * v[3]); }
            ss += __shfl_xor(ss, 16); ss += __shfl_xor(ss, 32);
            if (ATOM && fq == 0) atomicAdd(SS1 + row, ss); }
    }
};
struct EpiAct {
    static constexpr bool PERM = true, AFTER_DRAIN = false;
    bf16_t* ACT; const float* SS1;
    DI void operator()(const f32x4 (&acc)[2][2][4][2], const pg8::Unit& u, int wr, int wc, int fr, int fq) const {
        const int row0 = u.pm * 256 + wr * 64 + fr, col0 = u.pn * 256 + wc * 32 + 8 * fq;
        float ssv[8];
#pragma unroll
        for (int gi = 0; gi < 8; ++gi) ssv[gi] = SS1[row0 + (gi >> 2) * 128 + (gi & 3) * 16];
#pragma unroll
        for (int ai = 0; ai < 2; ++ai)
#pragma unroll
            for (int m = 0; m < 4; ++m) { const int row = row0 + ai * 128 + m * 16; const float rstd = rsqrtf(ssv[ai * 4 + m] * (1.f / DM) + 1e-6f);
                bf16_t* rowp = ACT + (size_t)row * DFF + (col0 >> 1);
#pragma unroll
                for (int bj = 0; bj < 2; ++bj) { const f32x4 v0 = acc[ai][bj][m][0] * rstd, v1 = acc[ai][bj][m][1] * rstd;
                    u32x2 w; w.x = pg8::cvt_pk_bf16(silu(v0[0]) * v0[1], silu(v0[2]) * v0[3]); w.y = pg8::cvt_pk_bf16(silu(v1[0]) * v1[1], silu(v1[2]) * v1[3]);
                    *(u32x2*)(rowp + bj * 64) = w; } }
    }
};
struct EpiX2 {
    static constexpr bool PERM = false, AFTER_DRAIN = false;
    float* Y; const bf16_t* X1B;
    DI void operator()(const f32x4 (&acc)[2][2][4][2], const pg8::Unit& u, int wr, int wc, int fr, int fq) const {
        const int row0 = u.pm * 256 + wr * 64 + fr, col0 = u.pn * 256 + wc * 32 + 4 * fq;
        const bf16_t* xbase = X1B + (size_t)row0 * DM + col0; float* ybase = Y + (size_t)row0 * DM + col0;
        u32x2 xv[3][4];
#pragma unroll
        for (int g0 = 0; g0 < 2; ++g0) { const bf16_t* xn = xbase + (size_t)((g0 >> 2) * 128 + (g0 & 3) * 16) * DM;
#pragma unroll
            for (int k = 0; k < 4; ++k) xv[g0][k] = *(const u32x2*)(xn + (k >> 1) * 128 + (k & 1) * 16); }
#pragma unroll
        for (int gi = 0; gi < 8; ++gi) { const int ai = gi >> 2, m = gi & 3;
            if (gi + 2 < 8) { const int g2 = gi + 2; const bf16_t* xn = xbase + (size_t)((g2 >> 2) * 128 + (g2 & 3) * 16) * DM;
#pragma unroll
                for (int k = 0; k < 4; ++k) xv[g2 % 3][k] = *(const u32x2*)(xn + (k >> 1) * 128 + (k & 1) * 16); }
            float* yp = ybase + (size_t)(ai * 128 + m * 16) * DM;
#pragma unroll
            for (int k = 0; k < 4; ++k) { const u32x2 x = xv[gi % 3][k];
                const f32x4 xf = (f32x4){__uint_as_float(x.x << 16), __uint_as_float(x.x & 0xffff0000u), __uint_as_float(x.y << 16), __uint_as_float(x.y & 0xffff0000u)};
                *(f32x4*)(yp + (k >> 1) * 128 + (k & 1) * 16) = xf + acc[ai][k >> 1][m][k & 1]; } }
    }
};
struct SplitOrder {
    int G, c;
    DI bool next(int i, pg8::Unit& u) const { const int L = i * G + c; if (L >= 176) return false; const int ks = L % 11, t = L / 11; u.pm = 64 + (t >> 2); u.pn = t & 3; u.kb = ks * 512; u.ks = ks; return true; }
    DI void a_ready(const pg8::Unit&) const {}
    DI void done(const pg8::Unit&) const {}
};
struct SampleOrder3 {
    int c;
    DI bool next(int i, pg8::Unit& u) const { if (i != 0 || c >= 48) return false; u.pm = 64 + c / 12; u.pn = c % 12; u.kb = 0; u.ks = 0; return true; }
    DI void a_ready(const pg8::Unit&) const {}
    DI void done(const pg8::Unit&) const {}
};
struct SplitOrder2 {
    int G, c;
    DI bool next(int i, pg8::Unit& u) const { const int L = i * G + c; if (L >= 64) return false; const int ks = L & 3, t = L >> 2; u.pm = 64 + (t >> 2); u.pn = t & 3; u.kb = ks * 512; u.ks = ks; return true; }
    DI void a_ready(const pg8::Unit&) const {}
    DI void done(const pg8::Unit&) const {}
};
struct EpiX2Split {
    static constexpr bool PERM = false, AFTER_DRAIN = false;
    float* SLAB;
    DI void operator()(const f32x4 (&acc)[2][2][4][2], const pg8::Unit& u, int wr, int wc, int fr, int fq) const {
        const int row0 = u.pm * 256 + wr * 64 + fr, col0 = u.pn * 256 + wc * 32 + 4 * fq;
        float* base = SLAB + (size_t)u.ks * (1024 * 1024) - (size_t)NTOK_P * DM;
#pragma unroll
        for (int ai = 0; ai < 2; ++ai)
#pragma unroll
            for (int m = 0; m < 4; ++m) { float* yp = base + (size_t)(row0 + ai * 128 + m * 16) * DM + col0;
#pragma unroll
                for (int bj = 0; bj < 2; ++bj)
#pragma unroll
                    for (int n = 0; n < 2; ++n) { f32x4* p = (f32x4*)(yp + bj * 128 + n * 16); *p = acc[ai][bj][m][n]; } }
    }
};

DI void p0_transpose_item(const float* W, int ldw, int nblk, int K, bf16_t* WT, int rmul, int radd, const float* ksc, LAS float* scr, int item, int lane) {
    const int kb = item / nblk, nb = item % nblk, k0 = 64 * kb, n0 = 32 * nb;
#pragma unroll
    for (int i = 0; i < 32; ++i) { const int kk = 2 * i + (lane >> 5); scr[kk * 33 + (lane & 31)] = W[(size_t)(k0 + kk) * ldw + n0 + (lane & 31)]; }
    const int c = lane & 7;
    f32x4 sa = (f32x4){1.f, 1.f, 1.f, 1.f}, sb = sa;
    if (ksc) { sa = *(const f32x4*)(ksc + k0 + 8 * c); sb = *(const f32x4*)(ksc + k0 + 8 * c + 4); }
    asm volatile("s_waitcnt lgkmcnt(0)" ::: "memory");
#pragma unroll
    for (int j = 0; j < 4; ++j) { const int n = (lane >> 3) + 8 * j; const LAS float* s = scr + (8 * c) * 33 + n;
        u32x4 o; o.x = pk2(s[0 * 33] * sa.x, s[1 * 33] * sa.y); o.y = pk2(s[2 * 33] * sa.z, s[3 * 33] * sa.w); o.z = pk2(s[4 * 33] * sb.x, s[5 * 33] * sb.y); o.w = pk2(s[6 * 33] * sb.z, s[7 * 33] * sb.w);
        *(u32x4*)(WT + (size_t)((n0 + n) * rmul + radd) * K + k0 + 8 * c) = o; }
    asm volatile("s_waitcnt lgkmcnt(0)" ::: "memory");
}
DI void phase0(const Params& P, LAS unsigned char* lds) {
    const int tid = tid_(), lane = tid & 63, wave = tid >> 6, G = gridDim.x;
    unsigned char* ws = P.ws;
    LAS float* scr = (LAS float*)(lds + wave * 16384);
    const int gw = blockIdx.x * NWAVES + wave, NGW = G * NWAVES;
    constexpr int I_IN = 16 * 96;
    for (int it = gw; it < I_IN + 512; it += NGW) {
        if (it < I_IN) p0_transpose_item(P.in[I_WIN], DIN, 96, DM, (bf16_t*)(ws + WS_WIN), 1, 0, nullptr, scr, it, lane);
        else p0_transpose_item(P.in[I_WOUT], DM, 32, DM, (bf16_t*)(ws + WS_WOUT), 1, 0, nullptr, scr, it - I_IN, lane); }
    for (int s = blockIdx.x * NTHR + tid; s < 8192; s += G * NTHR) {
        const int l = s & 63, f = s >> 6, ks = f & 3, nt = (f >> 2) & 1, hb = (f >> 3) & 7, mat = f >> 6;
        const float* w = (mat ? P.in[I_RWI] : P.in[I_RWA]) + hb * 4096 + (16 * ks + 8 * (l >> 5)) * 64 + 32 * nt + (l & 31);
        u32x4 o; o.x = pk2(w[0], w[64]); o.y = pk2(w[128], w[192]); o.z = pk2(w[256], w[320]); o.w = pk2(w[384], w[448]);
        *(u32x4*)(ws + WS_RGW + (size_t)s * 16) = o;
    }
    __syncthreads();
    LAS float* EXT = (LAS float*)lds;
    for (int i = tid; i < 8192; i += NTHR) { const int k = i >> 3, c = i & 7, l = (k & 255) >> 2, q = k & 3, j = k >> 8;
        EXT[(((j * 4 + q) * 64 + l) << 3) + c] = P.in[I_WIN][(size_t)k * DIN + NPROJ + c]; }
    __syncthreads();
    const float* n1 = P.in[I_NORM1];
    f32x4 nw[4];
#pragma unroll
    for (int j = 0; j < 4; ++j) nw[j] = *(const f32x4*)(n1 + 4 * lane + 256 * j);
    for (int m = gw; m < NTOK; m += NGW) {
        const float* xrow = (m < NTOK_P) ? P.in[I_XP] + (size_t)m * DM : P.in[I_XS] + (size_t)(m - NTOK_P) * DM;
        f32x4 v[4]; float s = 0.f;
#pragma unroll
        for (int j = 0; j < 4; ++j) { v[j] = *(const f32x4*)(xrow + 4 * lane + 256 * j); s += (v[j].x * v[j].x + v[j].y * v[j].y) + (v[j].z * v[j].z + v[j].w * v[j].w); }
        const float rstd = rsqrtf(wave_sum(s) * (1.f / DM) + 1e-6f);
        float e[8];
#pragma unroll
        for (int c = 0; c < 8; ++c) e[c] = 0.f;
        bf16_t* orow = (bf16_t*)(ws + WS_HN) + (size_t)m * DM;
#pragma unroll
        for (int j = 0; j < 4; ++j) { v[j] = v[j] * rstd * nw[j];
            u32x2 w; w.x = pk2(v[j].x, v[j].y); w.y = pk2(v[j].z, v[j].w); *(u32x2*)(orow + 4 * lane + 256 * j) = w;
#pragma unroll
            for (int q = 0; q < 4; ++q) { const LAS f32x4* ep = (const LAS f32x4*)(EXT + (((j * 4 + q) * 64 + lane) << 3)); const f32x4 e0 = ep[0], e1 = ep[1]; const float hv = v[j][q];
                e[0] += hv * e0.x; e[1] += hv * e0.y; e[2] += hv * e0.z; e[3] += hv * e0.w; e[4] += hv * e1.x; e[5] += hv * e1.y; e[6] += hv * e1.z; e[7] += hv * e1.w; } }
        {
            const bool b0 = lane & 1, b1 = lane & 2, b2 = lane & 4;
            float k4[4], k2[2];
#pragma unroll
            for (int q = 0; q < 4; ++q) { const float snd = b0 ? e[q] : e[q + 4]; k4[q] = (b0 ? e[q + 4] : e[q]) + __shfl_xor(snd, 1); }
#pragma unroll
            for (int q = 0; q < 2; ++q) { const float snd = b1 ? k4[q] : k4[q + 2]; k2[q] = (b1 ? k4[q + 2] : k4[q]) + __shfl_xor(snd, 2); }
            const float snd = b2 ? k2[0] : k2[1]; float sv = (b2 ? k2[1] : k2[0]) + __shfl_xor(snd, 4);
            sv += __shfl_xor(sv, 8); sv += __shfl_xor(sv, 16); sv += __shfl_xor(sv, 32);
            const int col = (b0 ? 4 : 0) + (b1 ? 2 : 0) + (b2 ? 1 : 0);
            if (lane < 8) {
                if (col < 4) ((float*)(ws + WS_BETA))[m * 4 + col] = sigm(sv);
                else ((float*)(ws + WS_G))[m * 4 + col - 4] = -__expf(P.in[I_ALOG][col - 4]) * softplus(sv + P.in[I_DTB][col - 4]); } }
    }
}

DI void late_weights(const Params& P, LAS unsigned char* lds, int vb, int nb) {
    const int tid = tid_(), lane = tid & 63, wave = tid >> 6;
    unsigned char* ws = P.ws;
    LAS float* scr = (LAS float*)(lds + wave * 16384);
    constexpr int I_G = 16 * 88, I_D = 44 * 32, NIT = 2 * I_G + I_D;
    for (int it = vb * NWAVES + wave; it < NIT; it += nb * NWAVES) {
        int r = it;
        if (r < I_G) { p0_transpose_item(P.in[I_WG], DFF, 88, DM, (bf16_t*)(ws + WS_WGU), 2, 0, P.in[I_NORM2], scr, r, lane); continue; } r -= I_G;
        if (r < I_G) { p0_transpose_item(P.in[I_WU], DFF, 88, DM, (bf16_t*)(ws + WS_WGU), 2, 1, P.in[I_NORM2], scr, r, lane); continue; } r -= I_G;
        p0_transpose_item(P.in[I_WD], DM, 32, DFF, (bf16_t*)(ws + WS_WDN), 1, 0, nullptr, scr, r, lane);
    }
}

DI void gdn_chunk_item(const Params& P, LAS unsigned char* lds, int item) {
    const int tid = tid_(), lane = tid & 63, wave = tid >> 6;
    const int h = item & 3, bn = item >> 2, b = bn >> 5, n = bn & 31;
    const int m0 = b * 2048 + n * 64, cid = (b * 4 + h) * 32 + n;
    unsigned char* ws = P.ws;
    LAS float* QT = (LAS float*)lds; LAS float* KT = QT + 64 * 132; LAS float* VT = KT + 64 * 132;
    LAS float* LM = VT + 64 * 132; LAS float* QKM = LM + 64 * 68; LAS float* SM = QKM + 64 * 68;
    const bf16_t* PROJ = (const bf16_t*)(ws + WS_PROJ);
    if (tid < 384) {
        const int cg8 = tid % 48, tg = tid / 48, mat = cg8 >> 4, d0 = (cg8 & 15) * 8, ch = mat * 512 + h * 128 + d0;
        const bf16_t* src = PROJ + (size_t)(m0 + 8 * tg) * NPROJ + 1024 + ch;
        u32x4 raw[11];
        const bool hist = (n > 0 || tg > 0);
#pragma unroll
        for (int q = 0; q < 11; ++q) { if (q >= 3 || hist) raw[q] = *(const u32x4*)(src + (q - 3) * NPROJ); else raw[q] = (u32x4){0u, 0u, 0u, 0u}; }
        const float* cw = P.in[I_GCW] + ch;
        f32x4 wv[4][2];
#pragma unroll
        for (int j = 0; j < 4; ++j) { wv[j][0] = *(const f32x4*)(cw + j * 1536); wv[j][1] = *(const f32x4*)(cw + j * 1536 + 4); }
        LAS float* T = QT + mat * (64 * 132);
#pragma unroll
        for (int i = 0; i < 8; ++i) {
            f32x4 y0 = (f32x4){0.f, 0.f, 0.f, 0.f}, y1 = y0;
#pragma unroll
            for (int j = 0; j < 4; ++j) { const u32x4 x = raw[i + j];
                const f32x4 xa = (f32x4){__uint_as_float(x.x << 16), __uint_as_float(x.x & 0xffff0000u), __uint_as_float(x.y << 16), __uint_as_float(x.y & 0xffff0000u)};
                const f32x4 xb = (f32x4){__uint_as_float(x.z << 16), __uint_as_float(x.z & 0xffff0000u), __uint_as_float(x.w << 16), __uint_as_float(x.w & 0xffff0000u)};
                y0 += wv[j][0] * xa; y1 += wv[j][1] * xb; }
            f32x4 s0, s1;
#pragma unroll
            for (int e = 0; e < 4; ++e) { s0[e] = silu(y0[e]); s1[e] = silu(y1[e]); }
            *(LAS f32x4*)(T + (8 * tg + i) * 132 + d0) = s0; *(LAS f32x4*)(T + (8 * tg + i) * 132 + d0 + 4) = s1;
            if (n == 31 && tg == 7 && i >= 5) { const u32x4 x = raw[i + 3]; float* op = P.out + OUT_PGC + (size_t)(b * 3 + (i - 5)) * 1536 + ch;
                *(f32x4*)op = (f32x4){__uint_as_float(x.x << 16), __uint_as_float(x.x & 0xffff0000u), __uint_as_float(x.y << 16), __uint_as_float(x.y & 0xffff0000u)};
                *(f32x4*)(op + 4) = (f32x4){__uint_as_float(x.z << 16), __uint_as_float(x.z & 0xffff0000u), __uint_as_float(x.w << 16), __uint_as_float(x.w & 0xffff0000u)}; }
        }
    }
    if (tid < 64) {
        SM[128 + tid] = ((const float*)(ws + WS_BETA))[(m0 + tid) * 4 + h];
        float g = ((const float*)(ws + WS_G))[(m0 + tid) * 4 + h];
#pragma unroll
        for (int o = 1; o < 64; o <<= 1) { const float t = __shfl_up(g, o); if (lane >= o) g += t; }
        SM[tid] = g; SM[64 + tid] = __expf(g);
    }
    __syncthreads();
#pragma unroll 1
    for (int k = 0; k < 8; ++k) {
        const int i = 8 * wave + k;
        const float q0 = QT[i * 132 + lane], q1 = QT[i * 132 + 64 + lane], k0 = KT[i * 132 + lane], k1 = KT[i * 132 + 64 + lane];
        const float rq = rsqrtf(wave_sum(q0 * q0 + q1 * q1) + 1e-6f) * 0.08838834764831845f, rk = rsqrtf(wave_sum(k0 * k0 + k1 * k1) + 1e-6f);
        QT[i * 132 + lane] = q0 * rq; QT[i * 132 + 64 + lane] = q1 * rq; KT[i * 132 + lane] = k0 * rk; KT[i * 132 + 64 + lane] = k1 * rk;
    }
    __syncthreads();
    {
        const int which = wave >> 2, it = (wave >> 1) & 1, jt = wave & 1, r = lane & 31, hh = lane >> 5;
        LAS float* dst = which ? QKM : LM;
        f32x16 acc = zero16();
        if (!(it == 0 && jt == 1)) {
            const LAS float* Ar = (which ? QT : KT) + (32 * it + r) * 132 + 8 * hh;
            const LAS float* Br = KT + (32 * jt + r) * 132 + 8 * hh;
#pragma unroll
            for (int ks = 0; ks < 8; ++ks) {
                const bf16x8 a = pack8(*(const LAS f32x4*)(Ar + 16 * ks), *(const LAS f32x4*)(Ar + 16 * ks + 4));
                const bf16x8 bb = pack8(*(const LAS f32x4*)(Br + 16 * ks), *(const LAS f32x4*)(Br + 16 * ks + 4));
                acc = MFMA32(a, bb, acc);
            }
        }
        const int j = 32 * jt + r; const float gcj = SM[j];
#pragma unroll
        for (int reg = 0; reg < 16; ++reg) {
            const int i = 32 * it + crow(reg, hh); const float gci = SM[i];
            float v = 0.f;
            if (which == 0) { if (j < i) v = acc[reg] * SM[128 + i] * __expf(gci - gcj); }
            else { if (j <= i) v = acc[reg] * __expf(gci - gcj); }
            dst[i * 68 + j] = v;
        }
    }
    __syncthreads();
    {
        const float gcl = SM[63];
        bf16_t* QDF = (bf16_t*)(ws + WS_QDF) + (size_t)cid * 8192; bf16_t* KTF = (bf16_t*)(ws + WS_KTF) + (size_t)cid * 8192; bf16_t* QKF = (bf16_t*)(ws + WS_QKF) + (size_t)cid * 4096;
#pragma unroll 1
        for (int s = tid; s < 2560; s += NTHR) {
            const int l = s & 63, r = l & 31, hh = l >> 5, f = s >> 6;
            float v[8];
            if (f < 16) { const int mt = f >> 3, kk = f & 7, c = 32 * mt + r, db = 16 * kk + 4 * hh; const float sc = SM[64 + c];
#pragma unroll
                for (int e = 0; e < 8; ++e) v[e] = QT[c * 132 + db + 8 * (e >> 2) + (e & 3)] * sc;
                *(bf16x8*)(QDF + f * 512 + l * 8) = pack8v(v);
            } else if (f < 32) { const int f2 = f - 16, dmt = f2 >> 2, ks = f2 & 3, d = 32 * dmt + r, cb = 16 * ks + 4 * hh;
#pragma unroll
                for (int e = 0; e < 8; ++e) { const int c = cb + 8 * (e >> 2) + (e & 3); v[e] = KT[c * 132 + d] * __expf(gcl - SM[c]); }
                *(bf16x8*)(KTF + f2 * 512 + l * 8) = pack8v(v);
            } else { const int f3 = f - 32, mt = f3 >> 2, ks = f3 & 3, i = 32 * mt + r, cb = 16 * ks + 4 * hh;
#pragma unroll
                for (int e = 0; e < 8; ++e) v[e] = QKM[i * 68 + cb + 8 * (e >> 2) + (e & 3)];
                *(bf16x8*)(QKF + f3 * 512 + l * 8) = pack8v(v);
            }
        }
        if (tid == 0) ((float*)(ws + WS_GL))[cid] = __expf(gcl);
    }
    __syncthreads();
    LAS float* TM = QKM;
    {   const int r = lane & 31, hh = lane >> 5;
        if (wave < 2 && lane < 32) {
            const LAS float* Lb = vlaunder((const LAS float*)(LM + (32 * wave) * 68 + 32 * wave));
            float x[32];
#pragma unroll
            for (int i = 0; i < 32; ++i) x[i] = (i == lane) ? 1.f : 0.f;
#pragma unroll
            for (int ip = 1; ip < 32; ip += 2) {
                f32x4 la[8], lb[8];
#pragma unroll
                for (int j4 = 0; j4 < (ip + 3) / 4; ++j4) la[j4] = *(const LAS f32x4*)(Lb + ip * 68 + 4 * j4);
                if (ip + 1 < 32) {
#pragma unroll
                    for (int j4 = 0; j4 < (ip + 4) / 4; ++j4) lb[j4] = *(const LAS f32x4*)(Lb + (ip + 1) * 68 + 4 * j4); }
                {   const int i = ip; float a0 = 0.f, a1 = 0.f, a2 = 0.f, a3 = 0.f;
#pragma unroll
                    for (int j4 = 0; j4 < (i + 3) / 4; ++j4) { const f32x4 l4 = la[j4];
                        if (4 * j4 + 0 < i) a0 += l4.x * x[4 * j4 + 0]; if (4 * j4 + 1 < i) a1 += l4.y * x[4 * j4 + 1];
                        if (4 * j4 + 2 < i) a2 += l4.z * x[4 * j4 + 2]; if (4 * j4 + 3 < i) a3 += l4.w * x[4 * j4 + 3]; }
                    x[i] -= (a0 + a1) + (a2 + a3); }
                if (ip + 1 < 32) { const int i = ip + 1; float a0 = 0.f, a1 = 0.f, a2 = 0.f, a3 = 0.f;
#pragma unroll
                    for (int j4 = 0; j4 < (i + 3) / 4; ++j4) { const f32x4 l4 = lb[j4];
                        if (4 * j4 + 0 < i) a0 += l4.x * x[4 * j4 + 0]; if (4 * j4 + 1 < i) a1 += l4.y * x[4 * j4 + 1];
                        if (4 * j4 + 2 < i) a2 += l4.z * x[4 * j4 + 2]; if (4 * j4 + 3 < i) a3 += l4.w * x[4 * j4 + 3]; }
                    x[i] -= (a0 + a1) + (a2 + a3); }
                asm volatile("" ::: "memory"); __builtin_amdgcn_sched_barrier(0);
            }
            LAS float* Tb = vlaunder(TM + (32 * wave) * 68 + 32 * wave + lane);
#pragma unroll
            for (int i = 0; i < 32; ++i) Tb[i * 68] = x[i];
        } else if (wave == 2) {
#pragma unroll
            for (int q = 0; q < 16; ++q) { const int idx = q * 64 + lane; TM[(idx >> 5) * 68 + 32 + (idx & 31)] = 0.f; }
        }
        __syncthreads();
        if (wave == 0) {
            f32x16 M = zero16();
#pragma unroll
            for (int ks = 0; ks < 2; ++ks) { const LAS float* ap = LM + (32 + r) * 68 + 16 * ks + 8 * hh; float bv[8];
#pragma unroll
                for (int e = 0; e < 8; ++e) bv[e] = TM[(16 * ks + 8 * hh + e) * 68 + r];
                M = MFMA32(pack8(*(const LAS f32x4*)ap, *(const LAS f32x4*)(ap + 4)), pack8v(bv), M); }
            f32x16 T2 = zero16();
#pragma unroll
            for (int sx = 0; sx < 2; ++sx) { const LAS float* ap = TM + (32 + r) * 68 + 32 + 16 * sx + 4 * hh;
                T2 = MFMA32(pack8(*(const LAS f32x4*)ap, *(const LAS f32x4*)(ap + 8)), pack_step(M, sx), T2); }
#pragma unroll
            for (int reg = 0; reg < 16; ++reg) TM[(32 + crow(reg, hh)) * 68 + r] = -T2[reg];
        }
        __syncthreads();
        {
            bf16_t* WF = (bf16_t*)(ws + WS_WF) + (size_t)cid * 8192; bf16_t* UB = (bf16_t*)(ws + WS_UB) + (size_t)cid * 8192;
            const int dt = wave >> 1, ct = wave & 1, mt = wave >> 2, es = wave & 3;
            f32x16 aw = zero16(), au = zero16();
#pragma unroll
            for (int ks = 0; ks < 4; ++ks) {
                float av[8], bv[8];
#pragma unroll
                for (int e = 0; e < 8; ++e) { const int j = 16 * ks + 8 * hh + e; const float bj = SM[128 + j]; av[e] = KT[j * 132 + 32 * dt + r] * bj * SM[64 + j]; bv[e] = VT[j * 132 + 32 * es + r] * bj; }
                const LAS float* tw = TM + (32 * ct + r) * 68 + 16 * ks + 8 * hh; const LAS float* tu = TM + (32 * mt + r) * 68 + 16 * ks + 8 * hh;
                aw = MFMA32(pack8v(av), pack8(*(const LAS f32x4*)tw, *(const LAS f32x4*)(tw + 4)), aw);
                au = MFMA32(pack8(*(const LAS f32x4*)tu, *(const LAS f32x4*)(tu + 4)), pack8v(bv), au);
            }
            aw = aw * -1.f;
#pragma unroll
            for (int sx = 0; sx < 2; ++sx) *(bf16x8*)(WF + (ct * 8 + 2 * dt + sx) * 512 + lane * 8) = pack_step(aw, sx);
#pragma unroll
            for (int sx = 0; sx < 2; ++sx) *(bf16x8*)(UB + ((es * 2 + mt) * 64 + lane) * 16 + 8 * sx) = pack_step(au, sx);
        }
    }
    __syncthreads();
}

DI void rg_tile_item(const Params& P, LAS unsigned char* lds, int T) {
    const int tid = tid_(), lane = tid & 63, wave = tid >> 6, r = lane & 31, hh = lane >> 5;
    unsigned char* ws = P.ws;
    LAS bf16_t* XC = (LAS bf16_t*)lds + wave * (64 * 72);
    const bf16_t* PROJ = (const bf16_t*)(ws + WS_PROJ);
    const int m0 = 64 * T; const bool prm = T < 256; const int sq0 = prm ? 0 : (m0 - NTOK_P) / 8;
    {
        const int c = 64 * wave + lane;
        const float* cw = P.in[I_RCW]; const float w0 = cw[c], w1 = cw[512 + c], w2 = cw[1024 + c], w3 = cw[1536 + c], cb = P.in[I_RCB][c];
        const bf16_t* src = PROJ + (size_t)m0 * NPROJ + c;
        float x3 = 0.f, x2 = 0.f, x1 = 0.f;
        if (prm && (T & 31) != 0) { x3 = bf2f(src[-3 * NPROJ]); x2 = bf2f(src[-2 * NPROJ]); x1 = bf2f(src[-NPROJ]); }
        const float* rcs = P.in[I_SRC];
        float xr[64];
#pragma unroll
        for (int i = 0; i < 64; ++i) xr[i] = bf2f(src[i * NPROJ]);
#pragma unroll
        for (int i = 0; i < 64; ++i) {
            const int seq = sq0 + (i >> 3);
            if (!prm && (i & 7) == 0) { x3 = rcs[(size_t)(seq * 3 + 0) * 512 + c]; x2 = rcs[(size_t)(seq * 3 + 1) * 512 + c]; x1 = rcs[(size_t)(seq * 3 + 2) * 512 + c]; }
            const float x0 = xr[i];
            XC[i * 72 + lane] = (bf16_t)f2bf(w0 * x3 + w1 * x2 + w2 * x1 + w3 * x0 + cb);
            if (prm) { if ((T & 31) == 31 && i >= 61) P.out[OUT_PRC + (size_t)((T >> 5) * 3 + (i - 61)) * 512 + c] = x0; }
            else { if ((i & 7) >= 5) P.out[OUT_SRC + (size_t)(seq * 3 + (i & 7) - 5) * 512 + c] = x0; }
            x3 = x2; x2 = x1; x1 = x0;
        }
    }
    asm volatile("s_waitcnt lgkmcnt(0)" ::: "memory");
    const bf16x8* RGW = (const bf16x8*)(ws + WS_RGW);
#pragma unroll 1
    for (int nt = 0; nt < 2; ++nt) {
        f32x16 aa[2], ai[2]; aa[0] = zero16(); aa[1] = zero16(); ai[0] = zero16(); ai[1] = zero16();
#pragma unroll
        for (int ks = 0; ks < 4; ++ks) {
            const bf16x8 bfa = RGW[(((0 * 8 + wave) * 2 + nt) * 4 + ks) * 64 + lane], bfi = RGW[(((1 * 8 + wave) * 2 + nt) * 4 + ks) * 64 + lane];
#pragma unroll
            for (int mt = 0; mt < 2; ++mt) { const bf16x8 a = *(const LAS bf16x8*)(XC + (32 * mt + r) * 72 + 16 * ks + 8 * hh);
                aa[mt] = MFMA32(a, bfa, aa[mt]); ai[mt] = MFMA32(a, bfi, ai[mt]); }
        }
        const int j = 64 * wave + 32 * nt + r;
        const float ba = P.in[I_RBA][j], bi = P.in[I_RBI][j], spl = -8.f * softplus(-P.in[I_LAM][j]);
        float Cc = 0.f, Pp = 1.f;
        const bf16_t* projb = PROJ + (size_t)(m0 + 4 * hh) * NPROJ + 512 + j;
        bf16_t yv[32];
#pragma unroll
        for (int q = 0; q < 32; ++q) yv[q] = projb[(size_t)(32 * (q >> 4) + 8 * ((q >> 2) & 3) + (q & 3)) * NPROJ];
        bf16_t* mixb = (bf16_t*)(ws + WS_MIX) + (size_t)(m0 + 4 * hh) * DM + j;
        bf16_t* gab = (bf16_t*)(ws + WS_GA) + (size_t)(m0 + 4 * hh) * 512 + j;
#pragma unroll
        for (int Gi = 0; Gi < 8; ++Gi) {
            const int mt = Gi >> 2, g = Gi & 3;
            bf16_t* mb = vlaunder(mixb); bf16_t* gb = vlaunder(gab);
            float Hl[4], Ac[4];
#pragma unroll
            for (int k = 0; k < 4; ++k) { const int reg = 4 * g + k, t = 32 * mt + 8 * g + 4 * hh + k;
                const float rg_ = sigm(aa[mt][reg] + ba), ig = sigm(ai[mt][reg] + bi), la = spl * rg_, a = __expf(la), mult = __builtin_amdgcn_sqrtf(one_minus_exp(2.f * la, a * a));
                const float u = mult * ig * bf2f(XC[t * 72 + 32 * nt + r]);
                if (k == 0) { Hl[0] = u; Ac[0] = a; } else { Hl[k] = a * Hl[k - 1] + u; Ac[k] = a * Ac[k - 1]; } }
            const float Ag = Ac[3], Hg = Hl[3], pA = __shfl_xor(Ag, 32), pH = __shfl_xor(Hg, 32);
            const int seq = sq0 + Gi;
            if (!prm) { Cc = P.in[I_SRH][(size_t)seq * 512 + j]; Pp = 1.f; }
            float cin, pin, Cn, Pn;
            if (hh == 0) { cin = Cc; pin = Pp; Cn = pA * (Ag * Cc + Hg) + pH; Pn = Pp * Ag * pA; }
            else { cin = pA * Cc + pH; pin = Pp * pA; Cn = Ag * cin + Hg; Pn = Pp * pA * Ag; }
#pragma unroll
            for (int k = 0; k < 4; ++k) { const int tt = 32 * mt + 8 * g + k;
                const float hv = Hl[k] + Ac[k] * cin, gy = gelu_tanh(bf2f(yv[4 * Gi + k]));
                mb[(size_t)tt * DM] = (bf16_t)f2bf(gy * hv);
                if (prm) gb[(size_t)tt * 512] = (bf16_t)f2bf(gy * Ac[k] * pin);
                else if (hh == 1 && k == 3) P.out[OUT_SRH + (size_t)seq * 512 + j] = hv; }
            Cc = Cn; Pp = Pn;
            asm volatile("" ::: "memory"); __builtin_amdgcn_sched_barrier(0);
        }
        if (prm && hh == 0) { ((float*)(ws + WS_SEGA))[T * 512 + j] = Pp; ((float*)(ws + WS_SEGH))[T * 512 + j] = Cc; }
    }
    asm volatile("s_waitcnt lgkmcnt(0)" ::: "memory");
}

constexpr int SEQ_BUF = 49152;
DI void seq_step(f32x16 (&S)[4], const LAS unsigned char* bw, bf16_t* SNB, bf16_t* VNB, int cid, int es, int lane, float gl) {
    bf16x8 Sb[8];
#pragma unroll
    for (int dt = 0; dt < 4; ++dt) { Sb[2 * dt] = pack_step(S[dt], 0); Sb[2 * dt + 1] = pack_step(S[dt], 1); }
#pragma unroll
    for (int kk = 0; kk < 8; ++kk) *(bf16x8*)(SNB + (size_t)cid * 16384 + (es * 8 + kk) * 512 + lane * 8) = Sb[kk];
    f32x16 vacc[2];
#pragma unroll
    for (int mt = 0; mt < 2; ++mt) { const LAS u32x4* up = (const LAS u32x4*)(bw + 32768 + ((es * 2 + mt) * 64 + lane) * 32); const u32x4 u0 = up[0], u1 = up[1];
#pragma unroll
        for (int i = 0; i < 4; ++i) { vacc[mt][2 * i] = __uint_as_float(u0[i] << 16); vacc[mt][2 * i + 1] = __uint_as_float(u0[i] & 0xffff0000u);
            vacc[mt][8 + 2 * i] = __uint_as_float(u1[i] << 16); vacc[mt][8 + 2 * i + 1] = __uint_as_float(u1[i] & 0xffff0000u); } }
#pragma unroll
    for (int mt = 0; mt < 2; ++mt)
#pragma unroll
        for (int kk = 0; kk < 8; ++kk) vacc[mt] = MFMA32(*(const LAS bf16x8*)(bw + ((mt * 8 + kk) * 64 + lane) * 16), Sb[kk], vacc[mt]);
    bf16x8 vb[4];
#pragma unroll
    for (int ct = 0; ct < 2; ++ct) { vb[2 * ct] = pack_step(vacc[ct], 0); vb[2 * ct + 1] = pack_step(vacc[ct], 1); }
#pragma unroll
    for (int ks = 0; ks < 4; ++ks) *(bf16x8*)(VNB + (size_t)cid * 8192 + (es * 4 + ks) * 512 + lane * 8) = vb[ks];
#pragma unroll
    for (int dt = 0; dt < 4; ++dt) { S[dt] = S[dt] * gl;
#pragma unroll
        for (int ks = 0; ks < 4; ++ks) S[dt] = MFMA32(*(const LAS bf16x8*)(bw + 16384 + ((dt * 4 + ks) * 64 + lane) * 16), vb[ks], S[dt]); }
}
DI void gdn_seq_block(const Params& P, LAS unsigned char* lds, int bh) {
    const int tid = tid_(), lane = tid & 63, wave = __builtin_amdgcn_readfirstlane(tid >> 6), r = lane & 31, hh = lane >> 5;
    unsigned char* ws = P.ws;
    const unsigned char* gW = ws + WS_WF + (size_t)bh * 32 * 16384; const unsigned char* gK = ws + WS_KTF + (size_t)bh * 32 * 16384; const unsigned char* gU = ws + WS_UB + (size_t)bh * 32 * 16384;
    bf16_t* SNB = (bf16_t*)P.out; bf16_t* VNB = (bf16_t*)((unsigned char*)P.out + 32 * MiB);
    const float glv = (lane < 32) ? ((const float*)(ws + WS_GL))[bh * 32 + lane] : 0.f;
    f32x16 S[4]; S[0] = zero16(); S[1] = zero16(); S[2] = zero16(); S[3] = zero16();
    const int es = wave & 3, lt = tid - 256;
#define SEQ_STAGE(nn, bb) do { _Pragma("unroll") for (int q = 0; q < 12; ++q) { const unsigned char* g_ = (q < 4 ? gW : q < 8 ? gK : gU) + (size_t)(nn) * 16384 + ((q & 3) * 256 + lt) * 16; \
        __builtin_amdgcn_global_load_lds((const unsigned*)g_, (LAS unsigned*)(lds + (bb) * SEQ_BUF + (q >> 2) * 16384 + (q & 3) * 4096 + (wave - 4) * 1024), 16, 0, 0); } } while (0)
    if (wave >= 4) {
        SEQ_STAGE(0, 0); SEQ_STAGE(1, 1); asm volatile("s_waitcnt vmcnt(12)" ::: "memory");
        __builtin_amdgcn_s_barrier(); asm volatile("" ::: "memory");
        int bn = 2;
#pragma unroll 1
        for (int n = 0; n < 32; ++n) {
            const int ns = (n + 2 < 32) ? n + 2 : 31; SEQ_STAGE(ns, bn); asm volatile("s_waitcnt vmcnt(12)" ::: "memory");
            __builtin_amdgcn_s_barrier(); asm volatile("" ::: "memory");
            bn = (bn == 2) ? 0 : bn + 1;
        }
        asm volatile("s_waitcnt vmcnt(0)" ::: "memory");
    } else {
        __builtin_amdgcn_s_barrier(); asm volatile("" ::: "memory");
        int bc = 0;
#pragma unroll 1
        for (int n = 0; n < 32; ++n) {
            seq_step(S, lds + bc * SEQ_BUF, SNB, VNB, bh * 32 + n, es, lane, __shfl(glv, n));
            asm volatile("s_waitcnt lgkmcnt(0)" ::: "memory"); __builtin_amdgcn_s_barrier(); asm volatile("" ::: "memory");
            bc = (bc == 2) ? 0 : bc + 1;
        }
    }
    __syncthreads();
#undef SEQ_STAGE
    if (wave < 4) {
        const int e0 = 32 * es;
#pragma unroll
        for (int dt = 0; dt < 4; ++dt)
#pragma unroll
            for (int reg = 0; reg < 16; ++reg) P.out[OUT_PGS + ((size_t)bh * 128 + 32 * dt + crow(reg, hh)) * 128 + e0 + r] = S[dt][reg];
    }
}

DI void gdn_out_item(const Params& P, LAS unsigned char* lds, int cid) {
    const int tid = tid_(), lane = tid & 63, wave = tid >> 6, r = lane & 31, hh = lane >> 5;
    unsigned char* ws = P.ws;
    const int bh = cid >> 5, n = cid & 31, b = bh >> 2, h = bh & 3, mt = wave >> 2, es = wave & 3;
    const bf16_t* SNB = (const bf16_t*)P.out; const bf16_t* VNB = (const bf16_t*)((const unsigned char*)P.out + 32 * MiB);
    const bf16_t* PROJ = (const bf16_t*)(ws + WS_PROJ);
    LAS float* OB = (LAS float*)lds;
    bf16x8 a1[8], b1[8], a2[4], b2[4];
#pragma unroll
    for (int kk = 0; kk < 8; ++kk) { a1[kk] = *(const bf16x8*)((const bf16_t*)(ws + WS_QDF) + (size_t)cid * 8192 + (mt * 8 + kk) * 512 + lane * 8); b1[kk] = *(const bf16x8*)(SNB + (size_t)cid * 16384 + (es * 8 + kk) * 512 + lane * 8); }
#pragma unroll
    for (int ks = 0; ks < 4; ++ks) { a2[ks] = *(const bf16x8*)((const bf16_t*)(ws + WS_QKF) + (size_t)cid * 4096 + (mt * 4 + ks) * 512 + lane * 8); b2[ks] = *(const bf16x8*)(VNB + (size_t)cid * 8192 + (es * 4 + ks) * 512 + lane * 8); }
    const size_t mb = (size_t)b * 2048 + 64 * n + 8 * wave;
    bf16_t zr[8][2];
#pragma unroll
    for (int k = 0; k < 8; ++k) { zr[k][0] = PROJ[(mb + k) * NPROJ + 2560 + 128 * h + lane]; zr[k][1] = PROJ[(mb + k) * NPROJ + 2560 + 128 * h + 64 + lane]; }
    f32x16 oacc = zero16();
#pragma unroll
    for (int kk = 0; kk < 8; ++kk) oacc = MFMA32(a1[kk], b1[kk], oacc);
#pragma unroll
    for (int ks = 0; ks < 4; ++ks) oacc = MFMA32(a2[ks], b2[ks], oacc);
#pragma unroll
    for (int reg = 0; reg < 16; ++reg) OB[(32 * mt + crow(reg, hh)) * 132 + 32 * es + r] = oacc[reg];
    __syncthreads();
    const float gw0 = P.in[I_GNW][lane], gw1 = P.in[I_GNW][lane + 64];
#pragma unroll
    for (int k = 0; k < 8; ++k) { const int c = 8 * wave + k;
        const float o0 = OB[c * 132 + lane], o1 = OB[c * 132 + 64 + lane];
        const float rstd = rsqrtf(wave_sum(o0 * o0 + o1 * o1) * (1.f / 128.f) + 1e-6f);
        bf16_t* mp = (bf16_t*)(ws + WS_MIX) + (mb + k) * DM + 512 + 128 * h;
        mp[lane] = (bf16_t)f2bf(o0 * rstd * gw0 * silu(bf2f(zr[k][0]))); mp[lane + 64] = (bf16_t)f2bf(o1 * rstd * gw1 * silu(bf2f(zr[k][1]))); }
    __syncthreads();
}

DI void gdn_sample_item(const Params& P, LAS unsigned char* lds, int s, int h) {
    const int tid = tid_(), lane = tid & 63, wave = tid >> 6;
    unsigned char* ws = P.ws;
    LAS float* Q = (LAS float*)lds; LAS float* K = Q + 1024; LAS float* V = K + 1024; LAS float* Uu = V + 1024; LAS float* Ww = Uu + 1024; LAS float* Oo = Ww + 1024;
    LAS float* RED = Oo + 1024;
    LAS float* SMs = RED + 8192;
    const bf16_t* PROJ = (const bf16_t*)(ws + WS_PROJ);
    const int m0 = NTOK_P + 8 * s;
    float Sr[32];
    {   const float* S0 = P.in[I_SGS] + ((size_t)(s * 4 + h) * 128 + 32 * (tid >> 7)) * 128 + (tid & 127);
#pragma unroll
        for (int k = 0; k < 32; ++k) Sr[k] = S0[(size_t)k * 128]; }
    const bf16_t zq0 = PROJ[(size_t)(m0 + wave) * NPROJ + 2560 + 128 * h + lane], zq1 = PROJ[(size_t)(m0 + wave) * NPROJ + 2560 + 128 * h + 64 + lane];
    const float gq = ((const float*)(ws + WS_G))[(m0 + (lane & 7)) * 4 + h], bq = ((const float*)(ws + WS_BETA))[(m0 + (lane & 7)) * 4 + h];
    const float gnw0 = P.in[I_GNW][lane], gnw1 = P.in[I_GNW][lane + 64];
    if (tid < 384) {
        const int mat = tid >> 7, d = tid & 127, ch = mat * 512 + h * 128 + d;
        const float* cw = P.in[I_GCW]; const float w0 = cw[ch], w1 = cw[1536 + ch], w2 = cw[3072 + ch], w3 = cw[4608 + ch];
        const float* st = P.in[I_SGC] + (size_t)s * 3 * 1536 + ch;
        float x3 = st[0], x2 = st[1536], x1 = st[3072];
        LAS float* T = Q + mat * 1024;
#pragma unroll
        for (int t = 0; t < 8; ++t) { const float x0 = bf2f(PROJ[(size_t)(m0 + t) * NPROJ + 1024 + ch]);
            T[t * 128 + d] = silu(w0 * x3 + w1 * x2 + w2 * x1 + w3 * x0);
            if (t >= 5) P.out[OUT_SGC + (size_t)(s * 3 + t - 5) * 1536 + ch] = x0;
            x3 = x2; x2 = x1; x1 = x0; }
    }
    if (tid >= 448) {
        const int t = lane & 7;
        float g = gq; const float bt = bq;
#pragma unroll
        for (int o = 1; o < 8; o <<= 1) { const float v = __shfl_up(g, o); if (t >= o) g += v; }
        const float tot = __shfl(g, 7);
        if (lane < 8) { SMs[t] = g; SMs[8 + t] = __expf(g); SMs[16 + t] = bt; SMs[24 + t] = __expf(tot - g); } }
    __syncthreads();
    {   const int i = wave;
        const float q0 = Q[i * 128 + lane], q1 = Q[i * 128 + 64 + lane], k0 = K[i * 128 + lane], k1 = K[i * 128 + 64 + lane];
        const float rq = rsqrtf(wave_sum(q0 * q0 + q1 * q1) + 1e-6f) * 0.08838834764831845f, rk = rsqrtf(wave_sum(k0 * k0 + k1 * k1) + 1e-6f);
        Q[i * 128 + lane] = q0 * rq; Q[i * 128 + 64 + lane] = q1 * rq; K[i * 128 + lane] = k0 * rk; K[i * 128 + 64 + lane] = k1 * rk; }
    __syncthreads();
    if (tid < 128) { const int which = tid >> 6, i = (tid >> 3) & 7, j = tid & 7;
        const LAS float* a = (which ? Q : K) + i * 128; const LAS float* bq = K + j * 128; float dot = 0.f;
        for (int d = 0; d < 128; ++d) dot += a[d] * bq[d];
        const float dec = __expf(SMs[i] - SMs[j]);
        if (which == 0) SMs[32 + i * 8 + j] = (j < i) ? dot * SMs[16 + i] * dec : 0.f;
        else SMs[96 + i * 8 + j] = (j <= i) ? dot * dec : 0.f; }
    __syncthreads();
    if (tid < 256) { const bool isw = tid >= 128; const int ci = tid & 127; float x[8];
#pragma unroll
        for (int i = 0; i < 8; ++i) { float acc = (isw ? K : V)[i * 128 + ci] * SMs[16 + i]; if (isw) acc *= SMs[8 + i];
#pragma unroll
            for (int j = 0; j < 8; ++j) if (j < i) acc -= SMs[32 + i * 8 + j] * x[j];
            x[i] = acc; (isw ? Ww : Uu)[i * 128 + ci] = acc; } }
    __syncthreads();
    {   const int e = tid & 127, dq = tid >> 7;
        float pv[8], po[8];
#pragma unroll
        for (int c = 0; c < 8; ++c) { pv[c] = 0.f; po[c] = 0.f; }
#pragma unroll
        for (int k4 = 0; k4 < 8; ++k4) { const int d = 32 * dq + 4 * k4;
#pragma unroll
            for (int c = 0; c < 8; ++c) { const f32x4 w4 = *(const LAS f32x4*)(Ww + c * 128 + d), q4 = *(const LAS f32x4*)(Q + c * 128 + d);
                pv[c] += (w4.x * Sr[4 * k4] + w4.y * Sr[4 * k4 + 1]) + (w4.z * Sr[4 * k4 + 2] + w4.w * Sr[4 * k4 + 3]);
                po[c] += (q4.x * Sr[4 * k4] + q4.y * Sr[4 * k4 + 1]) + (q4.z * Sr[4 * k4 + 2] + q4.w * Sr[4 * k4 + 3]); } }
#pragma unroll
        for (int c = 0; c < 8; ++c) { RED[(dq * 16 + c) * 128 + e] = pv[c]; RED[(dq * 16 + 8 + c) * 128 + e] = po[c] * SMs[8 + c]; }
        __syncthreads();
        float vn[8];
#pragma unroll
        for (int c = 0; c < 8; ++c) vn[c] = Uu[c * 128 + e] - ((RED[(0 * 16 + c) * 128 + e] + RED[(1 * 16 + c) * 128 + e]) + (RED[(2 * 16 + c) * 128 + e] + RED[(3 * 16 + c) * 128 + e]));
        const float gl = SMs[15];
        float* So = P.out + OUT_SGS + ((size_t)(s * 4 + h) * 128 + 32 * dq) * 128 + e;
        float kv[8];
#pragma unroll
        for (int c = 0; c < 8; ++c) kv[c] = SMs[24 + c] * vn[c];
#pragma unroll
        for (int k4 = 0; k4 < 8; ++k4) { const int d = 32 * dq + 4 * k4; f32x4 acc = (f32x4){Sr[4 * k4] * gl, Sr[4 * k4 + 1] * gl, Sr[4 * k4 + 2] * gl, Sr[4 * k4 + 3] * gl};
#pragma unroll
            for (int c = 0; c < 8; ++c) acc += *(const LAS f32x4*)(K + c * 128 + d) * kv[c];
            So[(size_t)(4 * k4) * 128] = acc.x; So[(size_t)(4 * k4 + 1) * 128] = acc.y; So[(size_t)(4 * k4 + 2) * 128] = acc.z; So[(size_t)(4 * k4 + 3) * 128] = acc.w; }
        if (dq == 0) {
#pragma unroll
            for (int c = 0; c < 8; ++c) { float o = (RED[(0 * 16 + 8 + c) * 128 + e] + RED[(1 * 16 + 8 + c) * 128 + e]) + (RED[(2 * 16 + 8 + c) * 128 + e] + RED[(3 * 16 + 8 + c) * 128 + e]);
#pragma unroll
                for (int j = 0; j < 8; ++j) if (j <= c) o += SMs[96 + c * 8 + j] * vn[j];
                Oo[c * 128 + e] = o; } }
    }
    __syncthreads();
    {   const int c = wave; const size_t m = m0 + c;
        const float o0 = Oo[c * 128 + lane], o1 = Oo[c * 128 + 64 + lane];
        const float rstd = rsqrtf(wave_sum(o0 * o0 + o1 * o1) * (1.f / 128.f) + 1e-6f);
        const float z0 = bf2f(zq0), z1 = bf2f(zq1);
        bf16_t* mp = (bf16_t*)(ws + WS_MIX) + m * DM + 512 + 128 * h;
        mp[lane] = (bf16_t)f2bf(o0 * rstd * gnw0 * silu(z0)); mp[lane + 64] = (bf16_t)f2bf(o1 * rstd * gnw1 * silu(z1)); }
    __syncthreads();
}

DI void rg_fix_item(const Params& P, int b, int n) {
    const int c = tid_(); unsigned char* ws = P.ws;
    const float* SA = (const float*)(ws + WS_SEGA); const float* SH = (const float*)(ws + WS_SEGH);
    float Cc = 0.f;
    {   float sa[31], sh[31];
#pragma unroll
        for (int j = 0; j < 31; ++j) { const int Tj = b * 32 + j; sa[j] = (j < n) ? SA[Tj * 512 + c] : 1.f; sh[j] = (j < n) ? SH[Tj * 512 + c] : 0.f; }
#pragma unroll
        for (int j = 0; j < 31; ++j) Cc = sa[j] * Cc + sh[j]; }
    bf16_t* MIX = (bf16_t*)(ws + WS_MIX); const bf16_t* GA = (const bf16_t*)(ws + WS_GA);
    const size_t mb = (size_t)b * 2048 + 64 * n;
#pragma unroll 1
    for (int i0 = 0; i0 < 64; i0 += 32) {
        bf16_t mx[32], ga[32];
#pragma unroll
        for (int i = 0; i < 32; ++i) { const size_t m = mb + i0 + i; mx[i] = MIX[m * DM + c]; ga[i] = GA[m * 512 + c]; }
#pragma unroll
        for (int i = 0; i < 32; ++i) { const size_t m = mb + i0 + i; MIX[m * DM + c] = (bf16_t)f2bf(bf2f(mx[i]) + bf2f(ga[i]) * Cc); }
    }
    if (n == 31) { const int Tj = b * 32 + 31; P.out[OUT_PRH + (size_t)b * 512 + c] = SA[Tj * 512 + c] * Cc + SH[Tj * 512 + c]; }
}

__global__ void __launch_bounds__(NTHR, 2) hybrid_fwd(Params Pk) {
    extern __shared__ __attribute__((aligned(16))) unsigned char lds_raw[];
    LAS unsigned char* lds = (LAS unsigned char*)lds_raw;
    cg::grid_group grid = cg::this_grid();
    const int G = gridDim.x;
    volatile LAS unsigned* bst = (volatile LAS unsigned*)(lds + (LDS_BYTES - 64));
    if (threadIdx.x < 2) bst[threadIdx.x] = 0u;
    __syncthreads();
    XcdBarrier xb; { const Params P = load_params(); xb = xcd_barrier_post((unsigned*)(P.ws + WS_CTL), bst); }
    int n_stamp = 0;
#define STAMP() do { if (PROBE_T && blockIdx.x == 0 && threadIdx.x == 0) bst[4 + n_stamp] = (unsigned)__builtin_amdgcn_s_memrealtime(); ++n_stamp; } while (0)
    STAMP();

    { const Params P = load_params(); phase0(P, lds); }
    if (PROBE == 10) { __syncthreads(); const Params P = load_params(); phase0(P, lds); }
    if (Pk.ws == nullptr) grid.sync();
    xcd_barrier(xb); if (PROBE == 20) xcd_barrier(xb); STAMP();
    {   const Params P = load_params(); unsigned char* ws = P.ws;
        pg8::Gemm g{(const bf16_t*)(ws + WS_HN), (const bf16_t*)(ws + WS_WIN), NTOK_P, NPROJ, DM, DM}; pg8::StaticOrder S; S.init(NTOK_P, NPROJ, G, (int)blockIdx.x);
        EpiProj E{(bf16_t*)(ws + WS_PROJ), NPROJ};
        pg8::gemm_phase<EpiProj, pg8::StaticOrder, true, true>(lds, g, S, E);
        if (PROBE == 11) pg8::gemm_phase<EpiProj, pg8::StaticOrder, true, true>(lds, g, S, E); }
    xcd_barrier(xb); if (PROBE == 20) xcd_barrier(xb); STAMP();
    {
        const int bx = (int)blockIdx.x;
        if (bx < 48) {
            const Params P = load_params(); unsigned char* ws = P.ws;
            pg8::Gemm g{(const bf16_t*)(ws + WS_HN), (const bf16_t*)(ws + WS_WIN), NTOK, NPROJ, DM, DM}; SampleOrder3 S{bx};
            EpiProj E{(bf16_t*)(ws + WS_PROJ), NPROJ};
            pg8::gemm_phase<EpiProj, SampleOrder3, true, true>(lds, g, S, E);
            __syncthreads(); }
        const int nmine = (G == 256 && bx < 48) ? 3 : 4;
        for (int k = 0; k < nmine; ++k) { const int it = bx + k * G; if (it < 1024) { const Params P = load_params(); gdn_chunk_item(P, lds, it); } }
        if (G == 256 && bx >= 48 && bx < 96) { const Params P = load_params(); gdn_chunk_item(P, lds, 768 + bx - 48); }
        for (int it = bx; it < 256; it += G) { const Params P = load_params(); rg_tile_item(P, lds, it); __syncthreads(); }
        if (G != 256) { const Params P = load_params(); late_weights(P, lds, bx, G); }
        else if (bx >= 96) { const Params P = load_params(); late_weights(P, lds, bx - 96, 160); }
    }
    xcd_barrier(xb); if (PROBE == 20) xcd_barrier(xb); STAMP();
    if (blockIdx.x < 32) { for (int rep = 0; rep < (PROBE == 4 ? 2 : 1); ++rep) { const Params P = load_params(); gdn_seq_block(P, lds, blockIdx.x); } }
    else {
        for (int it = blockIdx.x - 32; it < 512; it += G - 32) { const Params P = load_params(); gdn_sample_item(P, lds, it >> 2, it & 3); }
        {   const int nb = (int)blockIdx.x - 32 - 64;
            if (nb >= 0 && nb < 16) { const Params P = load_params(); rg_tile_item(P, lds, 256 + nb); __syncthreads(); } }
        for (int q = blockIdx.x - 32; q < 248; q += G - 32) { const Params P = load_params(); rg_fix_item(P, q / 31, 1 + q % 31); }
    }
    if (PROBE_T >= 10) { asm volatile("s_waitcnt vmcnt(0)" ::: "memory"); __syncthreads(); if (threadIdx.x == 0) { const Params P = load_params(); ((unsigned*)(P.ws + WS_CTL))[16000 + blockIdx.x] = (unsigned)__builtin_amdgcn_s_memrealtime(); } }
    xcd_barrier(xb); if (PROBE == 20) xcd_barrier(xb); STAMP();
    {
        const int bx = (int)blockIdx.x; const int nmine = (G == 256 && bx >= 192) ? 3 : 4;
        for (int k = 0; k < nmine; ++k) { const int it = bx + k * G; if (it < 1024) { const Params P = load_params(); gdn_out_item(P, lds, it); } }
        if (G == 256 && bx < 64) { const Params P = load_params(); gdn_out_item(P, lds, 960 + bx); }
        if (G != 256) for (int it = bx + 4 * G; it < 1024; it += G) { const Params P = load_params(); gdn_out_item(P, lds, it); } }
    {
        const Params P = load_params(); unsigned char* ws = P.ws;
        pg8::Gemm g{(const bf16_t*)(ws + WS_MIX), (const bf16_t*)(ws + WS_WOUT), NTOK, DM, 256, DM}; SplitOrder2 S{G, G - 1 - (int)blockIdx.x};
        EpiX2Split E{(float*)(ws + WS_SLAB2)};
        pg8::gemm_phase<EpiX2Split, SplitOrder2, true, true>(lds, g, S, E); }
    xcd_barrier(xb); if (PROBE == 20) xcd_barrier(xb); STAMP();
    {   const Params P = load_params(); unsigned char* ws = P.ws;
        pg8::Gemm g{(const bf16_t*)(ws + WS_MIX), (const bf16_t*)(ws + WS_WOUT), NTOK_P, DM, DM, DM}; pg8::StaticOrder S; S.init(NTOK_P, DM, G, (int)blockIdx.x);
        {
            const int tid = tid_(), lane = tid & 63, wave = tid >> 6;
            for (int m = blockIdx.x * NWAVES + wave; m < NTOK - NTOK_P; m += G * NWAVES) {
                const float* xr = P.in[I_XS] + (size_t)m * DM + 4 * lane; const float* sl = (const float*)(ws + WS_SLAB2) + (size_t)m * DM + 4 * lane;
                f32x4 v[4]; float ssum = 0.f;
#pragma unroll
                for (int j = 0; j < 4; ++j) { v[j] = *(const f32x4*)(xr + 256 * j);
#pragma unroll
                    for (int q = 0; q < 4; ++q) v[j] += *(const f32x4*)(sl + (size_t)q * (1024 * 1024) + 256 * j);
                    ssum += (v[j].x * v[j].x + v[j].y * v[j].y) + (v[j].z * v[j].z + v[j].w * v[j].w);
                    u32x2 w; w.x = pk2(v[j].x, v[j].y); w.y = pk2(v[j].z, v[j].w); *(u32x2*)((bf16_t*)(ws + WS_X1B) + (size_t)(NTOK_P + m) * DM + 4 * lane + 256 * j) = w; }
                ssum = wave_sum(ssum); if (lane == 0) ((float*)(ws + WS_SS1))[NTOK_P + m] = ssum; }
            __syncthreads(); }
        if (PROBE == 12) { EpiX1T<false> E0{P.in[I_XP], P.in[I_XS], (bf16_t*)(ws + WS_X1B), (float*)(ws + WS_SS1)}; pg8::gemm_phase<EpiX1T<false>, pg8::StaticOrder, true, true>(lds, g, S, E0); }
        EpiX1T<true> E{P.in[I_XP], P.in[I_XS], (bf16_t*)(ws + WS_X1B), (float*)(ws + WS_SS1)};
        pg8::gemm_phase<EpiX1T<true>, pg8::StaticOrder, false, true>(lds, g, S, E); }
    xcd_barrier(xb); if (PROBE == 20) xcd_barrier(xb); STAMP();
    {   const Params P = load_params(); unsigned char* ws = P.ws;
        pg8::Gemm g{(const bf16_t*)(ws + WS_X1B), (const bf16_t*)(ws + WS_WGU), NTOK, NGU, DM, DM}; pg8::StaticOrder S; S.init(NTOK, NGU, G, (int)blockIdx.x);
        EpiAct E{(bf16_t*)(ws + WS_ACT), (const float*)(ws + WS_SS1)};
        pg8::gemm_phase<EpiAct, pg8::StaticOrder, true, true>(lds, g, S, E);
        if (PROBE == 15) pg8::gemm_phase<EpiAct, pg8::StaticOrder, true, true>(lds, g, S, E); }
    xcd_barrier(xb); if (PROBE == 20) xcd_barrier(xb); STAMP();
    {   const Params P = load_params(); unsigned char* ws = P.ws;
        {   pg8::Gemm g{(const bf16_t*)(ws + WS_ACT), (const bf16_t*)(ws + WS_WDN), NTOK_P, DM, DFF, DFF}; pg8::StaticOrder S; S.init(NTOK_P, DM, G, (int)blockIdx.x);
            EpiX2 E{P.out + OUT_Y, (const bf16_t*)(ws + WS_X1B)};
            pg8::gemm_phase<EpiX2, pg8::StaticOrder, false, true>(lds, g, S, E); }
        {   pg8::Gemm g{(const bf16_t*)(ws + WS_ACT), (const bf16_t*)(ws + WS_WDN), NTOK, DM, 256, DFF}; SplitOrder S{G, (int)blockIdx.x};
            EpiX2Split E{(float*)(ws + WS_SLAB)};
            pg8::gemm_phase<EpiX2Split, SplitOrder, true, true>(lds, g, S, E); } }
    xcd_barrier(xb); if (PROBE == 20) xcd_barrier(xb); STAMP();
    {
        const Params P = load_params();
        const int tid = tid_(), lane = tid & 63, wave = tid >> 6; const float* fw = P.in[I_FN];
        f32x4 nw[4];
#pragma unroll
        for (int j = 0; j < 4; ++j) nw[j] = *(const f32x4*)(fw + 4 * lane + 256 * j);
        for (int rep = (PROBE == 17 ? 0 : 1); rep < 2; ++rep)
        for (int m = blockIdx.x * NWAVES + wave; m < NTOK; m += G * NWAVES) {
            float* row = P.out + OUT_Y + (size_t)m * DM; f32x4 v[4]; float s = 0.f;
            float* orow = (rep == 0) ? (float*)(P.ws + WS_HN) + (size_t)m * DM : row;
#pragma unroll
            for (int j = 0; j < 4; ++j) v[j] = *(const f32x4*)(row + 4 * lane + 256 * j);
            if (m >= NTOK_P) { const bf16_t* xb = (const bf16_t*)(P.ws + WS_X1B) + (size_t)m * DM + 4 * lane;
#pragma unroll
                for (int j = 0; j < 4; ++j) { const u32x2 x = *(const u32x2*)(xb + 256 * j); v[j] = (f32x4){__uint_as_float(x.x << 16), __uint_as_float(x.x & 0xffff0000u), __uint_as_float(x.y << 16), __uint_as_float(x.y & 0xffff0000u)}; }
                const float* sl = (const float*)(P.ws + WS_SLAB) + (size_t)(m - NTOK_P) * DM + 4 * lane;
#pragma unroll
                for (int q = 0; q < 11; ++q)
#pragma unroll
                    for (int j = 0; j < 4; ++j) v[j] += *(const f32x4*)(sl + (size_t)q * (1024 * 1024) + 256 * j); }
#pragma unroll
            for (int j = 0; j < 4; ++j) s += (v[j].x * v[j].x + v[j].y * v[j].y) + (v[j].z * v[j].z + v[j].w * v[j].w);
            const float rstd = rsqrtf(wave_sum(s) * (1.f / DM) + 1e-6f);
#pragma unroll
            for (int j = 0; j < 4; ++j) *(f32x4*)(orow + 4 * lane + 256 * j) = v[j] * rstd * nw[j];
        }
    }
    if (PROBE_T) {
        asm volatile("s_waitcnt vmcnt(0)" ::: "memory"); __syncthreads(); STAMP(); __syncthreads();
        if (blockIdx.x == 0) { const Params P = load_params(); const unsigned* ctlw = (const unsigned*)(P.ws + WS_CTL);
            const unsigned dtk = (PROBE_T < 10) ? bst[4 + PROBE_T] - bst[4 + PROBE_T - 1] : __hip_atomic_load(ctlw + 16000 + (PROBE_T == 10 ? 0 : PROBE_T == 11 ? 40 : 255), __ATOMIC_RELAXED, __HIP_MEMORY_SCOPE_AGENT) - bst[4 + 3];
            const float sc = 1.f + PROBE_SC * (float)dtk;
            for (int i = threadIdx.x; i < 4096; i += NTHR) P.out[OUT_PRH + i] *= sc; }
    }
#undef STAMP
}

extern "C" void kernel_launch(void* const* d_in, const int* in_sizes, int n_in, void* d_out, int out_size, void* d_ws, size_t ws_size, hipStream_t stream) {
    static int grid = 0;
    if (grid == 0) {
        int dev = 0, cus = 0, per_cu = 0;
        if (n_in != 25 || ws_size < WS_END) { fprintf(stderr, "kernel_launch: unexpected n_in %d / ws_size %zu\n", n_in, ws_size); grid = -1; return; }
        hipGetDevice(&dev); hipDeviceGetAttribute(&cus, hipDeviceAttributeMultiprocessorCount, dev);
        hipFuncSetAttribute((const void*)hybrid_fwd, hipFuncAttributeMaxDynamicSharedMemorySize, LDS_BYTES);
        hipOccupancyMaxActiveBlocksPerMultiprocessor(&per_cu, (const void*)hybrid_fwd, NTHR, LDS_BYTES);
        (void)hipGetLastError();
        if (per_cu < 1) { fprintf(stderr, "kernel_launch: occupancy query says %d blocks per CU\n", per_cu); per_cu = 1; }
        grid = cus;
        if (grid > 256) grid = 256;
    }
    if (grid < 0) return;
    hipMemsetAsync((char*)d_ws + WS_CTL, 0, CTL_BYTES, stream);
    Params p{};
    for (int i = 0; i < 25; ++i) p.in[i] = (const float*)d_in[i];
    p.out = (float*)d_out; p.ws = (unsigned char*)d_ws;
    void* args[] = {&p};
    hipError_t e = hipLaunchCooperativeKernel((const void*)hybrid_fwd, dim3(grid), dim3(NTHR), args, LDS_BYTES, stream);
    if (e != hipSuccess) fprintf(stderr, "cooperative launch failed: %s (grid %d)\n", hipGetErrorString(e), grid);
}
```

```cpp
#include <hip/hip_runtime.h>
#include <hip/hip_cooperative_groups.h>
#include <cstdio>
#include <cstdint>
namespace cg = cooperative_groups;
namespace pg8 {
#define PG8_LAS __attribute__((address_space(3)))
typedef unsigned short bf16_t;
typedef short bf16x8 __attribute__((ext_vector_type(8)));
typedef float f32x4 __attribute__((ext_vector_type(4)));
typedef unsigned u32x4 __attribute__((ext_vector_type(4)));
constexpr int BM = 256, BK = 64, HALF = 128, HTB = HALF * BK * 2  , STAGE_BYTES = 8 * HTB, NXCD = 8, WGM = 8;

__host__ __device__ __forceinline__ int lds_byte(int r, int c) { const int st = (r >> 4) * 2 + (c >> 5), rr = r & 15, cc = c & 31, ob = rr * 64 + cc * 2; return st * 1024 + (ob ^ (((ob >> 9) & 1) << 5)); }
__host__ __device__ __forceinline__ void stage_rc(int b, int& R, int& C) { const int st = b / 1024, sb = b % 1024, swz = sb ^ (((sb >> 9) & 1) << 5); R = (st >> 1) * 16 + swz / 64; C = (st & 1) * 32 + (swz % 64) / 2; }
__host__ __device__ __forceinline__ int perm32(int rho) { const int n = rho >> 4, i = rho & 15; return 8 * (i >> 2) + 4 * n + (i & 3); }

struct Unit { int pm, pn, kb, ks; };
struct Gemm { const bf16_t* A; const bf16_t* Bt; int M, N, K, ld; };

struct StaticOrder {
    int nM, nN, nwg, G, c;
    __host__ __device__ void init(int M, int N, int G_, int c_) { nM = M / BM; nN = N / BM; nwg = nM * nN; G = G_; c = c_; }
    __host__ __device__ bool next(int i, Unit& u) const {
        const long L = (long)i * G + c; if (L >= nwg) return false;
        int wgid = (int)L; { const int q = nwg / NXCD, r = nwg % NXCD, xcd = wgid % NXCD, off = wgid / NXCD; wgid = (xcd < r ? xcd * (q + 1) : r * (q + 1) + (xcd - r) * q) + off; }
        const int nig = WGM * nN, gid = wgid / nig, fm = gid * WGM, gsz = (nM - fm) < WGM ? (nM - fm) : WGM;
        u.pm = fm + ((wgid % nig) % gsz); u.pn = (wgid % nig) / gsz; u.kb = 0; u.ks = 0; return true;
    }
    __device__ __forceinline__ void a_ready(const Unit&) const {}
    __device__ __forceinline__ void done(const Unit&) const {}
};
__device__ __forceinline__ unsigned cvt_pk_bf16(float lo, float hi) { unsigned r; asm volatile("v_cvt_pk_bf16_f32 %0, %1, %2" : "=v"(r) : "v"(lo), "v"(hi)); return r; }
template <class Epi, class Sched, bool ALIGN_EPI = false, bool SP2 = false>
__device__ __forceinline__ void gemm_phase(PG8_LAS unsigned char* lds, const Gemm g, const Sched& S, const Epi& E) {
    int tid = threadIdx.x; asm volatile("" : "+v"(tid)); const int wid = __builtin_amdgcn_readfirstlane(tid >> 6), lane = tid & 63, wr = wid >> 2, wc = wid & 3, fr = lane & 15, fq = lane >> 4;
    const int K = g.ld, nt = g.K / BK;
    unsigned voffA[2], voffB[2];
#pragma unroll
    for (int i = 0; i < 2; ++i) { int R, C; stage_rc(tid * 16 + i * 8192, R, C); const int Rb = Epi::PERM ? ((R & ~31) + perm32(R & 31)) : R;
        voffA[i] = (unsigned)(R * K + C) * 2u; voffB[i] = (unsigned)(Rb * K + C) * 2u; }
    const size_t kstep = (size_t)(BK * 2);
    const size_t hstep = (size_t)HALF * K * 2;
    const size_t tstep = 2 * hstep;
    const unsigned ldsw = (unsigned)wid * 1024u;
    const int aoff = lds_byte(wr * 64 + fr, fq * 8), boff = lds_byte(wc * 32 + fr, fq * 8);
#define PG8_SA(b, h) (((b) * 2 + (h)) * HTB)
#define PG8_SB(b, h) ((4 + (b) * 2 + (h)) * HTB)
#define PG8_STAGE(bufoff, gbase, voff) do { _Pragma("unroll") for (int _i = 0; _i < 2; ++_i) \
        __builtin_amdgcn_global_load_lds((const unsigned*)((const char*)(gbase) + (voff)[_i]), (PG8_LAS unsigned*)(lds + (bufoff) + ldsw + _i * 8192), 16, 0, 0); } while (0)
#define PG8_LDA(dst, b, h) do { _Pragma("unroll") for (int m = 0; m < 4; ++m) _Pragma("unroll") for (int k = 0; k < 2; ++k) dst[m][k] = *(const PG8_LAS bf16x8*)(lds + PG8_SA(b, h) + aoff + m * 2048 + k * 1024); } while (0)
#define PG8_LDB(dst, b, h) do { _Pragma("unroll") for (int n = 0; n < 2; ++n) _Pragma("unroll") for (int k = 0; k < 2; ++k) dst[n][k] = *(const PG8_LAS bf16x8*)(lds + PG8_SB(b, h) + boff + n * 2048 + k * 1024); } while (0)
#define PG8_MMA(ai, bj, At, Bt) do { __builtin_amdgcn_s_setprio(1); _Pragma("unroll") for (int m = 0; m < 4; ++m) _Pragma("unroll") for (int n = 0; n < 2; ++n) _Pragma("unroll") for (int k = 0; k < 2; ++k) \
        acc[ai][bj][m][n] = __builtin_amdgcn_mfma_f32_16x16x32_bf16(Bt[n][k], At[m][k], acc[ai][bj][m][n], 0, 0, 0); __builtin_amdgcn_s_setprio(0); } while (0)
#define PG8_WAIT_V(n) asm volatile("s_waitcnt vmcnt(" #n ")" ::: "memory")
#define PG8_WAIT_L(n) asm volatile("s_waitcnt lgkmcnt(" #n ")" ::: "memory")
#define PG8_BAR __builtin_amdgcn_s_barrier()
#define PG8_SCHED __builtin_amdgcn_sched_barrier(0)
    Unit cur, nxt; int ui = 0;
    if (!S.next(0, cur)) return;
    f32x4 acc[2][2][4][2];
#pragma unroll
    for (int a = 0; a < 2; ++a)
#pragma unroll
        for (int b = 0; b < 2; ++b)
#pragma unroll
            for (int m = 0; m < 4; ++m)
#pragma unroll
                for (int n = 0; n < 2; ++n) acc[a][b][m][n] = (f32x4){0.f, 0.f, 0.f, 0.f};
    bf16x8 At[4][2], B0[2][2], B1[2][2];
    const char* cA = (const char*)g.A + (size_t)cur.pm * tstep + cur.kb; const char* cB = (const char*)g.Bt + (size_t)cur.pn * tstep + cur.kb;
    S.a_ready(cur);
    if constexpr (SP2) {
        PG8_STAGE(PG8_SB(0, 0), cB, voffB); PG8_STAGE(PG8_SB(0, 1), cB + hstep, voffB); PG8_STAGE(PG8_SA(0, 0), cA, voffA); PG8_STAGE(PG8_SA(0, 1), cA + hstep, voffA);
        if (wr == 1) PG8_BAR;
        PG8_WAIT_V(2); PG8_BAR;
        PG8_STAGE(PG8_SB(1, 0), cB + kstep, voffB); PG8_STAGE(PG8_SA(1, 0), cA + kstep, voffA); PG8_STAGE(PG8_SB(1, 1), cB + hstep + kstep, voffB);
        PG8_WAIT_V(6); PG8_BAR;
    } else {
        PG8_STAGE(PG8_SB(0, 0), cB, voffB); PG8_STAGE(PG8_SA(0, 0), cA, voffA); PG8_STAGE(PG8_SB(0, 1), cB + hstep, voffB); PG8_STAGE(PG8_SA(0, 1), cA + hstep, voffA);
        if (wr == 1) PG8_BAR;
        PG8_WAIT_V(4); PG8_BAR;
        PG8_STAGE(PG8_SB(1, 0), cB + kstep, voffB); PG8_STAGE(PG8_SA(1, 0), cA + kstep, voffA); PG8_STAGE(PG8_SB(1, 1), cB + hstep + kstep, voffB);
        PG8_WAIT_V(6); PG8_BAR;
    }
    for (;;) {
        const bool has_next = S.next(ui + 1, nxt);
        const char* nA = has_next ? (const char*)g.A + (size_t)nxt.pm * tstep + nxt.kb : cA; const char* nB = has_next ? (const char*)g.Bt + (size_t)nxt.pn * tstep + nxt.kb : cB;
        for (int t = 0; t < nt; t += 2) {
            const bool last = (t == nt - 2);
            const char* a1 = cA + (size_t)(t + 1) * kstep;
            const char* a2 = last ? nA : cA + (size_t)(t + 2) * kstep; const char* b2 = last ? nB : cB + (size_t)(t + 2) * kstep;
            const char* a3 = a2 + kstep; const char* b3 = b2 + kstep;
            if (last && has_next) S.a_ready(nxt);
            if constexpr (SP2) {
            PG8_LDB(B0, 0, 0); PG8_LDB(B1, 0, 1); PG8_SCHED; PG8_LDA(At, 0, 0); PG8_STAGE(PG8_SA(1, 1), a1 + hstep, voffA);
            PG8_WAIT_V(8); PG8_WAIT_L(0); PG8_BAR; PG8_MMA(0, 0, At, B0); PG8_MMA(0, 1, At, B1); PG8_BAR; PG8_SCHED;
            PG8_LDA(At, 0, 1); PG8_STAGE(PG8_SB(0, 0), b2, voffB); PG8_STAGE(PG8_SB(0, 1), b2 + hstep, voffB); PG8_STAGE(PG8_SA(0, 0), a2, voffA);
            PG8_WAIT_V(8); PG8_WAIT_L(0); PG8_BAR; PG8_MMA(1, 0, At, B0); PG8_MMA(1, 1, At, B1); PG8_BAR; PG8_SCHED;
            PG8_LDB(B0, 1, 0); PG8_LDB(B1, 1, 1); PG8_SCHED; PG8_LDA(At, 1, 0); PG8_STAGE(PG8_SA(0, 1), a2 + hstep, voffA);
            PG8_WAIT_V(8); PG8_WAIT_L(0); PG8_BAR; PG8_MMA(0, 0, At, B0); PG8_MMA(0, 1, At, B1); PG8_BAR; PG8_SCHED;
            PG8_LDA(At, 1, 1); PG8_STAGE(PG8_SB(1, 0), b3, voffB); PG8_STAGE(PG8_SB(1, 1), b3 + hstep, voffB); PG8_STAGE(PG8_SA(1, 0), a3, voffA);
            PG8_WAIT_V(8); PG8_WAIT_L(0); PG8_BAR; PG8_MMA(1, 0, At, B0); PG8_MMA(1, 1, At, B1); PG8_BAR; PG8_SCHED;
            } else {
            PG8_LDB(B0, 0, 0); PG8_SCHED; PG8_LDA(At, 0, 0); PG8_STAGE(PG8_SA(1, 1), a1 + hstep, voffA);
            PG8_WAIT_L(8); PG8_BAR; PG8_WAIT_L(0); PG8_MMA(0, 0, At, B0); PG8_BAR; PG8_SCHED;
            PG8_LDB(B1, 0, 1); PG8_STAGE(PG8_SB(0, 0), b2, voffB);
            PG8_BAR; PG8_WAIT_L(0); PG8_MMA(0, 1, At, B1); PG8_BAR;
            PG8_LDA(At, 0, 1); PG8_STAGE(PG8_SA(0, 0), a2, voffA);
            PG8_BAR; PG8_WAIT_L(0); PG8_MMA(1, 0, At, B0); PG8_BAR; PG8_SCHED;
            PG8_STAGE(PG8_SB(0, 1), b2 + hstep, voffB);
            PG8_WAIT_V(6); PG8_BAR; PG8_MMA(1, 1, At, B1); PG8_BAR;
            PG8_LDB(B0, 1, 0); PG8_SCHED; PG8_LDA(At, 1, 0); PG8_STAGE(PG8_SA(0, 1), a2 + hstep, voffA);
            PG8_WAIT_L(8); PG8_BAR; PG8_WAIT_L(0); PG8_MMA(0, 0, At, B0); PG8_BAR; PG8_SCHED;
            PG8_LDB(B1, 1, 1); PG8_STAGE(PG8_SB(1, 0), b3, voffB);
            PG8_BAR; PG8_WAIT_L(0); PG8_MMA(0, 1, At, B1); PG8_BAR;
            PG8_LDA(At, 1, 1); PG8_STAGE(PG8_SA(1, 0), a3, voffA);
            PG8_BAR; PG8_WAIT_L(0); PG8_MMA(1, 0, At, B0); PG8_BAR; PG8_SCHED;
            PG8_STAGE(PG8_SB(1, 1), b3 + hstep, voffB);
            PG8_WAIT_V(6); PG8_BAR; PG8_MMA(1, 1, At, B1); PG8_BAR;
            }
        }
        if constexpr (ALIGN_EPI) { if (wr == 0) PG8_BAR; }
        if constexpr (!Epi::AFTER_DRAIN) { E(acc, cur, wr, wc, fr, fq); S.done(cur); }
        if (!has_next) break;
#pragma unroll
        for (int a = 0; a < 2; ++a)
#pragma unroll
            for (int b = 0; b < 2; ++b)
#pragma unroll
                for (int m = 0; m < 4; ++m)
#pragma unroll
                    for (int n = 0; n < 2; ++n) acc[a][b][m][n] = (f32x4){0.f, 0.f, 0.f, 0.f};
        cur = nxt; cA = nA; cB = nB; ++ui;
        if constexpr (ALIGN_EPI) { if (wr == 1) PG8_BAR; }
    }
    PG8_WAIT_V(0);
    if constexpr (!ALIGN_EPI) { if (wr == 0) PG8_BAR; }
    PG8_BAR;
    if constexpr (Epi::AFTER_DRAIN) { E.fused(acc, cur, wr, wc, fr, fq, lds, wid, lane); S.done(cur); }
#undef PG8_SA
#undef PG8_SB
#undef PG8_STAGE
#undef PG8_LDA
#undef PG8_LDB
#undef PG8_MMA
#undef PG8_WAIT_V
#undef PG8_WAIT_L
#undef PG8_BAR
#undef PG8_SCHED
}
}

#define LAS __attribute__((address_space(3)))
typedef unsigned short bf16_t;
typedef short bf16x8 __attribute__((ext_vector_type(8)));
typedef float f32x4 __attribute__((ext_vector_type(4)));
typedef float f32x16 __attribute__((ext_vector_type(16)));
typedef unsigned u32x4 __attribute__((ext_vector_type(4)));
typedef unsigned u32x2 __attribute__((ext_vector_type(2)));

#define XB_TMO      128
#define XB_XCNT(j)  (256  + 64 * (j))
#define XB_XSUB(j)  (1280 + 64 * (j))
#define XB_XGEN(j)  (2304 + 64 * (j))
#define XB_TOP      3328
#define XB_TOPGEN   3392
#define XCD_BAR_WORDS 3456
#define XB_SPIN_CAP (1u << 18)

__device__ __forceinline__ unsigned xb_ld(unsigned* p)              { return __hip_atomic_load(p, __ATOMIC_RELAXED, __HIP_MEMORY_SCOPE_AGENT); }
__device__ __forceinline__ unsigned xb_add(unsigned* p, unsigned v) { return __hip_atomic_fetch_add(p, v, __ATOMIC_RELAXED, __HIP_MEMORY_SCOPE_AGENT); }
__device__ __forceinline__ unsigned xb_xcc_id() { return (unsigned)__builtin_amdgcn_s_getreg((3 << 11) | 20) & 0xFu; }
#define XB_SPIN(cond, bar) do { unsigned _sp = 0; while (cond) { __builtin_amdgcn_s_sleep(1); \
    if ((++_sp & 255u) == 0u) { if (xb_ld(&(bar)[XB_TMO])) break; if (_sp > XB_SPIN_CAP) { atomicAdd(&(bar)[XB_TMO], 1u); break; } } } } while (0)

struct XcdBarrier {
    unsigned* bar; unsigned x;
    volatile LAS unsigned* st;
};

__device__ __forceinline__ XcdBarrier xcd_barrier_post(unsigned* bar, volatile LAS unsigned* st) {
    XcdBarrier b; b.bar = bar; b.x = xb_xcc_id(); b.st = st;
    if (threadIdx.x == 0) (void)xb_add(&bar[XB_XCNT(b.x)], 1u);
    return b;
}
__device__ __forceinline__ void xcd_barrier_complete(unsigned* bar, unsigned x, unsigned& nloc, unsigned& nx) {
    const unsigned G = gridDim.x * gridDim.y * gridDim.z;
    unsigned sum, cnt, mine, sp = 0u;
    for (;;) {
        sum = 0u; cnt = 0u; mine = 0u;
#pragma unroll
        for (unsigned j = 0; j < 16; ++j) { const unsigned c = xb_ld(&bar[XB_XCNT(j)]); sum += c; cnt += (c > 0u) ? 1u : 0u; mine = (j == x) ? c : mine; }
        if (sum == G) break;
        __builtin_amdgcn_s_sleep(1);
        if ((++sp & 255u) == 0u) { if (xb_ld(&bar[XB_TMO])) break; if (sp > XB_SPIN_CAP) { atomicAdd(&bar[XB_TMO], 1u); break; } }
    }
    nloc = mine > 0u ? mine : 1u; nx = cnt > 0u ? cnt : 1u;
}

__device__ __forceinline__ void xcd_barrier(const XcdBarrier& b) {
    asm volatile("s_waitcnt vmcnt(0)" ::: "memory");
    __syncthreads();
    if (threadIdx.x == 0) {
        unsigned* bar = b.bar;
        __builtin_amdgcn_s_waitcnt(0);
        unsigned nloc = b.st[0], nx = b.st[1];
        if (nloc == 0u) { xcd_barrier_complete(bar, b.x, nloc, nx); b.st[0] = nloc; b.st[1] = nx; }
        const unsigned old = xb_add(&bar[XB_XSUB(b.x)], 1u);
        const unsigned gen = old / nloc;
        if (old + 1u == (gen + 1u) * nloc) {
            __builtin_amdgcn_fence(__ATOMIC_RELEASE, "agent");
            asm volatile("s_waitcnt vmcnt(0)" ::: "memory");
            const unsigned og = xb_add(&bar[XB_TOP], 1u);
            const unsigned tg = og / nx;
            if (og + 1u == (tg + 1u) * nx) xb_add(&bar[XB_TOPGEN], 1u);
            else XB_SPIN(xb_ld(&bar[XB_TOPGEN]) == tg, bar);
            __builtin_amdgcn_fence(__ATOMIC_ACQUIRE, "agent");
            xb_add(&bar[XB_XGEN(b.x)], 1u);
            asm volatile("s_waitcnt vmcnt(0)" ::: "memory");
        } else {
            XB_SPIN(xb_ld(&bar[XB_XGEN(b.x)]) == gen, bar);
            __builtin_amdgcn_fence(__ATOMIC_ACQUIRE, "agent");
            asm volatile("s_waitcnt vmcnt(0)" ::: "memory");
        }
    }
    __syncthreads();
}


constexpr int DM = 1024, NTOK_P = 16384, NTOK = 17408, DIN = 3080, NPROJ = 3072, DFF = 2816, NGU = 5632;
constexpr int NWAVES = 8, NTHR = 512;
constexpr int PROBE = 0;
constexpr int PROBE_T = 0; constexpr float PROBE_SC = 1e-6f;
constexpr int LDS_BYTES = 148480;
constexpr size_t MiB = 1u << 20;
constexpr size_t WS_CTL = 0, CTL_BYTES = 160 * 1024, WS_SS1 = 65536;
constexpr size_t WS_WIN = 1 * MiB, WS_WOUT = 7 * MiB, WS_WGU = 9 * MiB, WS_WDN = 20 * MiB;
constexpr size_t WS_RGW = 25 * MiB + 512 * 1024;
constexpr size_t WS_BETA = 26 * MiB, WS_G = 26 * MiB + 512 * 1024, WS_GL = 26 * MiB + 896 * 1024;
constexpr size_t WS_SEGA = 27 * MiB, WS_SEGH = 27 * MiB + 512 * 1024;
constexpr size_t WS_HN = 28 * MiB, WS_WF = 28 * MiB, WS_QDF = 44 * MiB, WS_X1B = 28 * MiB;
constexpr size_t WS_PROJ = 62 * MiB, WS_ACT = 62 * MiB;
constexpr size_t WS_SLAB2 = 198 * MiB;
constexpr size_t WS_SLAB = 198 * MiB;
constexpr size_t WS_MIX = 164 * MiB, WS_GA = 198 * MiB, WS_KTF = 214 * MiB, WS_QKF = 230 * MiB, WS_UB = 238 * MiB, WS_END = 254 * MiB;
constexpr size_t OUT_Y = 0, OUT_PRC = 17825792, OUT_PRH = 17838080, OUT_PGC = 17842176, OUT_PGS = 17879040,
                 OUT_SRC = 18403328, OUT_SRH = 18599936, OUT_SGC = 18665472, OUT_SGS = 19255296;

struct Params { const float* in[25]; float* out; unsigned char* ws; };
enum { I_XP = 0, I_XS, I_SRC, I_SRH, I_SGC, I_SGS, I_NORM1, I_WIN, I_RCW, I_RCB, I_RWA, I_RBA, I_RWI, I_RBI, I_LAM, I_GCW, I_ALOG, I_DTB, I_GNW, I_WOUT, I_NORM2, I_WG, I_WU, I_WD, I_FN };

#define DI __device__ __forceinline__
#define KAS __attribute__((address_space(4)))
DI Params load_params() {
#if defined(__HIP_DEVICE_COMPILE__)
    const KAS unsigned char* ka = (const KAS unsigned char*)__builtin_amdgcn_kernarg_segment_ptr(); asm volatile("" : "+s"(ka)); return *(const KAS Params*)ka;
#else
    return Params{};
#endif
}
template <class T> DI T vlaunder(T p) { asm volatile("" : "+v"(p)); return p; }
DI int tid_() { int t = threadIdx.x; asm volatile("" : "+v"(t)); return t; }
typedef __bf16 hbf2 __attribute__((ext_vector_type(2)));
typedef float f32x2 __attribute__((ext_vector_type(2)));
DI unsigned pk2(float lo, float hi) { const f32x2 v = {lo, hi}; return __builtin_bit_cast(unsigned, __builtin_convertvector(v, hbf2)); }
DI unsigned f2bf(float f) { return pk2(f, 0.f) & 0xffffu; }
DI float bf2f(bf16_t b) { return __uint_as_float(((unsigned)b) << 16); }
DI float dpp_add(float v, const int ctrl_sel) {
    const int x = __float_as_int(v); int y;
    if (ctrl_sel == 0) y = __builtin_amdgcn_update_dpp(x, x, 0xB1, 0xf, 0xf, false);
    else if (ctrl_sel == 1) y = __builtin_amdgcn_update_dpp(x, x, 0x4E, 0xf, 0xf, false);
    else if (ctrl_sel == 2) y = __builtin_amdgcn_update_dpp(x, x, 0x141, 0xf, 0xf, false);
    else y = __builtin_amdgcn_update_dpp(x, x, 0x140, 0xf, 0xf, false);
    return v + __int_as_float(y);
}
DI float wave_sum(float v) {
    v = dpp_add(v, 0); v = dpp_add(v, 1); v = dpp_add(v, 2); v = dpp_add(v, 3);
    v += __shfl_xor(v, 16); v += __shfl_xor(v, 32);
    return v;
}
DI float sigm(float x) { return __builtin_amdgcn_rcpf(1.f + __expf(-x)); }
DI float silu(float x) { return x * __builtin_amdgcn_rcpf(1.f + __expf(-x)); }
DI float one_minus_exp(float y, float e) { const float p = -y * (1.f + y * (0.5f + y * (0.16666667f + y * (0.041666668f + y * 0.0083333338f)))); return y > -0.3f ? p : 1.f - e; }
DI float softplus(float x) { return x > 20.f ? x : log1pf(__expf(x)); }
DI float gelu_tanh(float x) { const float u = 0.7978845608028654f * (x + 0.044715f * x * x * x); return x * __builtin_amdgcn_rcpf(1.f + __expf(-2.f * u)); }
DI int crow(int reg, int hh) { return (reg & 3) + 8 * (reg >> 2) + 4 * hh; }
DI bf16x8 pack8(f32x4 a, f32x4 b) { u32x4 p; p.x = pk2(a.x, a.y); p.y = pk2(a.z, a.w); p.z = pk2(b.x, b.y); p.w = pk2(b.z, b.w); return __builtin_bit_cast(bf16x8, p); }
DI bf16x8 pack8v(const float* v) { u32x4 p; p.x = pk2(v[0], v[1]); p.y = pk2(v[2], v[3]); p.z = pk2(v[4], v[5]); p.w = pk2(v[6], v[7]); return __builtin_bit_cast(bf16x8, p); }
#define MFMA32(a, b, c) __builtin_amdgcn_mfma_f32_32x32x16_bf16((a), (b), (c), 0, 0, 0)
DI bf16x8 pack_step(const f32x16& x, int s) {
    u32x4 p;
    p.x = pk2(x[8 * s + 0], x[8 * s + 1]); p.y = pk2(x[8 * s + 2], x[8 * s + 3]); p.z = pk2(x[8 * s + 4], x[8 * s + 5]); p.w = pk2(x[8 * s + 6], x[8 * s + 7]);
    return __builtin_bit_cast(bf16x8, p);
}
DI f32x16 zero16() { f32x16 z;
#pragma unroll
    for (int i = 0; i < 16; ++i) z[i] = 0.f;
    return z; }

struct EpiProj {
    static constexpr bool PERM = true, AFTER_DRAIN = false;
    bf16_t* O; int ldc;
    DI void operator()(const f32x4 (&acc)[2][2][4][2], const pg8::Unit& u, int wr, int wc, int fr, int fq) const {
        const int row0 = u.pm * 256 + wr * 64 + fr, col0 = u.pn * 256 + wc * 32 + 8 * fq;
#pragma unroll
        for (int ai = 0; ai < 2; ++ai)
#pragma unroll
            for (int m = 0; m < 4; ++m) { bf16_t* rowp = O + (size_t)(row0 + ai * 128 + m * 16) * ldc + col0;
#pragma unroll
                for (int bj = 0; bj < 2; ++bj) { const f32x4 v0 = acc[ai][bj][m][0], v1 = acc[ai][bj][m][1];
                    u32x4 w; w.x = pg8::cvt_pk_bf16(v0[0], v0[1]); w.y = pg8::cvt_pk_bf16(v0[2], v0[3]); w.z = pg8::cvt_pk_bf16(v1[0], v1[1]); w.w = pg8::cvt_pk_bf16(v1[2], v1[3]);
                    *(u32x4*)(rowp + bj * 128) = w; } }
    }
};
template <bool ATOM> struct EpiX1T {
    static constexpr bool PERM = false, AFTER_DRAIN = false;
    const float* xp; const float* xs; bf16_t* X1B; float* SS1;
    DI void operator()(const f32x4 (&acc)[2][2][4][2], const pg8::Unit& u, int wr, int wc, int fr, int fq) const {
        const int row0 = u.pm * 256 + wr * 64 + fr, col0 = u.pn * 256 + wc * 32 + 4 * fq;
        const float* xbase = (u.pm < 64 ? xp + (size_t)row0 * DM : xs + (size_t)(row0 - NTOK_P) * DM) + col0;
        f32x4 xv[3][4];
#pragma unroll
        for (int g0 = 0; g0 < 2; ++g0) { const float* xn = xbase + (size_t)((g0 >> 2) * 128 + (g0 & 3) * 16) * DM;
#pragma unroll
            for (int k = 0; k < 4; ++k) xv[g0][k] = *(const f32x4*)(xn + (k >> 1) * 128 + (k & 1) * 16); }
#pragma unroll
        for (int gi = 0; gi < 8; ++gi) { const int ai = gi >> 2, m = gi & 3, row = row0 + ai * 128 + m * 16;
            if (gi + 2 < 8) { const int g2 = gi + 2; const float* xn = xbase + (size_t)((g2 >> 2) * 128 + (g2 & 3) * 16) * DM;
#pragma unroll
                for (int k = 0; k < 4; ++k) xv[g2 % 3][k] = *(const f32x4*)(xn + (k >> 1) * 128 + (k & 1) * 16); }
            bf16_t* bp = X1B + (size_t)row * DM + col0; float ss = 0.f;
#pragma unroll
            for (int k = 0; k < 4; ++k) { const int bj = k >> 1, n = k & 1; const f32x4 v = acc[ai][bj][m][n] + xv[gi % 3][k];
                u32x2 w; w.x = pk2(v[0], v[1]); w.y = pk2(v[2], v[3]);
                *(u32x2*)(bp + bj * 128 + n * 16) = w; ss += (v[0] * v[0] + v[1] * v[1]) + (v[2] * v[2] + v[3] * v[3]); }
            ss += __shfl_xor(ss, 16); ss += __shfl_xor(ss, 32);
            if (ATOM && fq == 0) atomicAdd(SS1 + row, ss); }
    }
};
struct EpiAct {
    static constexpr bool PERM = true, AFTER_DRAIN = false;
    bf16_t* ACT; const float* SS1;
    DI void operator()(const f32x4 (&acc)[2][2][4][2], const pg8::Unit& u, int wr, int wc, int fr, int fq) const {
        const int row0 = u.pm * 256 + wr * 64 + fr, col0 = u.pn * 256 + wc * 32 + 8 * fq;
        float ssv[8];
#pragma unroll
        for (int gi = 0; gi < 8; ++gi) ssv[gi] = SS1[row0 + (gi >> 2) * 128 + (gi & 3) * 16];
#pragma unroll
        for (int ai = 0; ai < 2; ++ai)
#pragma unroll
            for (int m = 0; m < 4; ++m) { const int row = row0 + ai * 128 + m * 16; const float rstd = rsqrtf(ssv[ai * 4 + m] * (1.f / DM) + 1e-6f);
                bf16_t* rowp = ACT + (size_t)row * DFF + (col0 >> 1);
#pragma unroll
                for (int bj = 0; bj < 2; ++bj) { const f32x4 v0 = acc[ai][bj][m][0] * rstd, v1 = acc[ai][bj][m][1] * rstd;
                    u32x2 w; w.x = pg8::cvt_pk_bf16(silu(v0[0]) * v0[1], silu(v0[2]) * v0[3]); w.y = pg8::cvt_pk_bf16(silu(v1[0]) * v1[1], silu(v1[2]) * v1[3]);
                    *(u32x2*)(rowp + bj * 64) = w; } }
    }
};
struct EpiX2 {
    static constexpr bool PERM = false, AFTER_DRAIN = false;
    float* Y; const bf16_t* X1B;
    DI void operator()(const f32x4 (&acc)[2][2][4][2], const pg8::Unit& u, int wr, int wc, int fr, int fq) const {
        const int row0 = u.pm * 256 + wr * 64 + fr, col0 = u.pn * 256 + wc * 32 + 4 * fq;
        const bf16_t* xbase = X1B + (size_t)row0 * DM + col0; float* ybase = Y + (size_t)row0 * DM + col0;
        u32x2 xv[3][4];
#pragma unroll
        for (int g0 = 0; g0 < 2; ++g0) { const bf16_t* xn = xbase + (size_t)((g0 >> 2) * 128 + (g0 & 3) * 16) * DM;
#pragma unroll
            for (int k = 0; k < 4; ++k) xv[g0][k] = *(const u32x2*)(xn + (k >> 1) * 128 + (k & 1) * 16); }
#pragma unroll
        for (int gi = 0; gi < 8; ++gi) { const int ai = gi >> 2, m = gi & 3;
            if (gi + 2 < 8) { const int g2 = gi + 2; const bf16_t* xn = xbase + (size_t)((g2 >> 2) * 128 + (g2 & 3) * 16) * DM;
#pragma unroll
                for (int k = 0; k < 4; ++k) xv[g2 % 3][k] = *(const u32x2*)(xn + (k >> 1) * 128 + (k & 1) * 16); }
            float* yp = ybase + (size_t)(ai * 128 + m * 16) * DM;
#pragma unroll
            for (int k = 0; k < 4; ++k) { const u32x2 x = xv[gi % 3][k];
                const f32x4 xf = (f32x4){__uint_as_float(x.x << 16), __uint_as_float(x.x & 0xffff0000u), __uint_as_float(x.y << 16), __uint_as_float(x.y & 0xffff0000u)};
                *(f32x4*)(yp + (k >> 1) * 128 + (k & 1) * 16) = xf + acc[ai][k >> 1][m][k & 1]; } }
    }
};
struct SplitOrder {
    int G, c;
    DI bool next(int i, pg8::Unit& u) const { const int L = i * G + c; if (L >= 176) return false; const int ks = L % 11, t = L / 11; u.pm = 64 + (t >> 2); u.pn = t & 3; u.kb = ks * 512; u.ks = ks; return true; }
    DI void a_ready(const pg8::Unit&) const {}
    DI void done(const pg8::Unit&) const {}
};
struct SampleOrder3 {
    int c;
    DI bool next(int i, pg8::Unit& u) const { if (i != 0 || c >= 48) return false; u.pm = 64 + c / 12; u.pn = c % 12; u.kb = 0; u.ks = 0; return true; }
    DI void a_ready(const pg8::Unit&) const {}
    DI void done(const pg8::Unit&) const {}
};
struct SplitOrder2 {
    int G, c;
    DI bool next(int i, pg8::Unit& u) const { const int L = i * G + c; if (L >= 64) return false; const int ks = L & 3, t = L >> 2; u.pm = 64 + (t >> 2); u.pn = t & 3; u.kb = ks * 512; u.ks = ks; return true; }
    DI void a_ready(const pg8::Unit&) const {}
    DI void done(const pg8::Unit&) const {}
};
struct EpiX2Split {
    static constexpr bool PERM = false, AFTER_DRAIN = false;
    float* SLAB;
    DI void operator()(const f32x4 (&acc)[2][2][4][2], const pg8::Unit& u, int wr, int wc, int fr, int fq) const {
        const int row0 = u.pm * 256 + wr * 64 + fr, col0 = u.pn * 256 + wc * 32 + 4 * fq;
        float* base = SLAB + (size_t)u.ks * (1024 * 1024) - (size_t)NTOK_P * DM;
#pragma unroll
        for (int ai = 0; ai < 2; ++ai)
#pragma unroll
            for (int m = 0; m < 4; ++m) { float* yp = base + (size_t)(row0 + ai * 128 + m * 16) * DM + col0;
#pragma unroll
                for (int bj = 0; bj < 2; ++bj)
#pragma unroll
                    for (int n = 0; n < 2; ++n) { f32x4* p = (f32x4*)(yp + bj * 128 + n * 16); *p = acc[ai][bj][m][n]; } }
    }
};

DI void p0_transpose_item(const float* W, int ldw, int nblk, int K, bf16_t* WT, int rmul, int radd, const float* ksc, LAS float* scr, int item, int lane) {
    const int kb = item / nblk, nb = item % nblk, k0 = 64 * kb, n0 = 32 * nb;
#pragma unroll
    for (int i = 0; i < 32; ++i) { const int kk = 2 * i + (lane >> 5); scr[kk * 33 + (lane & 31)] = W[(size_t)(k0 + kk) * ldw + n0 + (lane & 31)]; }
    const int c = lane & 7;
    f32x4 sa = (f32x4){1.f, 1.f, 1.f, 1.f}, sb = sa;
    if (ksc) { sa = *(const f32x4*)(ksc + k0 + 8 * c); sb = *(const f32x4*)(ksc + k0 + 8 * c + 4); }
    asm volatile("s_waitcnt lgkmcnt(0)" ::: "memory");
#pragma unroll
    for (int j = 0; j < 4; ++j) { const int n = (lane >> 3) + 8 * j; const LAS float* s = scr + (8 * c) * 33 + n;
        u32x4 o; o.x = pk2(s[0 * 33] * sa.x, s[1 * 33] * sa.y); o.y = pk2(s[2 * 33] * sa.z, s[3 * 33] * sa.w); o.z = pk2(s[4 * 33] * sb.x, s[5 * 33] * sb.y); o.w = pk2(s[6 * 33] * sb.z, s[7 * 33] * sb.w);
        *(u32x4*)(WT + (size_t)((n0 + n) * rmul + radd) * K + k0 + 8 * c) = o; }
    asm volatile("s_waitcnt lgkmcnt(0)" ::: "memory");
}
DI void phase0(const Params& P, LAS unsigned char* lds) {
    const int tid = tid_(), lane = tid & 63, wave = tid >> 6, G = gridDim.x;
    unsigned char* ws = P.ws;
    LAS float* scr = (LAS float*)(lds + wave * 16384);
    const int gw = blockIdx.x * NWAVES + wave, NGW = G * NWAVES;
    constexpr int I_IN = 16 * 96;
    for (int it = gw; it < I_IN + 512; it += NGW) {
        if (it < I_IN) p0_transpose_item(P.in[I_WIN], DIN, 96, DM, (bf16_t*)(ws + WS_WIN), 1, 0, nullptr, scr, it, lane);
        else p0_transpose_item(P.in[I_WOUT], DM, 32, DM, (bf16_t*)(ws + WS_WOUT), 1, 0, nullptr, scr, it - I_IN, lane); }
    for (int s = blockIdx.x * NTHR + tid; s < 8192; s += G * NTHR) {
        const int l = s & 63, f = s >> 6, ks = f & 3, nt = (f >> 2) & 1, hb = (f >> 3) & 7, mat = f >> 6;
        const float* w = (mat ? P.in[I_RWI] : P.in[I_RWA]) + hb * 4096 + (16 * ks + 8 * (l >> 5)) * 64 + 32 * nt + (l & 31);
        u32x4 o; o.x = pk2(w[0], w[64]); o.y = pk2(w[128], w[192]); o.z = pk2(w[256], w[320]); o.w = pk2(w[384], w[448]);
        *(u32x4*)(ws + WS_RGW + (size_t)s * 16) = o;
    }
    __syncthreads();
    LAS float* EXT = (LAS float*)lds;
    for (int i = tid; i < 8192; i += NTHR) { const int k = i >> 3, c = i & 7, l = (k & 255) >> 2, q = k & 3, j = k >> 8;
        EXT[(((j * 4 + q) * 64 + l) << 3) + c] = P.in[I_WIN][(size_t)k * DIN + NPROJ + c]; }
    __syncthreads();
    const float* n1 = P.in[I_NORM1];
    f32x4 nw[4];
#pragma unroll
    for (int j = 0; j < 4; ++j) nw[j] = *(const f32x4*)(n1 + 4 * lane + 256 * j);
    for (int m = gw; m < NTOK; m += NGW) {
        const float* xrow = (m < NTOK_P) ? P.in[I_XP] + (size_t)m * DM : P.in[I_XS] + (size_t)(m - NTOK_P) * DM;
        f32x4 v[4]; float s = 0.f;
#pragma unroll
        for (int j = 0; j < 4; ++j) { v[j] = *(const f32x4*)(xrow + 4 * lane + 256 * j); s += (v[j].x * v[j].x + v[j].y * v[j].y) + (v[j].z * v[j].z + v[j].w * v[j].w); }
        const float rstd = rsqrtf(wave_sum(s) * (1.f / DM) + 1e-6f);
        float e[8];
#pragma unroll
        for (int c = 0; c < 8; ++c) e[c] = 0.f;
        bf16_t* orow = (bf16_t*)(ws + WS_HN) + (size_t)m * DM;
#pragma unroll
        for (int j = 0; j < 4; ++j) { v[j] = v[j] * rstd * nw[j];
            u32x2 w; w.x = pk2(v[j].x, v[j].y); w.y = pk2(v[j].z, v[j].w); *(u32x2*)(orow + 4 * lane + 256 * j) = w;
#pragma unroll
            for (int q = 0; q < 4; ++q) { const LAS f32x4* ep = (const LAS f32x4*)(EXT + (((j * 4 + q) * 64 + lane) << 3)); const f32x4 e0 = ep[0], e1 = ep[1]; const float hv = v[j][q];
                e[0] += hv * e0.x; e[1] += hv * e0.y; e[2] += hv * e0.z; e[3] += hv * e0.w; e[4] += hv * e1.x; e[5] += hv * e1.y; e[6] += hv * e1.z; e[7] += hv * e1.w; } }
        {
            const bool b0 = lane & 1, b1 = lane & 2, b2 = lane & 4;
            float k4[4], k2[2];
#pragma unroll
            for (int q = 0; q < 4; ++q) { const float snd = b0 ? e[q] : e[q + 4]; k4[q] = (b0 ? e[q + 4] : e[q]) + __shfl_xor(snd, 1); }
#pragma unroll
            for (int q = 0; q < 2; ++q) { const float snd = b1 ? k4[q] : k4[q + 2]; k2[q] = (b1 ? k4[q + 2] : k4[q]) + __shfl_xor(snd, 2); }
            const float snd = b2 ? k2[0] : k2[1]; float sv = (b2 ? k2[1] : k2[0]) + __shfl_xor(snd, 4);
            sv += __shfl_xor(sv, 8); sv += __shfl_xor(sv, 16); sv += __shfl_xor(sv, 32);
            const int col = (b0 ? 4 : 0) + (b1 ? 2 : 0) + (b2 ? 1 : 0);
            if (lane < 8) {
                if (col < 4) ((float*)(ws + WS_BETA))[m * 4 + col] = sigm(sv);
                else ((float*)(ws + WS_G))[m * 4 + col - 4] = -__expf(P.in[I_ALOG][col - 4]) * softplus(sv + P.in[I_DTB][col - 4]); } }
    }
}

DI void late_weights(const Params& P, LAS unsigned char* lds, int vb, int nb) {
    const int tid = tid_(), lane = tid & 63, wave = tid >> 6;
    unsigned char* ws = P.ws;
    LAS float* scr = (LAS float*)(lds + wave * 16384);
    constexpr int I_G = 16 * 88, I_D = 44 * 32, NIT = 2 * I_G + I_D;
    for (int it = vb * NWAVES + wave; it < NIT; it += nb * NWAVES) {
        int r = it;
        if (r < I_G) { p0_transpose_item(P.in[I_WG], DFF, 88, DM, (bf16_t*)(ws + WS_WGU), 2, 0, P.in[I_NORM2], scr, r, lane); continue; } r -= I_G;
        if (r < I_G) { p0_transpose_item(P.in[I_WU], DFF, 88, DM, (bf16_t*)(ws + WS_WGU), 2, 1, P.in[I_NORM2], scr, r, lane); continue; } r -= I_G;
        p0_transpose_item(P.in[I_WD], DM, 32, DFF, (bf16_t*)(ws + WS_WDN), 1, 0, nullptr, scr, r, lane);
    }
}

DI void gdn_chunk_item(const Params& P, LAS unsigned char* lds, int item) {
    const int tid = tid_(), lane = tid & 63, wave = tid >> 6;
    const int h = item & 3, bn = item >> 2, b = bn >> 5, n = bn & 31;
    const int m0 = b * 2048 + n * 64, cid = (b * 4 + h) * 32 + n;
    unsigned char* ws = P.ws;
    LAS float* QT = (LAS float*)lds; LAS float* KT = QT + 64 * 132; LAS float* VT = KT + 64 * 132;
    LAS float* LM = VT + 64 * 132; LAS float* QKM = LM + 64 * 68; LAS float* SM = QKM + 64 * 68;
    const bf16_t* PROJ = (const bf16_t*)(ws + WS_PROJ);
    if (tid < 384) {
        const int cg8 = tid % 48, tg = tid / 48, mat = cg8 >> 4, d0 = (cg8 & 15) * 8, ch = mat * 512 + h * 128 + d0;
        const bf16_t* src = PROJ + (size_t)(m0 + 8 * tg) * NPROJ + 1024 + ch;
        u32x4 raw[11];
        const bool hist = (n > 0 || tg > 0);
#pragma unroll
        for (int q = 0; q < 11; ++q) { if (q >= 3 || hist) raw[q] = *(const u32x4*)(src + (q - 3) * NPROJ); else raw[q] = (u32x4){0u, 0u, 0u, 0u}; }
        const float* cw = P.in[I_GCW] + ch;
        f32x4 wv[4][2];
#pragma unroll
        for (int j = 0; j < 4; ++j) { wv[j][0] = *(const f32x4*)(cw + j * 1536); wv[j][1] = *(const f32x4*)(cw + j * 1536 + 4); }
        LAS float* T = QT + mat * (64 * 132);
#pragma unroll
        for (int i = 0; i < 8; ++i) {
            f32x4 y0 = (f32x4){0.f, 0.f, 0.f, 0.f}, y1 = y0;
#pragma unroll
            for (int j = 0; j < 4; ++j) { const u32x4 x = raw[i + j];
                const f32x4 xa = (f32x4){__uint_as_float(x.x << 16), __uint_as_float(x.x & 0xffff0000u), __uint_as_float(x.y << 16), __uint_as_float(x.y & 0xffff0000u)};
                const f32x4 xb = (f32x4){__uint_as_float(x.z << 16), __uint_as_float(x.z & 0xffff0000u), __uint_as_float(x.w << 16), __uint_as_float(x.w & 0xffff0000u)};
                y0 += wv[j][0] * xa; y1 += wv[j][1] * xb; }
            f32x4 s0, s1;
#pragma unroll
            for (int e = 0; e < 4; ++e) { s0[e] = silu(y0[e]); s1[e] = silu(y1[e]); }
            *(LAS f32x4*)(T + (8 * tg + i) * 132 + d0) = s0; *(LAS f32x4*)(T + (8 * tg + i) * 132 + d0 + 4) = s1;
            if (n == 31 && tg == 7 && i >= 5) { const u32x4 x = raw[i + 3]; float* op = P.out + OUT_PGC + (size_t)(b * 3 + (i - 5)) * 1536 + ch;
                *(f32x4*)op = (f32x4){__uint_as_float(x.x << 16), __uint_as_float(x.x & 0xffff0000u), __uint_as_float(x.y << 16), __uint_as_float(x.y & 0xffff0000u)};
                *(f32x4*)(op + 4) = (f32x4){__uint_as_float(x.z << 16), __uint_as_float(x.z & 0xffff0000u), __uint_as_float(x.w << 16), __uint_as_float(x.w & 0xffff0000u)}; }
        }
    }
    if (tid < 64) {
        SM[128 + tid] = ((const float*)(ws + WS_BETA))[(m0 + tid) * 4 + h];
        float g = ((const float*)(ws + WS_G))[(m0 + tid) * 4 + h];
#pragma unroll
        for (int o = 1; o < 64; o <<= 1) { const float t = __shfl_up(g, o); if (lane >= o) g += t; }
        SM[tid] = g; SM[64 + tid] = __expf(g);
    }
    __syncthreads();
#pragma unroll 1
    for (int k = 0; k < 8; ++k) {
        const int i = 8 * wave + k;
        const float q0 = QT[i * 132 + lane], q1 = QT[i * 132 + 64 + lane], k0 = KT[i * 132 + lane], k1 = KT[i * 132 + 64 + lane];
        const float rq = rsqrtf(wave_sum(q0 * q0 + q1 * q1) + 1e-6f) * 0.08838834764831845f, rk = rsqrtf(wave_sum(k0 * k0 + k1 * k1) + 1e-6f);
        QT[i * 132 + lane] = q0 * rq; QT[i * 132 + 64 + lane] = q1 * rq; KT[i * 132 + lane] = k0 * rk; KT[i * 132 + 64 + lane] = k1 * rk;
    }
    __syncthreads();
    {
        const int which = wave >> 2, it = (wave >> 1) & 1, jt = wave & 1, r = lane & 31, hh = lane >> 5;
        LAS float* dst = which ? QKM : LM;
        f32x16 acc = zero16();
        if (!(it == 0 && jt == 1)) {
            const LAS float* Ar = (which ? QT : KT) + (32 * it + r) * 132 + 8 * hh;
            const LAS float* Br = KT + (32 * jt + r) * 132 + 8 * hh;
#pragma unroll
            for (int ks = 0; ks < 8; ++ks) {
                const bf16x8 a = pack8(*(const LAS f32x4*)(Ar + 16 * ks), *(const LAS f32x4*)(Ar + 16 * ks + 4));
                const bf16x8 bb = pack8(*(const LAS f32x4*)(Br + 16 * ks), *(const LAS f32x4*)(Br + 16 * ks + 4));
                acc = MFMA32(a, bb, acc);
            }
        }
        const int j = 32 * jt + r; const float gcj = SM[j];
#pragma unroll
        for (int reg = 0; reg < 16; ++reg) {
            const int i = 32 * it + crow(reg, hh); const float gci = SM[i];
            float v = 0.f;
            if (which == 0) { if (j < i) v = acc[reg] * SM[128 + i] * __expf(gci - gcj); }
            else { if (j <= i) v = acc[reg] * __expf(gci - gcj); }
            dst[i * 68 + j] = v;
        }
    }
    __syncthreads();
    {
        const float gcl = SM[63];
        bf16_t* QDF = (bf16_t*)(ws + WS_QDF) + (size_t)cid * 8192; bf16_t* KTF = (bf16_t*)(ws + WS_KTF) + (size_t)cid * 8192; bf16_t* QKF = (bf16_t*)(ws + WS_QKF) + (size_t)cid * 4096;
#pragma unroll 1
        for (int s = tid; s < 2560; s += NTHR) {
            const int l = s & 63, r = l & 31, hh = l >> 5, f = s >> 6;
            float v[8];
            if (f < 16) { const int mt = f >> 3, kk = f & 7, c = 32 * mt + r, db = 16 * kk + 4 * hh; const float sc = SM[64 + c];
#pragma unroll
                for (int e = 0; e < 8; ++e) v[e] = QT[c * 132 + db + 8 * (e >> 2) + (e & 3)] * sc;
                *(bf16x8*)(QDF + f * 512 + l * 8) = pack8v(v);
            } else if (f < 32) { const int f2 = f - 16, dmt = f2 >> 2, ks = f2 & 3, d = 32 * dmt + r, cb = 16 * ks + 4 * hh;
#pragma unroll
                for (int e = 0; e < 8; ++e) { const int c = cb + 8 * (e >> 2) + (e & 3); v[e] = KT[c * 132 + d] * __expf(gcl - SM[c]); }
                *(bf16x8*)(KTF + f2 * 512 + l * 8) = pack8v(v);
            } else { const int f3 = f - 32, mt = f3 >> 2, ks = f3 & 3, i = 32 * mt + r, cb = 16 * ks + 4 * hh;
#pragma unroll
                for (int e = 0; e < 8; ++e) v[e] = QKM[i * 68 + cb + 8 * (e >> 2) + (e & 3)];
                *(bf16x8*)(QKF + f3 * 512 + l * 8) = pack8v(v);
            }
        }
        if (tid == 0) ((float*)(ws + WS_GL))[cid] = __expf(gcl);
    }
    __syncthreads();
    LAS float* TM = QKM;
    {   const int r = lane & 31, hh = lane >> 5;
        if (wave < 2 && lane < 32) {
            const LAS float* Lb = vlaunder((const LAS float*)(LM + (32 * wave) * 68 + 32 * wave));
            float x[32];
#pragma unroll
            for (int i = 0; i < 32; ++i) x[i] = (i == lane) ? 1.f : 0.f;
#pragma unroll
            for (int ip = 1; ip < 32; ip += 2) {
                f32x4 la[8], lb[8];
#pragma unroll
                for (int j4 = 0; j4 < (ip + 3) / 4; ++j4) la[j4] = *(const LAS f32x4*)(Lb + ip * 68 + 4 * j4);
                if (ip + 1 < 32) {
#pragma unroll
                    for (int j4 = 0; j4 < (ip + 4) / 4; ++j4) lb[j4] = *(const LAS f32x4*)(Lb + (ip + 1) * 68 + 4 * j4); }
                {   const int i = ip; float a0 = 0.f, a1 = 0.f, a2 = 0.f, a3 = 0.f;
#pragma unroll
                    for (int j4 = 0; j4 < (i + 3) / 4; ++j4) { const f32x4 l4 = la[j4];
                        if (4 * j4 + 0 < i) a0 += l4.x * x[4 * j4 + 0]; if (4 * j4 + 1 < i) a1 += l4.y * x[4 * j4 + 1];
                        if (4 * j4 + 2 < i) a2 += l4.z * x[4 * j4 + 2]; if (4 * j4 + 3 < i) a3 += l4.w * x[4 * j4 + 3]; }
                    x[i] -= (a0 + a1) + (a2 + a3); }
                if (ip + 1 < 32) { const int i = ip + 1; float a0 = 0.f, a1 = 0.f, a2 = 0.f, a3 = 0.f;
#pragma unroll
                    for (int j4 = 0; j4 < (i + 3) / 4; ++j4) { const f32x4 l4 = lb[j4];
                        if (4 * j4 + 0 < i) a0 += l4.x * x[4 * j4 + 0]; if (4 * j4 + 1 < i) a1 += l4.y * x[4 * j4 + 1];
                        if (4 * j4 + 2 < i) a2 += l4.z * x[4 * j4 + 2]; if (4 * j4 + 3 < i) a3 += l4.w * x[4 * j4 + 3]; }
                    x[i] -= (a0 + a1) + (a2 + a3); }
                asm volatile("" ::: "memory"); __builtin_amdgcn_sched_barrier(0);
            }
            LAS float* Tb = vlaunder(TM + (32 * wave) * 68 + 32 * wave + lane);
#pragma unroll
            for (int i = 0; i < 32; ++i) Tb[i * 68] = x[i];
        } else if (wave == 2) {
#pragma unroll
            for (int q = 0; q < 16; ++q) { const int idx = q * 64 + lane; TM[(idx >> 5) * 68 + 32 + (idx & 31)] = 0.f; }
        }
        __syncthreads();
        if (wave == 0) {
            f32x16 M = zero16();
#pragma unroll
            for (int ks = 0; ks < 2; ++ks) { const LAS float* ap = LM + (32 + r) * 68 + 16 * ks + 8 * hh; float bv[8];
#pragma unroll
                for (int e = 0; e < 8; ++e) bv[e] = TM[(16 * ks + 8 * hh + e) * 68 + r];
                M = MFMA32(pack8(*(const LAS f32x4*)ap, *(const LAS f32x4*)(ap + 4)), pack8v(bv), M); }
            f32x16 T2 = zero16();
#pragma unroll
            for (int sx = 0; sx < 2; ++sx) { const LAS float* ap = TM + (32 + r) * 68 + 32 + 16 * sx + 4 * hh;
                T2 = MFMA32(pack8(*(const LAS f32x4*)ap, *(const LAS f32x4*)(ap + 8)), pack_step(M, sx), T2); }
#pragma unroll
            for (int reg = 0; reg < 16; ++reg) TM[(32 + crow(reg, hh)) * 68 + r] = -T2[reg];
        }
        __syncthreads();
        {
            bf16_t* WF = (bf16_t*)(ws + WS_WF) + (size_t)cid * 8192; bf16_t* UB = (bf16_t*)(ws + WS_UB) + (size_t)cid * 8192;
            const int dt = wave >> 1, ct = wave & 1, mt = wave >> 2, es = wave & 3;
            f32x16 aw = zero16(), au = zero16();
#pragma unroll
            for (int ks = 0; ks < 4; ++ks) {
                float av[8], bv[8];
#pragma unroll
                for (int e = 0; e < 8; ++e) { const int j = 16 * ks + 8 * hh + e; const float bj = SM[128 + j]; av[e] = KT[j * 132 + 32 * dt + r] * bj * SM[64 + j]; bv[e] = VT[j * 132 + 32 * es + r] * bj; }
                const LAS float* tw = TM + (32 * ct + r) * 68 + 16 * ks + 8 * hh; const LAS float* tu = TM + (32 * mt + r) * 68 + 16 * ks + 8 * hh;
                aw = MFMA32(pack8v(av), pack8(*(const LAS f32x4*)tw, *(const LAS f32x4*)(tw + 4)), aw);
                au = MFMA32(pack8(*(const LAS f32x4*)tu, *(const LAS f32x4*)(tu + 4)), pack8v(bv), au);
            }
            aw = aw * -1.f;
#pragma unroll
            for (int sx = 0; sx < 2; ++sx) *(bf16x8*)(WF + (ct * 8 + 2 * dt + sx) * 512 + lane * 8) = pack_step(aw, sx);
#pragma unroll
            for (int sx = 0; sx < 2; ++sx) *(bf16x8*)(UB + ((es * 2 + mt) * 64 + lane) * 16 + 8 * sx) = pack_step(au, sx);
        }
    }
    __syncthreads();
}

DI void rg_tile_item(const Params& P, LAS unsigned char* lds, int T) {
    const int tid = tid_(), lane = tid & 63, wave = tid >> 6, r = lane & 31, hh = lane >> 5;
    unsigned char* ws = P.ws;
    LAS bf16_t* XC = (LAS bf16_t*)lds + wave * (64 * 72);
    const bf16_t* PROJ = (const bf16_t*)(ws + WS_PROJ);
    const int m0 = 64 * T; const bool prm = T < 256; const int sq0 = prm ? 0 : (m0 - NTOK_P) / 8;
    {
        const int c = 64 * wave + lane;
        const float* cw = P.in[I_RCW]; const float w0 = cw[c], w1 = cw[512 + c], w2 = cw[1024 + c], w3 = cw[1536 + c], cb = P.in[I_RCB][c];
        const bf16_t* src = PROJ + (size_t)m0 * NPROJ + c;
        float x3 = 0.f, x2 = 0.f, x1 = 0.f;
        if (prm && (T & 31) != 0) { x3 = bf2f(src[-3 * NPROJ]); x2 = bf2f(src[-2 * NPROJ]); x1 = bf2f(src[-NPROJ]); }
        const float* rcs = P.in[I_SRC];
        float xr[64];
#pragma unroll
        for (int i = 0; i < 64; ++i) xr[i] = bf2f(src[i * NPROJ]);
#pragma unroll
        for (int i = 0; i < 64; ++i) {
            const int seq = sq0 + (i >> 3);
            if (!prm && (i & 7) == 0) { x3 = rcs[(size_t)(seq * 3 + 0) * 512 + c]; x2 = rcs[(size_t)(seq * 3 + 1) * 512 + c]; x1 = rcs[(size_t)(seq * 3 + 2) * 512 + c]; }
            const float x0 = xr[i];
            XC[i * 72 + lane] = (bf16_t)f2bf(w0 * x3 + w1 * x2 + w2 * x1 + w3 * x0 + cb);
            if (prm) { if ((T & 31) == 31 && i >= 61) P.out[OUT_PRC + (size_t)((T >> 5) * 3 + (i - 61)) * 512 + c] = x0; }
            else { if ((i & 7) >= 5) P.out[OUT_SRC + (size_t)(seq * 3 + (i & 7) - 5) * 512 + c] = x0; }
            x3 = x2; x2 = x1; x1 = x0;
        }
    }
    asm volatile("s_waitcnt lgkmcnt(0)" ::: "memory");
    const bf16x8* RGW = (const bf16x8*)(ws + WS_RGW);
#pragma unroll 1
    for (int nt = 0; nt < 2; ++nt) {
        f32x16 aa[2], ai[2]; aa[0] = zero16(); aa[1] = zero16(); ai[0] = zero16(); ai[1] = zero16();
#pragma unroll
        for (int ks = 0; ks < 4; ++ks) {
            const bf16x8 bfa = RGW[(((0 * 8 + wave) * 2 + nt) * 4 + ks) * 64 + lane], bfi = RGW[(((1 * 8 + wave) * 2 + nt) * 4 + ks) * 64 + lane];
#pragma unroll
            for (int mt = 0; mt < 2; ++mt) { const bf16x8 a = *(const LAS bf16x8*)(XC + (32 * mt + r) * 72 + 16 * ks + 8 * hh);
                aa[mt] = MFMA32(a, bfa, aa[mt]); ai[mt] = MFMA32(a, bfi, ai[mt]); }
        }
        const int j = 64 * wave + 32 * nt + r;
        const float ba = P.in[I_RBA][j], bi = P.in[I_RBI][j], spl = -8.f * softplus(-P.in[I_LAM][j]);
        float Cc = 0.f, Pp = 1.f;
        const bf16_t* projb = PROJ + (size_t)(m0 + 4 * hh) * NPROJ + 512 + j;
        bf16_t yv[32];
#pragma unroll
        for (int q = 0; q < 32; ++q) yv[q] = projb[(size_t)(32 * (q >> 4) + 8 * ((q >> 2) & 3) + (q & 3)) * NPROJ];
        bf16_t* mixb = (bf16_t*)(ws + WS_MIX) + (size_t)(m0 + 4 * hh) * DM + j;
        bf16_t* gab = (bf16_t*)(ws + WS_GA) + (size_t)(m0 + 4 * hh) * 512 + j;
#pragma unroll
        for (int Gi = 0; Gi < 8; ++Gi) {
            const int mt = Gi >> 2, g = Gi & 3;
            bf16_t* mb = vlaunder(mixb); bf16_t* gb = vlaunder(gab);
            float Hl[4], Ac[4];
#pragma unroll
            for (int k = 0; k < 4; ++k) { const int reg = 4 * g + k, t = 32 * mt + 8 * g + 4 * hh + k;
                const float rg_ = sigm(aa[mt][reg] + ba), ig = sigm(ai[mt][reg] + bi), la = spl * rg_, a = __expf(la), mult = __builtin_amdgcn_sqrtf(one_minus_exp(2.f * la, a * a));
                const float u = mult * ig * bf2f(XC[t * 72 + 32 * nt + r]);
                if (k == 0) { Hl[0] = u; Ac[0] = a; } else { Hl[k] = a * Hl[k - 1] + u; Ac[k] = a * Ac[k - 1]; } }
            const float Ag = Ac[3], Hg = Hl[3], pA = __shfl_xor(Ag, 32), pH = __shfl_xor(Hg, 32);
            const int seq = sq0 + Gi;
            if (!prm) { Cc = P.in[I_SRH][(size_t)seq * 512 + j]; Pp = 1.f; }
            float cin, pin, Cn, Pn;
            if (hh == 0) { cin = Cc; pin = Pp; Cn = pA * (Ag * Cc + Hg) + pH; Pn = Pp * Ag * pA; }
            else { cin = pA * Cc + pH; pin = Pp * pA; Cn = Ag * cin + Hg; Pn = Pp * pA * Ag; }
#pragma unroll
            for (int k = 0; k < 4; ++k) { const int tt = 32 * mt + 8 * g + k;
                const float hv = Hl[k] + Ac[k] * cin, gy = gelu_tanh(bf2f(yv[4 * Gi + k]));
                mb[(size_t)tt * DM] = (bf16_t)f2bf(gy * hv);
                if (prm) gb[(size_t)tt * 512] = (bf16_t)f2bf(gy * Ac[k] * pin);
                else if (hh == 1 && k == 3) P.out[OUT_SRH + (size_t)seq * 512 + j] = hv; }
            Cc = Cn; Pp = Pn;
            asm volatile("" ::: "memory"); __builtin_amdgcn_sched_barrier(0);
        }
        if (prm && hh == 0) { ((float*)(ws + WS_SEGA))[T * 512 + j] = Pp; ((float*)(ws + WS_SEGH))[T * 512 + j] = Cc; }
    }
    asm volatile("s_waitcnt lgkmcnt(0)" ::: "memory");
}

constexpr int SEQ_BUF = 49152;
DI void seq_step(f32x16 (&S)[4], const LAS unsigned char* bw, bf16_t* SNB, bf16_t* VNB, int cid, int es, int lane, float gl) {
    bf16x8 Sb[8];
#pragma unroll
    for (int dt = 0; dt < 4; ++dt) { Sb[2 * dt] = pack_step(S[dt], 0); Sb[2 * dt + 1] = pack_step(S[dt], 1); }
#pragma unroll
    for (int kk = 0; kk < 8; ++kk) *(bf16x8*)(SNB + (size_t)cid * 16384 + (es * 8 + kk) * 512 + lane * 8) = Sb[kk];
    f32x16 vacc[2];
#pragma unroll
    for (int mt = 0; mt < 2; ++mt) { const LAS u32x4* up = (const LAS u32x4*)(bw + 32768 + ((es * 2 + mt) * 64 + lane) * 32); const u32x4 u0 = up[0], u1 = up[1];
#pragma unroll
        for (int i = 0; i < 4; ++i) { vacc[mt][2 * i] = __uint_as_float(u0[i] << 16); vacc[mt][2 * i + 1] = __uint_as_float(u0[i] & 0xffff0000u);
            vacc[mt][8 + 2 * i] = __uint_as_float(u1[i] << 16); vacc[mt][8 + 2 * i + 1] = __uint_as_float(u1[i] & 0xffff0000u); } }
#pragma unroll
    for (int mt = 0; mt < 2; ++mt)
#pragma unroll
        for (int kk = 0; kk < 8; ++kk) vacc[mt] = MFMA32(*(const LAS bf16x8*)(bw + ((mt * 8 + kk) * 64 + lane) * 16), Sb[kk], vacc[mt]);
    bf16x8 vb[4];
#pragma unroll
    for (int ct = 0; ct < 2; ++ct) { vb[2 * ct] = pack_step(vacc[ct], 0); vb[2 * ct + 1] = pack_step(vacc[ct], 1); }
#pragma unroll
    for (int ks = 0; ks < 4; ++ks) *(bf16x8*)(VNB + (size_t)cid * 8192 + (es * 4 + ks) * 512 + lane * 8) = vb[ks];
#pragma unroll
    for (int dt = 0; dt < 4; ++dt) { S[dt] = S[dt] * gl;
#pragma unroll
        for (int ks = 0; ks < 4; ++ks) S[dt] = MFMA32(*(const LAS bf16x8*)(bw + 16384 + ((dt * 4 + ks) * 64 + lane) * 16), vb[ks], S[dt]); }
}
DI void gdn_seq_block(const Params& P, LAS unsigned char* lds, int bh) {
    const int tid = tid_(), lane = tid & 63, wave = __builtin_amdgcn_readfirstlane(tid >> 6), r = lane & 31, hh = lane >> 5;
    unsigned char* ws = P.ws;
    const unsigned char* gW = ws + WS_WF + (size_t)bh * 32 * 16384; const unsigned char* gK = ws + WS_KTF + (size_t)bh * 32 * 16384; const unsigned char* gU = ws + WS_UB + (size_t)bh * 32 * 16384;
    bf16_t* SNB = (bf16_t*)P.out; bf16_t* VNB = (bf16_t*)((unsigned char*)P.out + 32 * MiB);
    const float glv = (lane < 32) ? ((const float*)(ws + WS_GL))[bh * 32 + lane] : 0.f;
    f32x16 S[4]; S[0] = zero16(); S[1] = zero16(); S[2] = zero16(); S[3] = zero16();
    const int es = wave & 3, lt = tid - 256;
#define SEQ_STAGE(nn, bb) do { _Pragma("unroll") for (int q = 0; q < 12; ++q) { const unsigned char* g_ = (q < 4 ? gW : q < 8 ? gK : gU) + (size_t)(nn) * 16384 + ((q & 3) * 256 + lt) * 16; \
        __builtin_amdgcn_global_load_lds((const unsigned*)g_, (LAS unsigned*)(lds + (bb) * SEQ_BUF + (q >> 2) * 16384 + (q & 3) * 4096 + (wave - 4) * 1024), 16, 0, 0); } } while (0)
    if (wave >= 4) {
        SEQ_STAGE(0, 0); SEQ_STAGE(1, 1); asm volatile("s_waitcnt vmcnt(12)" ::: "memory");
        __builtin_amdgcn_s_barrier(); asm volatile("" ::: "memory");
        int bn = 2;
#pragma unroll 1
        for (int n = 0; n < 32; ++n) {
            const int ns = (n + 2 < 32) ? n + 2 : 31; SEQ_STAGE(ns, bn); asm volatile("s_waitcnt vmcnt(12)" ::: "memory");
            __builtin_amdgcn_s_barrier(); asm volatile("" ::: "memory");
            bn = (bn == 2) ? 0 : bn + 1;
        }
        asm volatile("s_waitcnt vmcnt(0)" ::: "memory");
    } else {
        __builtin_amdgcn_s_barrier(); asm volatile("" ::: "memory");
        int bc = 0;
#pragma unroll 1
        for (int n = 0; n < 32; ++n) {
            seq_step(S, lds + bc * SEQ_BUF, SNB, VNB, bh * 32 + n, es, lane, __shfl(glv, n));
            asm volatile("s_waitcnt lgkmcnt(0)" ::: "memory"); __builtin_amdgcn_s_barrier(); asm volatile("" ::: "memory");
            bc = (bc == 2) ? 0 : bc + 1;
        }
    }
    __syncthreads();
#undef SEQ_STAGE
    if (wave < 4) {
        const int e0 = 32 * es;
#pragma unroll
        for (int dt = 0; dt < 4; ++dt)
#pragma unroll
            for (int reg = 0; reg < 16; ++reg) P.out[OUT_PGS + ((size_t)bh * 128 + 32 * dt + crow(reg, hh)) * 128 + e0 + r] = S[dt][reg];
    }
}

DI void gdn_out_item(const Params& P, LAS unsigned char* lds, int cid) {
    const int tid = tid_(), lane = tid & 63, wave = tid >> 6, r = lane & 31, hh = lane >> 5;
    unsigned char* ws = P.ws;
    const int bh = cid >> 5, n = cid & 31, b = bh >> 2, h = bh & 3, mt = wave >> 2, es = wave & 3;
    const bf16_t* SNB = (const bf16_t*)P.out; const bf16_t* VNB = (const bf16_t*)((const unsigned char*)P.out + 32 * MiB);
    const bf16_t* PROJ = (const bf16_t*)(ws + WS_PROJ);
    LAS float* OB = (LAS float*)lds;
    bf16x8 a1[8], b1[8], a2[4], b2[4];
#pragma unroll
    for (int kk = 0; kk < 8; ++kk) { a1[kk] = *(const bf16x8*)((const bf16_t*)(ws + WS_QDF) + (size_t)cid * 8192 + (mt * 8 + kk) * 512 + lane * 8); b1[kk] = *(const bf16x8*)(SNB + (size_t)cid * 16384 + (es * 8 + kk) * 512 + lane * 8); }
#pragma unroll
    for (int ks = 0; ks < 4; ++ks) { a2[ks] = *(const bf16x8*)((const bf16_t*)(ws + WS_QKF) + (size_t)cid * 4096 + (mt * 4 + ks) * 512 + lane * 8); b2[ks] = *(const bf16x8*)(VNB + (size_t)cid * 8192 + (es * 4 + ks) * 512 + lane * 8); }
    const size_t mb = (size_t)b * 2048 + 64 * n + 8 * wave;
    unsigned zr[8];
#pragma unroll
    for (int k = 0; k < 8; ++k) zr[k] = *(const unsigned*)(PROJ + (mb + k) * NPROJ + 2560 + 128 * h + 2 * lane);
    f32x16 oacc = zero16();
#pragma unroll
    for (int kk = 0; kk < 8; ++kk) oacc = MFMA32(a1[kk], b1[kk], oacc);
#pragma unroll
    for (int ks = 0; ks < 4; ++ks) oacc = MFMA32(a2[ks], b2[ks], oacc);
#pragma unroll
    for (int reg = 0; reg < 16; ++reg) OB[(32 * mt + crow(reg, hh)) * 132 + 32 * es + r] = oacc[reg];
    __syncthreads();
    const float gw0 = P.in[I_GNW][2 * lane], gw1 = P.in[I_GNW][2 * lane + 1];
#pragma unroll
    for (int k = 0; k < 8; ++k) { const int c = 8 * wave + k;
        const f32x2 o = *(const LAS f32x2*)(OB + c * 132 + 2 * lane);
        const float rstd = rsqrtf(wave_sum(o.x * o.x + o.y * o.y) * (1.f / 128.f) + 1e-6f);
        bf16_t* mp = (bf16_t*)(ws + WS_MIX) + (mb + k) * DM + 512 + 128 * h;
        *(unsigned*)(mp + 2 * lane) = pk2(o.x * rstd * gw0 * silu(__uint_as_float(zr[k] << 16)), o.y * rstd * gw1 * silu(__uint_as_float(zr[k] & 0xffff0000u))); }
    __syncthreads();
}

DI void gdn_sample_item(const Params& P, LAS unsigned char* lds, int s, int h) {
    const int tid = tid_(), lane = tid & 63, wave = tid >> 6;
    unsigned char* ws = P.ws;
    LAS float* Q = (LAS float*)lds; LAS float* K = Q + 1024; LAS float* V = K + 1024; LAS float* Uu = V + 1024; LAS float* Ww = Uu + 1024; LAS float* Oo = Ww + 1024;
    LAS float* RED = Oo + 1024;
    LAS float* SMs = RED + 8192;
    const bf16_t* PROJ = (const bf16_t*)(ws + WS_PROJ);
    const int m0 = NTOK_P + 8 * s;
    float Sr[32];
    {   const float* S0 = P.in[I_SGS] + ((size_t)(s * 4 + h) * 128 + 32 * (tid >> 7)) * 128 + (tid & 127);
#pragma unroll
        for (int k = 0; k < 32; ++k) Sr[k] = S0[(size_t)k * 128]; }
    const bf16_t zq0 = PROJ[(size_t)(m0 + wave) * NPROJ + 2560 + 128 * h + lane], zq1 = PROJ[(size_t)(m0 + wave) * NPROJ + 2560 + 128 * h + 64 + lane];
    const float gq = ((const float*)(ws + WS_G))[(m0 + (lane & 7)) * 4 + h], bq = ((const float*)(ws + WS_BETA))[(m0 + (lane & 7)) * 4 + h];
    const float gnw0 = P.in[I_GNW][lane], gnw1 = P.in[I_GNW][lane + 64];
    if (tid < 384) {
        const int mat = tid >> 7, d = tid & 127, ch = mat * 512 + h * 128 + d;
        const float* cw = P.in[I_GCW]; const float w0 = cw[ch], w1 = cw[1536 + ch], w2 = cw[3072 + ch], w3 = cw[4608 + ch];
        const float* st = P.in[I_SGC] + (size_t)s * 3 * 1536 + ch;
        float x3 = st[0], x2 = st[1536], x1 = st[3072];
        LAS float* T = Q + mat * 1024;
#pragma unroll
        for (int t = 0; t < 8; ++t) { const float x0 = bf2f(PROJ[(size_t)(m0 + t) * NPROJ + 1024 + ch]);
            T[t * 128 + d] = silu(w0 * x3 + w1 * x2 + w2 * x1 + w3 * x0);
            if (t >= 5) P.out[OUT_SGC + (size_t)(s * 3 + t - 5) * 1536 + ch] = x0;
            x3 = x2; x2 = x1; x1 = x0; }
    }
    if (tid >= 448) {
        const int t = lane & 7;
        float g = gq; const float bt = bq;
#pragma unroll
        for (int o = 1; o < 8; o <<= 1) { const float v = __shfl_up(g, o); if (t >= o) g += v; }
        const float tot = __shfl(g, 7);
        if (lane < 8) { SMs[t] = g; SMs[8 + t] = __expf(g); SMs[16 + t] = bt; SMs[24 + t] = __expf(tot - g); } }
    __syncthreads();
    {   const int i = wave;
        const float q0 = Q[i * 128 + lane], q1 = Q[i * 128 + 64 + lane], k0 = K[i * 128 + lane], k1 = K[i * 128 + 64 + lane];
        const float rq = rsqrtf(wave_sum(q0 * q0 + q1 * q1) + 1e-6f) * 0.08838834764831845f, rk = rsqrtf(wave_sum(k0 * k0 + k1 * k1) + 1e-6f);
        Q[i * 128 + lane] = q0 * rq; Q[i * 128 + 64 + lane] = q1 * rq; K[i * 128 + lane] = k0 * rk; K[i * 128 + 64 + lane] = k1 * rk; }
    __syncthreads();
    if (tid < 128) { const int which = tid >> 6, i = (tid >> 3) & 7, j = tid & 7;
        const LAS float* a = (which ? Q : K) + i * 128; const LAS float* bq = K + j * 128; float dot = 0.f;
        for (int d = 0; d < 128; ++d) dot += a[d] * bq[d];
        const float dec = __expf(SMs[i] - SMs[j]);
        if (which == 0) SMs[32 + i * 8 + j] = (j < i) ? dot * SMs[16 + i] * dec : 0.f;
        else SMs[96 + i * 8 + j] = (j <= i) ? dot * dec : 0.f; }
    __syncthreads();
    if (tid < 256) { const bool isw = tid >= 128; const int ci = tid & 127; float x[8];
#pragma unroll
        for (int i = 0; i < 8; ++i) { float acc = (isw ? K : V)[i * 128 + ci] * SMs[16 + i]; if (isw) acc *= SMs[8 + i];
#pragma unroll
            for (int j = 0; j < 8; ++j) if (j < i) acc -= SMs[32 + i * 8 + j] * x[j];
            x[i] = acc; (isw ? Ww : Uu)[i * 128 + ci] = acc; } }
    __syncthreads();
    {   const int e = tid & 127, dq = tid >> 7;
        float pv[8], po[8];
#pragma unroll
        for (int c = 0; c < 8; ++c) { pv[c] = 0.f; po[c] = 0.f; }
#pragma unroll
        for (int k4 = 0; k4 < 8; ++k4) { const int d = 32 * dq + 4 * k4;
#pragma unroll
            for (int c = 0; c < 8; ++c) { const f32x4 w4 = *(const LAS f32x4*)(Ww + c * 128 + d), q4 = *(const LAS f32x4*)(Q + c * 128 + d);
                pv[c] += (w4.x * Sr[4 * k4] + w4.y * Sr[4 * k4 + 1]) + (w4.z * Sr[4 * k4 + 2] + w4.w * Sr[4 * k4 + 3]);
                po[c] += (q4.x * Sr[4 * k4] + q4.y * Sr[4 * k4 + 1]) + (q4.z * Sr[4 * k4 + 2] + q4.w * Sr[4 * k4 + 3]); } }
#pragma unroll
        for (int c = 0; c < 8; ++c) { RED[(dq * 16 + c) * 128 + e] = pv[c]; RED[(dq * 16 + 8 + c) * 128 + e] = po[c] * SMs[8 + c]; }
        __syncthreads();
        float vn[8];
#pragma unroll
        for (int c = 0; c < 8; ++c) vn[c] = Uu[c * 128 + e] - ((RED[(0 * 16 + c) * 128 + e] + RED[(1 * 16 + c) * 128 + e]) + (RED[(2 * 16 + c) * 128 + e] + RED[(3 * 16 + c) * 128 + e]));
        const float gl = SMs[15];
        float* So = P.out + OUT_SGS + ((size_t)(s * 4 + h) * 128 + 32 * dq) * 128 + e;
        float kv[8];
#pragma unroll
        for (int c = 0; c < 8; ++c) kv[c] = SMs[24 + c] * vn[c];
#pragma unroll
        for (int k4 = 0; k4 < 8; ++k4) { const int d = 32 * dq + 4 * k4; f32x4 acc = (f32x4){Sr[4 * k4] * gl, Sr[4 * k4 + 1] * gl, Sr[4 * k4 + 2] * gl, Sr[4 * k4 + 3] * gl};
#pragma unroll
            for (int c = 0; c < 8; ++c) acc += *(const LAS f32x4*)(K + c * 128 + d) * kv[c];
            So[(size_t)(4 * k4) * 128] = acc.x; So[(size_t)(4 * k4 + 1) * 128] = acc.y; So[(size_t)(4 * k4 + 2) * 128] = acc.z; So[(size_t)(4 * k4 + 3) * 128] = acc.w; }
        if (dq == 0) {
#pragma unroll
            for (int c = 0; c < 8; ++c) { float o = (RED[(0 * 16 + 8 + c) * 128 + e] + RED[(1 * 16 + 8 + c) * 128 + e]) + (RED[(2 * 16 + 8 + c) * 128 + e] + RED[(3 * 16 + 8 + c) * 128 + e]);
#pragma unroll
                for (int j = 0; j < 8; ++j) if (j <= c) o += SMs[96 + c * 8 + j] * vn[j];
                Oo[c * 128 + e] = o; } }
    }
    __syncthreads();
    {   const int c = wave; const size_t m = m0 + c;
        const float o0 = Oo[c * 128 + lane], o1 = Oo[c * 128 + 64 + lane];
        const float rstd = rsqrtf(wave_sum(o0 * o0 + o1 * o1) * (1.f / 128.f) + 1e-6f);
        const float z0 = bf2f(zq0), z1 = bf2f(zq1);
        bf16_t* mp = (bf16_t*)(ws + WS_MIX) + m * DM + 512 + 128 * h;
        mp[lane] = (bf16_t)f2bf(o0 * rstd * gnw0 * silu(z0)); mp[lane + 64] = (bf16_t)f2bf(o1 * rstd * gnw1 * silu(z1)); }
    __syncthreads();
}

DI void rg_fix_item(const Params& P, int b, int n) {
    const int c = tid_(); unsigned char* ws = P.ws;
    const float* SA = (const float*)(ws + WS_SEGA); const float* SH = (const float*)(ws + WS_SEGH);
    float Cc = 0.f;
    {   float sa[31], sh[31];
#pragma unroll
        for (int j = 0; j < 31; ++j) { const int Tj = b * 32 + j; sa[j] = (j < n) ? SA[Tj * 512 + c] : 1.f; sh[j] = (j < n) ? SH[Tj * 512 + c] : 0.f; }
#pragma unroll
        for (int j = 0; j < 31; ++j) Cc = sa[j] * Cc + sh[j]; }
    bf16_t* MIX = (bf16_t*)(ws + WS_MIX); const bf16_t* GA = (const bf16_t*)(ws + WS_GA);
    const size_t mb = (size_t)b * 2048 + 64 * n;
#pragma unroll 1
    for (int i0 = 0; i0 < 64; i0 += 32) {
        bf16_t mx[32], ga[32];
#pragma unroll
        for (int i = 0; i < 32; ++i) { const size_t m = mb + i0 + i; mx[i] = MIX[m * DM + c]; ga[i] = GA[m * 512 + c]; }
#pragma unroll
        for (int i = 0; i < 32; ++i) { const size_t m = mb + i0 + i; MIX[m * DM + c] = (bf16_t)f2bf(bf2f(mx[i]) + bf2f(ga[i]) * Cc); }
    }
    if (n == 31) { const int Tj = b * 32 + 31; P.out[OUT_PRH + (size_t)b * 512 + c] = SA[Tj * 512 + c] * Cc + SH[Tj * 512 + c]; }
}

__global__ void __launch_bounds__(NTHR, 2) hybrid_fwd(Params Pk) {
    extern __shared__ __attribute__((aligned(16))) unsigned char lds_raw[];
    LAS unsigned char* lds = (LAS unsigned char*)lds_raw;
    cg::grid_group grid = cg::this_grid();
    const int G = gridDim.x;
    volatile LAS unsigned* bst = (volatile LAS unsigned*)(lds + (LDS_BYTES - 64));
    if (threadIdx.x < 2) bst[threadIdx.x] = 0u;
    __syncthreads();
    XcdBarrier xb; { const Params P = load_params(); xb = xcd_barrier_post((unsigned*)(P.ws + WS_CTL), bst); }
    int n_stamp = 0;
#define STAMP() do { if (PROBE_T && blockIdx.x == 0 && threadIdx.x == 0) bst[4 + n_stamp] = (unsigned)__builtin_amdgcn_s_memrealtime(); ++n_stamp; } while (0)
    STAMP();

    { const Params P = load_params(); phase0(P, lds); }
    if (PROBE == 10) { __syncthreads(); const Params P = load_params(); phase0(P, lds); }
    if (Pk.ws == nullptr) grid.sync();
    xcd_barrier(xb); if (PROBE == 20) xcd_barrier(xb); STAMP();
    {   const Params P = load_params(); unsigned char* ws = P.ws;
        pg8::Gemm g{(const bf16_t*)(ws + WS_HN), (const bf16_t*)(ws + WS_WIN), NTOK_P, NPROJ, DM, DM}; pg8::StaticOrder S; S.init(NTOK_P, NPROJ, G, (int)blockIdx.x);
        EpiProj E{(bf16_t*)(ws + WS_PROJ), NPROJ};
        pg8::gemm_phase<EpiProj, pg8::StaticOrder, true, true>(lds, g, S, E);
        if (PROBE == 11) pg8::gemm_phase<EpiProj, pg8::StaticOrder, true, true>(lds, g, S, E); }
    xcd_barrier(xb); if (PROBE == 20) xcd_barrier(xb); STAMP();
    {
        const int bx = (int)blockIdx.x;
        if (bx < 48) {
            const Params P = load_params(); unsigned char* ws = P.ws;
            pg8::Gemm g{(const bf16_t*)(ws + WS_HN), (const bf16_t*)(ws + WS_WIN), NTOK, NPROJ, DM, DM}; SampleOrder3 S{bx};
            EpiProj E{(bf16_t*)(ws + WS_PROJ), NPROJ};
            pg8::gemm_phase<EpiProj, SampleOrder3, true, true>(lds, g, S, E);
            __syncthreads(); }
        const int nmine = (G == 256 && bx < 48) ? 3 : 4;
        for (int k = 0; k < nmine; ++k) { const int it = bx + k * G; if (it < 1024) { const Params P = load_params(); gdn_chunk_item(P, lds, it); } }
        if (G == 256 && bx >= 48 && bx < 96) { const Params P = load_params(); gdn_chunk_item(P, lds, 768 + bx - 48); }
        for (int it = bx; it < 256; it += G) { const Params P = load_params(); rg_tile_item(P, lds, it); __syncthreads(); }
        if (G != 256) { const Params P = load_params(); late_weights(P, lds, bx, G); }
        else if (bx >= 96) { const Params P = load_params(); late_weights(P, lds, bx - 96, 160); }
    }
    xcd_barrier(xb); if (PROBE == 20) xcd_barrier(xb); STAMP();
    if (blockIdx.x < 32) { for (int rep = 0; rep < (PROBE == 4 ? 2 : 1); ++rep) { const Params P = load_params(); gdn_seq_block(P, lds, blockIdx.x); } }
    else {
        for (int it = blockIdx.x - 32; it < 512; it += G - 32) { const Params P = load_params(); gdn_sample_item(P, lds, it >> 2, it & 3); }
        {   const int nb = (int)blockIdx.x - 32 - 64;
            if (nb >= 0 && nb < 16) { const Params P = load_params(); rg_tile_item(P, lds, 256 + nb); __syncthreads(); } }
        for (int q = blockIdx.x - 32; q < 248; q += G - 32) { const Params P = load_params(); rg_fix_item(P, q / 31, 1 + q % 31); }
    }
    if (PROBE_T >= 10) { asm volatile("s_waitcnt vmcnt(0)" ::: "memory"); __syncthreads(); if (threadIdx.x == 0) { const Params P = load_params(); ((unsigned*)(P.ws + WS_CTL))[16000 + blockIdx.x] = (unsigned)__builtin_amdgcn_s_memrealtime(); } }
    xcd_barrier(xb); if (PROBE == 20) xcd_barrier(xb); STAMP();
    {
        const int bx = (int)blockIdx.x; const int nmine = (G == 256 && bx >= 192) ? 3 : 4;
        for (int k = 0; k < nmine; ++k) { const int it = bx + k * G; if (it < 1024) { const Params P = load_params(); gdn_out_item(P, lds, it); } }
        if (G == 256 && bx < 64) { const Params P = load_params(); gdn_out_item(P, lds, 960 + bx); }
        if (G != 256) for (int it = bx + 4 * G; it < 1024; it += G) { const Params P = load_params(); gdn_out_item(P, lds, it); } }
    {
        const Params P = load_params(); unsigned char* ws = P.ws;
        pg8::Gemm g{(const bf16_t*)(ws + WS_MIX), (const bf16_t*)(ws + WS_WOUT), NTOK, DM, 256, DM}; SplitOrder2 S{G, G - 1 - (int)blockIdx.x};
        EpiX2Split E{(float*)(ws + WS_SLAB2)};
        pg8::gemm_phase<EpiX2Split, SplitOrder2, true, true>(lds, g, S, E); }
    xcd_barrier(xb); if (PROBE == 20) xcd_barrier(xb); STAMP();
    {   const Params P = load_params(); unsigned char* ws = P.ws;
        pg8::Gemm g{(const bf16_t*)(ws + WS_MIX), (const bf16_t*)(ws + WS_WOUT), NTOK_P, DM, DM, DM}; pg8::StaticOrder S; S.init(NTOK_P, DM, G, (int)blockIdx.x);
        {
            const int tid = tid_(), lane = tid & 63, wave = tid >> 6;
            for (int m = blockIdx.x * NWAVES + wave; m < NTOK - NTOK_P; m += G * NWAVES) {
                const float* xr = P.in[I_XS] + (size_t)m * DM + 4 * lane; const float* sl = (const float*)(ws + WS_SLAB2) + (size_t)m * DM + 4 * lane;
                f32x4 v[4]; float ssum = 0.f;
#pragma unroll
                for (int j = 0; j < 4; ++j) { v[j] = *(const f32x4*)(xr + 256 * j);
#pragma unroll
                    for (int q = 0; q < 4; ++q) v[j] += *(const f32x4*)(sl + (size_t)q * (1024 * 1024) + 256 * j);
                    ssum += (v[j].x * v[j].x + v[j].y * v[j].y) + (v[j].z * v[j].z + v[j].w * v[j].w);
                    u32x2 w; w.x = pk2(v[j].x, v[j].y); w.y = pk2(v[j].z, v[j].w); *(u32x2*)((bf16_t*)(ws + WS_X1B) + (size_t)(NTOK_P + m) * DM + 4 * lane + 256 * j) = w; }
                ssum = wave_sum(ssum); if (lane == 0) ((float*)(ws + WS_SS1))[NTOK_P + m] = ssum; }
            __syncthreads(); }
        if (PROBE == 12) { EpiX1T<false> E0{P.in[I_XP], P.in[I_XS], (bf16_t*)(ws + WS_X1B), (float*)(ws + WS_SS1)}; pg8::gemm_phase<EpiX1T<false>, pg8::StaticOrder, true, true>(lds, g, S, E0); }
        EpiX1T<true> E{P.in[I_XP], P.in[I_XS], (bf16_t*)(ws + WS_X1B), (float*)(ws + WS_SS1)};
        pg8::gemm_phase<EpiX1T<true>, pg8::StaticOrder, true, true>(lds, g, S, E); }
    xcd_barrier(xb); if (PROBE == 20) xcd_barrier(xb); STAMP();
    {   const Params P = load_params(); unsigned char* ws = P.ws;
        pg8::Gemm g{(const bf16_t*)(ws + WS_X1B), (const bf16_t*)(ws + WS_WGU), NTOK, NGU, DM, DM}; pg8::StaticOrder S; S.init(NTOK, NGU, G, (int)blockIdx.x);
        EpiAct E{(bf16_t*)(ws + WS_ACT), (const float*)(ws + WS_SS1)};
        pg8::gemm_phase<EpiAct, pg8::StaticOrder, true, true>(lds, g, S, E);
        if (PROBE == 15) pg8::gemm_phase<EpiAct, pg8::StaticOrder, true, true>(lds, g, S, E); }
    xcd_barrier(xb); if (PROBE == 20) xcd_barrier(xb); STAMP();
    {   const Params P = load_params(); unsigned char* ws = P.ws;
        {   pg8::Gemm g{(const bf16_t*)(ws + WS_ACT), (const bf16_t*)(ws + WS_WDN), NTOK_P, DM, DFF, DFF}; pg8::StaticOrder S; S.init(NTOK_P, DM, G, (int)blockIdx.x);
            EpiX2 E{P.out + OUT_Y, (const bf16_t*)(ws + WS_X1B)};
            pg8::gemm_phase<EpiX2, pg8::StaticOrder, true, true>(lds, g, S, E); }
        {   pg8::Gemm g{(const bf16_t*)(ws + WS_ACT), (const bf16_t*)(ws + WS_WDN), NTOK, DM, 256, DFF}; SplitOrder S{G, (int)blockIdx.x};
            EpiX2Split E{(float*)(ws + WS_SLAB)};
            pg8::gemm_phase<EpiX2Split, SplitOrder, true, true>(lds, g, S, E); } }
    xcd_barrier(xb); if (PROBE == 20) xcd_barrier(xb); STAMP();
    {
        const Params P = load_params();
        const int tid = tid_(), lane = tid & 63, wave = tid >> 6; const float* fw = P.in[I_FN];
        f32x4 nw[4];
#pragma unroll
        for (int j = 0; j < 4; ++j) nw[j] = *(const f32x4*)(fw + 4 * lane + 256 * j);
        for (int rep = (PROBE == 17 ? 0 : 1); rep < 2; ++rep)
        for (int m = blockIdx.x * NWAVES + wave; m < NTOK; m += G * NWAVES) {
            float* row = P.out + OUT_Y + (size_t)m * DM; f32x4 v[4]; float s = 0.f;
            float* orow = (rep == 0) ? (float*)(P.ws + WS_HN) + (size_t)m * DM : row;
#pragma unroll
            for (int j = 0; j < 4; ++j) v[j] = *(const f32x4*)(row + 4 * lane + 256 * j);
            if (m >= NTOK_P) { const bf16_t* xb = (const bf16_t*)(P.ws + WS_X1B) + (size_t)m * DM + 4 * lane;
#pragma unroll
                for (int j = 0; j < 4; ++j) { const u32x2 x = *(const u32x2*)(xb + 256 * j); v[j] = (f32x4){__uint_as_float(x.x << 16), __uint_as_float(x.x & 0xffff0000u), __uint_as_float(x.y << 16), __uint_as_float(x.y & 0xffff0000u)}; }
                const float* sl = (const float*)(P.ws + WS_SLAB) + (size_t)(m - NTOK_P) * DM + 4 * lane;
#pragma unroll
                for (int q = 0; q < 11; ++q)
#pragma unroll
                    for (int j = 0; j < 4; ++j) v[j] += *(const f32x4*)(sl + (size_t)q * (1024 * 1024) + 256 * j); }
#pragma unroll
            for (int j = 0; j < 4; ++j) s += (v[j].x * v[j].x + v[j].y * v[j].y) + (v[j].z * v[j].z + v[j].w * v[j].w);
            const float rstd = rsqrtf(wave_sum(s) * (1.f / DM) + 1e-6f);
#pragma unroll
            for (int j = 0; j < 4; ++j) *(f32x4*)(orow + 4 * lane + 256 * j) = v[j] * rstd * nw[j];
        }
    }
    if (PROBE_T) {
        asm volatile("s_waitcnt vmcnt(0)" ::: "memory"); __syncthreads(); STAMP(); __syncthreads();
        if (blockIdx.x == 0) { const Params P = load_params(); const unsigned* ctlw = (const unsigned*)(P.ws + WS_CTL);
            const unsigned dtk = (PROBE_T < 10) ? bst[4 + PROBE_T] - bst[4 + PROBE_T - 1] : __hip_atomic_load(ctlw + 16000 + (PROBE_T == 10 ? 0 : PROBE_T == 11 ? 40 : 255), __ATOMIC_RELAXED, __HIP_MEMORY_SCOPE_AGENT) - bst[4 + 3];
            const float sc = 1.f + PROBE_SC * (float)dtk;
            for (int i = threadIdx.x; i < 4096; i += NTHR) P.out[OUT_PRH + i] *= sc; }
    }
#undef STAMP
}

extern "C" void kernel_launch(void* const* d_in, const int* in_sizes, int n_in, void* d_out, int out_size, void* d_ws, size_t ws_size, hipStream_t stream) {
    static int grid = 0;
    if (grid == 0) {
        int dev = 0, cus = 0, per_cu = 0;
        if (n_in != 25 || ws_size < WS_END) { fprintf(stderr, "kernel_launch: unexpected n_in %d / ws_size %zu\n", n_in, ws_size); grid = -1; return; }
        hipGetDevice(&dev); hipDeviceGetAttribute(&cus, hipDeviceAttributeMultiprocessorCount, dev);
        hipFuncSetAttribute((const void*)hybrid_fwd, hipFuncAttributeMaxDynamicSharedMemorySize, LDS_BYTES);
        hipOccupancyMaxActiveBlocksPerMultiprocessor(&per_cu, (const void*)hybrid_fwd, NTHR, LDS_BYTES);
        (void)hipGetLastError();
        if (per_cu < 1) { fprintf(stderr, "kernel_launch: occupancy query says %d blocks per CU\n", per_cu); per_cu = 1; }
        grid = cus;
        if (grid > 256) grid = 256;
    }
    if (grid < 0) return;
    hipMemsetAsync((char*)d_ws + WS_CTL, 0, CTL_BYTES, stream);
    Params p{};
    for (int i = 0; i < 25; ++i) p.in[i] = (const float*)d_in[i];
    p.out = (float*)d_out; p.ws = (unsigned char*)d_ws;
    void* args[] = {&p};
    hipError_t e = hipLaunchCooperativeKernel((const void*)hybrid_fwd, dim3(grid), dim3(NTHR), args, LDS_BYTES, stream);
    if (e != hipSuccess) fprintf(stderr, "cooperative launch failed: %s (grid %d)\n", hipGetErrorString(e), grid);
}
```
